# Optimizing an MI355X kernel written in HIP

```python
import numpy as np
import jax
import jax.numpy as jnp
from jax import lax

D_MODEL = 1024
BATCH = 16
SEQ = 2048
DEPTH = 4

GRID_W = 64
CTX_LEN = 256
NORM_EPS = 1e-6
N_MOD = 6

RET_HEADS = 4
RET_DK = 128
RET_DV = 256
RET_QK = RET_HEADS * RET_DK
RET_V = RET_HEADS * RET_DV
RET_CHUNK = 128
ROPE_BASE = 10000.0

CONV_W = 512
CONV_K = 3

POOL_WINDOWS = (2, 4, 8, 16)
POOL_GROUPS = 4
POOL_GDIM = 128
POOL_W = POOL_GROUPS * POOL_GDIM

N_BRANCH = 3
IN_SPLITS = (RET_QK, RET_QK, RET_V, RET_V, CONV_W, CONV_W, CONV_W, POOL_W, N_BRANCH * D_MODEL)
IN_WIDTH = 2 * RET_QK + 2 * RET_V + 3 * CONV_W + POOL_W + N_BRANCH * D_MODEL

N_GROUPS = 4
EXP_PER_GROUP = 4
N_EXPERTS = N_GROUPS * EXP_PER_GROUP
TOP_K_INNER = 2
D_FF_EXPERT = 512

kernel_name = 'hybrid_retention_conv_pool_hmoe_dit'


def rmsnorm(x, g):
    xf = x.astype(jnp.float32)
    y = xf * lax.rsqrt(jnp.mean(xf * xf, axis=-1, keepdims=True) + NORM_EPS)
    return (y * g.astype(jnp.float32)).astype(x.dtype)


def split_cols(p):
    offsets = np.cumsum(IN_SPLITS)[:-1].tolist()
    return jnp.split(p, offsets, axis=-1)


def to_heads(a, head_dim):
    b, n, w = a.shape
    return a.astype(jnp.float32).reshape(b, n, w // head_dim, head_dim)


def axial_rope(n_tokens):
    rows = n_tokens // GRID_W
    row = jnp.repeat(jnp.arange(rows, dtype=jnp.float32), GRID_W)
    col = jnp.tile(jnp.arange(GRID_W, dtype=jnp.float32), rows)
    n_freq = RET_DK // 4
    inv_freq = ROPE_BASE ** (-jnp.arange(n_freq, dtype=jnp.float32) / n_freq)
    ang = jnp.concatenate([row[:, None] * inv_freq[None, :], col[:, None] * inv_freq[None, :]], axis=-1)
    return jnp.cos(ang), jnp.sin(ang)


def apply_rope(x, cos, sin):
    x1, x2 = jnp.split(x, 2, axis=-1)
    c = cos[None, :, None, :]
    s = sin[None, :, None, :]
    return jnp.concatenate([x1 * c - x2 * s, x1 * s + x2 * c], axis=-1)


def retention_dir(q, k, v, log_gamma, state0):
    b, n_tok, h, dk = q.shape
    dv = v.shape[-1]
    C = RET_CHUNK
    n = n_tok // C
    qc = q.reshape(b, n, C, h, dk)
    kc = k.reshape(b, n, C, h, dk)
    vc = v.reshape(b, n, C, h, dv)
    j = jnp.arange(C, dtype=jnp.float32)
    rel = j[:, None] - j[None, :]
    intra_decay = jnp.where(rel[None] >= 0.0,
                            jnp.exp(log_gamma[:, None, None] * jnp.maximum(rel, 0.0)[None]), 0.0)
    scores = jnp.einsum('bnihd,bnjhd->bnhij', qc, kc) * intra_decay[None, None]
    intra = jnp.einsum('bnhij,bnjhe->bnihe', scores, vc)
    q_decay = jnp.exp(log_gamma[None, :] * (j[:, None] + 1.0))
    k_decay = jnp.exp(log_gamma[None, :] * (C - 1.0 - j[:, None]))
    chunk_decay = jnp.exp(log_gamma * C)[None, :, None, None]
    kv = jnp.einsum('bnjhd,jh,bnjhe->nbhde', kc, k_decay, vc)

    def step(state, inp):
        q_i, kv_i = inp
        out_i = jnp.einsum('bihd,bhde->bihe', q_i, state)
        return state * chunk_decay + kv_i, out_i

    _, inter = lax.scan(step, state0, (jnp.moveaxis(qc, 1, 0), kv))
    inter = jnp.moveaxis(inter, 0, 1) * q_decay[None, None, :, :, None]
    return (intra + inter).reshape(b, n_tok, h, dv)


def ctx_final_states(k, v, log_gamma):
    n_tok = k.shape[1]
    m = jnp.arange(n_tok, dtype=jnp.float32)
    w_fwd = jnp.exp(log_gamma[0][:, None] * (n_tok - 1.0 - m)[None, :])
    w_bwd = jnp.exp(log_gamma[1][:, None] * m[None, :])
    s_fwd = jnp.einsum('blhd,hl,blhe->bhde', k, w_fwd, v)
    s_bwd = jnp.einsum('blhd,hl,blhe->bhde', k, w_bwd, v)
    return s_fwd, s_bwd


def head_norm(y):
    mu = jnp.mean(y, axis=-1, keepdims=True)
    yc = y - mu
    return yc * lax.rsqrt(jnp.mean(yc * yc, axis=-1, keepdims=True) + NORM_EPS)


def short_conv(u, w):
    up = jnp.pad(u, ((0, 0), (1, 1), (0, 0)))
    return w[0] * up[:, :-2] + w[1] * up[:, 1:-1] + w[2] * up[:, 2:]


def multiscale_pool(u, w_group, scale):
    b, n_tok, width = u.shape
    uf = u.astype(jnp.float32)
    cs = jnp.concatenate([jnp.zeros((b, 1, width), jnp.float32), jnp.cumsum(uf, axis=1)], axis=1)
    t = jnp.arange(n_tok)
    outs = []
    for gi, win in enumerate(POOL_WINDOWS):
        sl = slice(gi * POOL_GDIM, (gi + 1) * POOL_GDIM)
        lo = jnp.clip(t - win // 2, 0, n_tok)
        hi = jnp.clip(t + win - win // 2, 0, n_tok)
        cnt = (hi - lo).astype(jnp.float32)
        mean = (cs[:, hi, sl] - cs[:, lo, sl]) / cnt[None, :, None]
        outs.append(mean - uf[:, :, sl])
    pooled = jnp.stack(outs, axis=2)
    mixed = jnp.einsum('blgc,gcd->blgd', pooled, w_group.astype(jnp.float32)).reshape(b, n_tok, width)
    return (mixed * scale.astype(jnp.float32)).astype(u.dtype)


def mix_stream(parts, rope, log_gamma, state_f, state_b, conv_w, pool_w, pool_scale,
               w_ret_out, w_conv_out, w_pool_out, w_o):
    q_in, k_in, v_in, g_in, conv_b, conv_c, conv_x, pool_in, gate_in = parts
    dt = q_in.dtype
    b, n_tok, _ = q_in.shape
    q = to_heads(q_in, RET_DK)
    k = to_heads(k_in, RET_DK) * RET_DK ** -0.5
    v = to_heads(v_in, RET_DV)
    if rope is not None:
        q = apply_rope(q, rope[0], rope[1])
        k = apply_rope(k, rope[0], rope[1])
    flip = lambda a: jnp.flip(a, axis=1)
    o_fwd = retention_dir(q, k, v, log_gamma[0], state_f)
    o_bwd = flip(retention_dir(flip(q), flip(k), flip(v), log_gamma[1], state_b))
    y_ret = head_norm(o_fwd + o_bwd).reshape(b, n_tok, RET_V).astype(dt) * jax.nn.silu(g_in)
    y_conv = conv_b * short_conv(conv_c * conv_x, conv_w)
    y_pool = multiscale_pool(pool_in, pool_w, pool_scale)
    g_ret, g_conv, g_pool = jnp.split(jax.nn.sigmoid(gate_in.astype(jnp.float32)).astype(dt), N_BRANCH, axis=-1)
    merged = g_ret * (y_ret @ w_ret_out) + g_conv * (y_conv @ w_conv_out) + g_pool * (y_pool @ w_pool_out)
    return merged @ w_o


def token_mixers(h, hc, rope, w_in, ret_decay, conv_w, pool_w, pool_scale,
                 w_ret_out, w_conv_out, w_pool_out, w_o, need_ctx):
    log_gamma = jax.nn.log_sigmoid(ret_decay.astype(jnp.float32))
    if need_ctx:
        pc = split_cols(hc @ w_in)
        k_c_in, v_c_in = pc[1], pc[2]
    else:
        k_c_in, v_c_in = jnp.split(hc @ w_in[:, RET_QK:2 * RET_QK + RET_V], [RET_QK], axis=-1)
    k_c = to_heads(k_c_in, RET_DK) * RET_DK ** -0.5
    v_c = to_heads(v_c_in, RET_DV)
    s_fwd, s_bwd = ctx_final_states(k_c, v_c, log_gamma)
    y = mix_stream(split_cols(h @ w_in), rope, log_gamma, s_fwd, s_bwd, conv_w, pool_w, pool_scale,
                   w_ret_out, w_conv_out, w_pool_out, w_o)
    if need_ctx:
        zeros = jnp.zeros_like(s_fwd)
        yc = mix_stream(pc, None, log_gamma, zeros, zeros, conv_w, pool_w, pool_scale,
                        w_ret_out, w_conv_out, w_pool_out, w_o)
    else:
        yc = None
    return y, yc


def hier_moe(h, w_rg, b_rg, w_re, b_re, w1, w3, w2):
    b, n_tok, d = h.shape
    t = h.reshape(-1, d)
    tf = t.astype(jnp.float32)
    g_prob = jax.nn.softmax(tf @ w_rg.astype(jnp.float32) + b_rg.astype(jnp.float32), axis=-1)
    g_top, g_idx = lax.top_k(g_prob, 1)
    e_logits = (tf @ w_re.astype(jnp.float32) + b_re.astype(jnp.float32)).reshape(-1, N_GROUPS, EXP_PER_GROUP)
    e_in_group = jnp.take_along_axis(e_logits, g_idx[:, :, None], axis=1)[:, 0]
    e_top, e_loc = lax.top_k(e_in_group, TOP_K_INNER)
    e_w = jax.nn.softmax(e_top, axis=-1) * g_top
    e_idx = g_idx * EXP_PER_GROUP + e_loc
    combine = jnp.sum(jax.nn.one_hot(e_idx, N_EXPERTS, dtype=jnp.float32) * e_w[..., None], axis=1).astype(t.dtype)
    y = jnp.zeros_like(t)
    for e in range(N_EXPERTS):
        a = jax.nn.silu(t @ w1[e]) * (t @ w3[e])
        y = y + combine[:, e:e + 1] * (a @ w2[e])
    return y.reshape(b, n_tok, d)


def setup_inputs(seed: int = 0) -> dict:
    key = jax.random.key(seed)
    ks = jax.random.split(key, 26)
    f32 = jnp.float32

    def nrm(k, shape, scale):
        return jax.random.normal(k, shape, f32) * scale

    D = D_MODEL
    decay_base = jnp.log(2.0 ** jnp.arange(5, 5 + RET_HEADS, dtype=f32) - 1.0)
    return {
        'x': nrm(ks[0], (BATCH, SEQ, D), 1.0),
        'c': nrm(ks[1], (BATCH, D), 1.0),
        'ctx': nrm(ks[2], (BATCH, CTX_LEN, D), 1.0),
        'c_ctx': nrm(ks[3], (D,), 1.0),
        'w_ada': nrm(ks[4], (DEPTH, D, N_MOD * D), 0.5 * D ** -0.5),
        'b_ada': nrm(ks[5], (DEPTH, N_MOD * D), 0.02),
        'norm1': 1.0 + nrm(ks[6], (DEPTH, D), 0.05),
        'norm2': 1.0 + nrm(ks[7], (DEPTH, D), 0.05),
        'w_in': nrm(ks[8], (DEPTH, D, IN_WIDTH), D ** -0.5),
        'ret_decay': decay_base[None, None, :] + nrm(ks[9], (DEPTH, 2, RET_HEADS), 0.1),
        'conv_w': nrm(ks[10], (DEPTH, CONV_K, CONV_W), CONV_K ** -0.5),
        'pool_w': nrm(ks[11], (DEPTH, POOL_GROUPS, POOL_GDIM, POOL_GDIM), POOL_GDIM ** -0.5),
        'pool_scale': 1.0 + nrm(ks[12], (DEPTH, POOL_W), 0.1),
        'w_ret_out': nrm(ks[13], (DEPTH, RET_V, D), RET_V ** -0.5),
        'w_conv_out': nrm(ks[14], (DEPTH, CONV_W, D), CONV_W ** -0.5),
        'w_pool_out': nrm(ks[15], (DEPTH, POOL_W, D), POOL_W ** -0.5),
        'w_o': nrm(ks[16], (DEPTH, D, D), D ** -0.5),
        'w_rg': nrm(ks[17], (DEPTH, D, N_GROUPS), D ** -0.5),
        'b_rg': nrm(ks[18], (DEPTH, N_GROUPS), 0.01),
        'w_re': nrm(ks[19], (DEPTH, D, N_EXPERTS), D ** -0.5),
        'b_re': nrm(ks[20], (DEPTH, N_EXPERTS), 0.01),
        'w1': nrm(ks[21], (DEPTH, N_EXPERTS, D, D_FF_EXPERT), D ** -0.5),
        'w3': nrm(ks[22], (DEPTH, N_EXPERTS, D, D_FF_EXPERT), D ** -0.5),
        'w2': nrm(ks[23], (DEPTH, N_EXPERTS, D_FF_EXPERT, D), D_FF_EXPERT ** -0.5),
        'final_norm': 1.0 + nrm(ks[24], (D,), 0.05),
    }


def reference(x, c, ctx, c_ctx, w_ada, b_ada, norm1, norm2, w_in, ret_decay, conv_w, pool_w, pool_scale,
              w_ret_out, w_conv_out, w_pool_out, w_o, w_rg, b_rg, w_re, b_re, w1, w3, w2, final_norm):
    rope = axial_rope(x.shape[1])
    xc = ctx
    silu_c = jax.nn.silu(c)
    silu_cc = jax.nn.silu(c_ctx)
    n_ctx = ctx.shape[1]
    for l in range(DEPTH):
        last = l == DEPTH - 1
        mod = (silu_c @ w_ada[l] + b_ada[l])[:, None, :]
        mod_c = (silu_cc @ w_ada[l] + b_ada[l])[None, None, :]
        sh1, sc1, gt1, sh2, sc2, gt2 = jnp.split(mod, N_MOD, axis=-1)
        csh1, csc1, cgt1, csh2, csc2, cgt2 = jnp.split(mod_c, N_MOD, axis=-1)
        h = rmsnorm(x, norm1[l]) * (1.0 + sc1) + sh1
        hc = rmsnorm(xc, norm1[l]) * (1.0 + csc1) + csh1
        y, yc = token_mixers(h, hc, rope, w_in[l], ret_decay[l], conv_w[l], pool_w[l], pool_scale[l],
                             w_ret_out[l], w_conv_out[l], w_pool_out[l], w_o[l], not last)
        x = x + gt1 * y
        h = rmsnorm(x, norm2[l]) * (1.0 + sc2) + sh2
        if last:
            x = x + gt2 * hier_moe(h, w_rg[l], b_rg[l], w_re[l], b_re[l], w1[l], w3[l], w2[l])
        else:
            xc = xc + cgt1 * yc
            hc = rmsnorm(xc, norm2[l]) * (1.0 + csc2) + csh2
            f = hier_moe(jnp.concatenate([hc, h], axis=1), w_rg[l], b_rg[l], w_re[l], b_re[l], w1[l], w3[l], w2[l])
            xc = xc + cgt2 * f[:, :n_ctx]
            x = x + gt2 * f[:, n_ctx:]
    return rmsnorm(x, final_norm)
```

```cpp
#include <hip/hip_runtime.h>
#include <cstdio>
#include <cstdint>

#ifndef REP_G1
#define REP_G1 1
#endif
#ifndef REP_G2
#define REP_G2 1
#endif
#ifndef REP_G3
#define REP_G3 1
#endif
#ifndef REP_G4
#define REP_G4 1
#endif
#ifndef REP_WO
#define REP_WO 1
#endif
#ifndef REP_M0
#define REP_M0 1
#endif
#ifndef REP_M1
#define REP_M1 1
#endif
#ifndef REP_M2
#define REP_M2 1
#endif
#ifndef REP_CVT
#define REP_CVT 1
#endif
#ifndef REP_P0
#define REP_P0 1
#endif
#ifndef REP_N1
#define REP_N1 1
#endif
#ifndef REP_BAR
#define REP_BAR 1
#endif
#ifndef REP_N2
#define REP_N2 1
#endif
#ifndef REP_CH
#define REP_CH 1
#endif
#ifndef REP_EPI
#define REP_EPI 1
#endif
#ifndef REP_CP
#define REP_CP 1
#endif
#define LAS __attribute__((address_space(3)))
typedef unsigned short bf16_t;
typedef short bf16x8 __attribute__((ext_vector_type(8)));
typedef short bf16x4 __attribute__((ext_vector_type(4)));
typedef float f32x4 __attribute__((ext_vector_type(4)));
typedef float f32x2 __attribute__((ext_vector_type(2)));
typedef unsigned u32x4 __attribute__((ext_vector_type(4)));
typedef unsigned u32x2 __attribute__((ext_vector_type(2)));

constexpr int D = 1024, NB = 16, SEQ = 2048, CL = 256, TPB = SEQ + CL  , T = NB * TPB  , DEPTH = 4;
constexpr int NG = 4, BG = NB / NG, TG = BG * TPB;
constexpr int NCH = TPB / 128;
constexpr float EPS = 1e-6f;
constexpr int NMOD = 6 * D;

constexpr size_t MiB = 1u << 20;
constexpr size_t WS_CTL = 0;
constexpr size_t WS_MOD = 1 * MiB;
constexpr size_t WS_TAB = WS_MOD + (size_t)DEPTH * 17 * NMOD * 4;
constexpr size_t WS_WIN = 3 * MiB;
constexpr size_t WS_WRET = WS_WIN + 16 * MiB;
constexpr size_t WS_WCONV = WS_WRET + 2 * MiB;
constexpr size_t WS_WPOOL = WS_WCONV + 1 * MiB;
constexpr size_t WS_WO = WS_WPOOL + 1 * MiB;
constexpr size_t WS_W13 = WS_WO + 2 * MiB;
constexpr size_t WS_W2 = WS_W13 + 32 * MiB;
constexpr size_t WS_XC = WS_W2 + 16 * MiB;
constexpr size_t WS_H = WS_XC + 16 * MiB;
constexpr size_t WS_PROJ = WS_H + 72 * MiB;
constexpr size_t SEC = (size_t)TG * 512 * 2;
constexpr size_t WS_QF = WS_PROJ, WS_QB = WS_QF + SEC, WS_KF = WS_QB + SEC, WS_KB = WS_KF + SEC, WS_KTF = WS_KB + SEC, WS_KTB = WS_KTF + SEC;
constexpr size_t WS_VT = WS_KTB + SEC, WS_GS = WS_VT + 2 * SEC, WS_CB = WS_GS + 2 * SEC, WS_CU = WS_CB + SEC, WS_PI = WS_CU + SEC;
constexpr size_t WS_GATE0 = WS_PI + SEC, WS_GATE1 = WS_GATE0 + 6 * SEC;
constexpr size_t WS_PROJ_END = WS_GATE1 + 6 * SEC;
constexpr size_t WS_H2S = WS_PROJ;
constexpr size_t WS_ACT = WS_PROJ + 152 * MiB;
constexpr size_t WS_STATES = WS_PROJ_END;
constexpr size_t WS_YRET = WS_STATES + 36 * MiB;
constexpr size_t WS_YCONV = WS_YRET + 18 * MiB;
constexpr size_t WS_POOLED = WS_YCONV + 9 * MiB;
constexpr size_t WS_MERGEDF = WS_POOLED + 9 * MiB;
constexpr size_t WS_X = WS_MERGEDF + 36 * MiB;
constexpr size_t WS_YATT = WS_X + 72 * MiB;
constexpr size_t WS_YS = WS_YATT + 72 * MiB;
constexpr size_t WS_MERGED = WS_YS;
constexpr size_t WS_ROUTEC = WS_YS + 152 * MiB;
constexpr size_t WS_SLOTOF = WS_ROUTEC + 512 * 1024;
constexpr size_t WS_LIST = WS_ROUTEC + 1 * MiB;
constexpr size_t WS_END = WS_LIST + 3 * MiB;
static_assert(WS_PROJ_END - WS_PROJ == 25 * SEC, "proj");
static_assert(WS_ACT + (size_t)(2 * T + 4096) * 512 * 2 <= WS_X && WS_H2S + (size_t)(2 * T + 4096) * 1024 * 2 <= WS_ACT, "moe alias");
static_assert(WS_END <= 798 * MiB, "workspace");
constexpr int CW_ERR = 16;
constexpr int CW_BAR = 4096;
constexpr int CW_CNT = 16384;

constexpr int LDS_BYTES = 147456;
constexpr int LC_OFF = 131072;
constexpr int LC_BAR = LC_OFF + 32;
constexpr int LC_CNT = LC_OFF + 256;
constexpr int LC_POFF = LC_OFF + 384;
constexpr int LC_NT = LC_OFF + 480;
constexpr int LC_TILEE = LC_OFF + 512;
constexpr int LC_RE = LC_OFF + 2048;
constexpr int LC_LCNT = LC_OFF + 3584;
constexpr int LC_GTBL = LC_OFF + 4096;

__device__ __forceinline__ unsigned cvt_pk_bf16(float lo, float hi) { unsigned r; asm volatile("s_nop 0\n\tv_cvt_pk_bf16_f32 %0, %1, %2" : "=v"(r) : "v"(lo), "v"(hi)); return r; }
__device__ __forceinline__ float bf_lo(unsigned w) { return __uint_as_float(w << 16); }
__device__ __forceinline__ float bf_hi(unsigned w) { return __uint_as_float(w & 0xffff0000u); }
template <int CTRL> __device__ __forceinline__ float dpp_add(float v) { return v + __builtin_bit_cast(float, __builtin_amdgcn_update_dpp(0, __builtin_bit_cast(int, v), CTRL, 0xF, 0xF, true)); }
__device__ __forceinline__ float row16_sum(float v) { v = dpp_add<0xB1>(v); v = dpp_add<0x4E>(v); v = dpp_add<0x141>(v); v = dpp_add<0x140>(v); return v; }
__device__ __forceinline__ float swap32_sum(float a, float b) { const auto r = __builtin_amdgcn_permlane32_swap(__builtin_bit_cast(unsigned, a), __builtin_bit_cast(unsigned, b), false, false);
    return __builtin_bit_cast(float, (unsigned)r[0]) + __builtin_bit_cast(float, (unsigned)r[1]); }
__device__ __forceinline__ float swap16_sum(float a, float b) { const auto r = __builtin_amdgcn_permlane16_swap(__builtin_bit_cast(unsigned, a), __builtin_bit_cast(unsigned, b), false, false);
    return __builtin_bit_cast(float, (unsigned)r[0]) + __builtin_bit_cast(float, (unsigned)r[1]); }
__device__ __forceinline__ float wave_sum4(float v0, float v1, float v2, float v3) { return row16_sum(swap16_sum(swap32_sum(v0, v1), swap32_sum(v2, v3))); }
__device__ __forceinline__ float wave_sum(float v) { const float r = row16_sum(v); const float t = swap16_sum(r, r); return swap32_sum(t, t); }
__device__ __forceinline__ float rows4_sum(float v) { const float t = swap16_sum(v, v); return swap32_sum(t, t); }
__device__ __forceinline__ float lane_val(float v, int l) { return __builtin_bit_cast(float, __builtin_amdgcn_readlane(__builtin_bit_cast(int, v), l)); }
__device__ __forceinline__ float fast_exp(float x) { return __builtin_amdgcn_exp2f(x * 1.4426950408889634f); }
__device__ __forceinline__ float silu_f(float x) { return x * __builtin_amdgcn_rcpf(1.0f + fast_exp(-x)); }
__device__ __forceinline__ float sigmoid_f(float x) { return __builtin_amdgcn_rcpf(1.0f + fast_exp(-x)); }
__device__ __forceinline__ float silu_fast(float x) { return x * __builtin_amdgcn_rcpf(1.0f + fast_exp(-x)); }
__device__ __forceinline__ float sigmoid_fast(float x) { return __builtin_amdgcn_rcpf(1.0f + fast_exp(-x)); }
__device__ __forceinline__ u32x4 pack8(const f32x4 a, const f32x4 b) { u32x4 w; w.x = cvt_pk_bf16(a[0], a[1]); w.y = cvt_pk_bf16(a[2], a[3]); w.z = cvt_pk_bf16(b[0], b[1]); w.w = cvt_pk_bf16(b[2], b[3]); return w; }
#define LDS_WAIT() asm volatile("s_waitcnt lgkmcnt(0)" ::: "memory")
#define VM_WAIT() asm volatile("s_waitcnt vmcnt(0)" ::: "memory")

#define XB_TMO      128
#define XB_XCNT(j)  (256  + 64 * (j))
#define XB_XSUB(j)  (1280 + 64 * (j))
#define XB_XGEN(j)  (2304 + 64 * (j))
#define XB_TOP      3328
#define XB_TOPGEN   3392
#define XCD_BAR_WORDS 3456
#define XB_SPIN_CAP (1u << 18)
__device__ __forceinline__ unsigned xb_ld(unsigned* p)              { return __hip_atomic_load(p, __ATOMIC_RELAXED, __HIP_MEMORY_SCOPE_AGENT); }
__device__ __forceinline__ unsigned xb_add(unsigned* p, unsigned v) { return __hip_atomic_fetch_add(p, v, __ATOMIC_RELAXED, __HIP_MEMORY_SCOPE_AGENT); }
__device__ __forceinline__ unsigned xb_xcc_id() { return (unsigned)__builtin_amdgcn_s_getreg((3 << 11) | 20) & 0xFu; }
#define XB_SPIN(cond, bar) do { unsigned _sp = 0; while (cond) { __builtin_amdgcn_s_sleep(1); \
    if ((++_sp & 255u) == 0u) { if (xb_ld(&(bar)[XB_TMO])) break; if (_sp > XB_SPIN_CAP) { atomicAdd(&(bar)[XB_TMO], 1u); break; } } } } while (0)
struct XcdBarrier { unsigned* bar; unsigned x; volatile LAS unsigned* st; };
__device__ __forceinline__ XcdBarrier xcd_barrier_post(unsigned* bar, volatile LAS unsigned* st) {
    XcdBarrier b; b.bar = bar; b.x = xb_xcc_id(); b.st = st;
    if (threadIdx.x == 0) (void)xb_add(&bar[XB_XCNT(b.x)], 1u);
    return b;
}
__device__ __forceinline__ void xcd_barrier_complete(unsigned* bar, unsigned x, unsigned& nloc, unsigned& nx) {
    const unsigned G = gridDim.x * gridDim.y * gridDim.z;
    unsigned sum, cnt, mine, sp = 0u;
    for (;;) {
        sum = 0u; cnt = 0u; mine = 0u;
#pragma unroll 1
        for (unsigned j = 0; j < 16; ++j) { const unsigned c = xb_ld(&bar[XB_XCNT(j)]); sum += c; cnt += (c > 0u) ? 1u : 0u; mine = (j == x) ? c : mine; }
        if (sum == G) break;
        __builtin_amdgcn_s_sleep(1);
        if ((++sp & 255u) == 0u) { if (xb_ld(&bar[XB_TMO])) break; if (sp > XB_SPIN_CAP) { atomicAdd(&bar[XB_TMO], 1u); break; } }
    }
    nloc = mine > 0u ? mine : 1u; nx = cnt > 0u ? cnt : 1u;
}
__device__ __forceinline__ void xcd_barrier(const XcdBarrier& b) {
    asm volatile("s_waitcnt vmcnt(0)" ::: "memory");
    __syncthreads();
    if (threadIdx.x == 0) {
        unsigned* bar = b.bar;
        __builtin_amdgcn_s_waitcnt(0);
        unsigned nloc = b.st[0], nx = b.st[1];
        if (nloc == 0u) { xcd_barrier_complete(bar, b.x, nloc, nx); b.st[0] = nloc; b.st[1] = nx; }
        const unsigned old = xb_add(&bar[XB_XSUB(b.x)], 1u);
        const unsigned gen = old / nloc;
        if (old + 1u == (gen + 1u) * nloc) {
            __builtin_amdgcn_fence(__ATOMIC_RELEASE, "agent");
            asm volatile("s_waitcnt vmcnt(0)" ::: "memory");
            const unsigned og = xb_add(&bar[XB_TOP], 1u);
            const unsigned tg = og / nx;
            if (og + 1u == (tg + 1u) * nx) xb_add(&bar[XB_TOPGEN], 1u);
            else XB_SPIN(xb_ld(&bar[XB_TOPGEN]) == tg, bar);
            __builtin_amdgcn_fence(__ATOMIC_ACQUIRE, "agent");
            xb_add(&bar[XB_XGEN(b.x)], 1u);
            asm volatile("s_waitcnt vmcnt(0)" ::: "memory");
        } else {
            XB_SPIN(xb_ld(&bar[XB_XGEN(b.x)]) == gen, bar);
            __builtin_amdgcn_fence(__ATOMIC_ACQUIRE, "agent");
            asm volatile("s_waitcnt vmcnt(0)" ::: "memory");
        }
    }
    __syncthreads();
}

namespace pg8 {
constexpr int BM = 256, BK = 64, HALF = 128, HTB = HALF * BK * 2, STAGE_BYTES = 8 * HTB, NXCD = 8, WGM = 8;
__host__ __device__ __forceinline__ int lds_byte(int r, int c) { const int st = (r >> 4) * 2 + (c >> 5), rr = r & 15, cc = c & 31, ob = rr * 64 + cc * 2; return st * 1024 + (ob ^ (((ob >> 9) & 1) << 5)); }
__host__ __device__ __forceinline__ void stage_rc(int b, int& R, int& C) { const int st = b / 1024, sb = b % 1024, swz = sb ^ (((sb >> 9) & 1) << 5); R = (st >> 1) * 16 + swz / 64; C = (st & 1) * 32 + (swz % 64) / 2; }
__host__ __device__ __forceinline__ int perm32(int rho) { const int n = rho >> 4, i = rho & 15; return 8 * (i >> 2) + 4 * n + (i & 3); }

struct Unit { const char* a; const char* b; int pm, pn, kind, nt, cont; };

__device__ __forceinline__ void tile_map(int L, int nM, int nN, int& pm, int& pn) {
    const int nwg = nM * nN; int wgid = L;
    { const int q = nwg / NXCD, r = nwg % NXCD, xcd = wgid % NXCD, off = wgid / NXCD; wgid = (xcd < r ? xcd * (q + 1) : r * (q + 1) + (xcd - r) * q) + off; }
    const int nig = WGM * nN, gid = wgid / nig, fm = gid * WGM, gsz = (nM - fm) < WGM ? (nM - fm) : WGM;
    pm = fm + ((wgid % nig) % gsz); pn = (wgid % nig) / gsz;
}

template <class S_> struct sched_gather { static constexpr bool value = false; };
template <int K, int lda, int ldb, class Epi, class Sched, bool ALIGN_EPI, bool SP2, bool VARNT = false>
__device__ __forceinline__ void gemm_phase(LAS unsigned char* lds, const int tid, const Sched& S, const Epi& E) {
    const int wid = __builtin_amdgcn_readfirstlane(tid >> 6), lane = tid & 63, wr = wid >> 2, wc = wid & 3, fr = lane & 15, fq = lane >> 4;
    constexpr int nt_c = K / BK;
    unsigned voffA[2], voffB[2];
#pragma unroll
    for (int i = 0; i < 2; ++i) { int R, C; stage_rc(tid * 16 + i * 8192, R, C); const int Rb = Epi::PERM ? ((R & ~31) + perm32(R & 31)) : R;
        voffA[i] = (unsigned)(R * lda + C) * 2u; voffB[i] = (unsigned)(Rb * ldb + C) * 2u; }
    constexpr bool GATHER = sched_gather<Sched>::value;
    int gR[2], gC2[2];
#pragma unroll
    for (int i = 0; i < 2; ++i) { int R, C; stage_rc(tid * 16 + i * 8192, R, C); gR[i] = R; gC2[i] = C * 2; }
    unsigned voA0[2] = {voffA[0], voffA[1]}, voA1[2] = {voffA[0], voffA[1]};
    constexpr size_t kstep = (size_t)(BK * 2);
    constexpr size_t hstepA = (size_t)HALF * lda * 2, hstepB = (size_t)HALF * ldb * 2;
    const unsigned ldsw = (unsigned)wid * 1024u;
    const int aoff = lds_byte(wr * 64 + fr, fq * 8), boff = lds_byte(wc * 32 + fr, fq * 8);
#define PG8_SA(b, h) (((b) * 2 + (h)) * HTB)
#define PG8_SB(b, h) ((4 + (b) * 2 + (h)) * HTB)
#define PG8_STAGE(bufoff, gbase, voff) do { _Pragma("unroll") for (int _i = 0; _i < 2; ++_i) \
        __builtin_amdgcn_global_load_lds((const unsigned*)((const char*)(gbase) + (voff)[_i]), (LAS unsigned*)(lds + (bufoff) + ldsw + _i * 8192), 16, 0, 0); } while (0)
#define PG8_STAGE_A(bufoff, gbase, h) do { if constexpr (GATHER) { if ((h) == 0) PG8_STAGE(bufoff, gbase, voA0); else PG8_STAGE(bufoff, gbase, voA1); } \
        else { PG8_STAGE(bufoff, (gbase) + ((h) ? hstepA : 0), voffA); } } while (0)
#define PG8_LDA(dst, b, h) do { _Pragma("unroll") for (int m = 0; m < 4; ++m) _Pragma("unroll") for (int k = 0; k < 2; ++k) dst[m][k] = *(const LAS bf16x8*)(lds + PG8_SA(b, h) + aoff + m * 2048 + k * 1024); } while (0)
#define PG8_LDB(dst, b, h) do { _Pragma("unroll") for (int n = 0; n < 2; ++n) _Pragma("unroll") for (int k = 0; k < 2; ++k) dst[n][k] = *(const LAS bf16x8*)(lds + PG8_SB(b, h) + boff + n * 2048 + k * 1024); } while (0)
#define PG8_MMA(ai, bj, At, Bt) do { __builtin_amdgcn_s_setprio(1); _Pragma("unroll") for (int m = 0; m < 4; ++m) _Pragma("unroll") for (int n = 0; n < 2; ++n) _Pragma("unroll") for (int k = 0; k < 2; ++k) \
        acc[ai][bj][m][n] = __builtin_amdgcn_mfma_f32_16x16x32_bf16(Bt[n][k], At[m][k], acc[ai][bj][m][n], 0, 0, 0); __builtin_amdgcn_s_setprio(0); } while (0)
#define PG8_WAIT_V(n) asm volatile("s_waitcnt vmcnt(" #n ")" ::: "memory")
#define PG8_WAIT_L(n) asm volatile("s_waitcnt lgkmcnt(" #n ")" ::: "memory")
#define PG8_BAR __builtin_amdgcn_s_barrier()
#define PG8_SCHED __builtin_amdgcn_sched_barrier(0)
    Unit cur, nxt; int ui = 0;
    if (!S.next(0, cur)) return;
    f32x4 acc[2][2][4][2];
#pragma unroll
    for (int a = 0; a < 2; ++a)
#pragma unroll
        for (int b = 0; b < 2; ++b)
#pragma unroll
            for (int m = 0; m < 4; ++m)
#pragma unroll
                for (int n = 0; n < 2; ++n) acc[a][b][m][n] = (f32x4){0.f, 0.f, 0.f, 0.f};
    bf16x8 At[4][2], B0[2][2], B1[2][2];
    const char* cA = cur.a; const char* cB = cur.b;
    if constexpr (GATHER) {
        S.fill_table(cur, 0, tid); asm volatile("s_waitcnt vmcnt(0)" ::: "memory"); __builtin_amdgcn_s_barrier(); asm volatile("" ::: "memory");
        S.load_offsets(cur, 0, gR, gC2, voA0, voA1);
    }
    if constexpr (SP2) {
        PG8_STAGE(PG8_SB(0, 0), cB, voffB); PG8_STAGE(PG8_SB(0, 1), cB + hstepB, voffB); PG8_STAGE_A(PG8_SA(0, 0), cA, 0); PG8_STAGE_A(PG8_SA(0, 1), cA, 1);
        if (wr == 1) PG8_BAR;
        PG8_WAIT_V(2); PG8_BAR;
        PG8_STAGE(PG8_SB(1, 0), cB + kstep, voffB); PG8_STAGE_A(PG8_SA(1, 0), cA + kstep, 0); PG8_STAGE(PG8_SB(1, 1), cB + hstepB + kstep, voffB);
        PG8_WAIT_V(6); PG8_BAR;
    } else {
        PG8_STAGE(PG8_SB(0, 0), cB, voffB); PG8_STAGE_A(PG8_SA(0, 0), cA, 0); PG8_STAGE(PG8_SB(0, 1), cB + hstepB, voffB); PG8_STAGE_A(PG8_SA(0, 1), cA, 1);
        if (wr == 1) PG8_BAR;
        PG8_WAIT_V(4); PG8_BAR;
        PG8_STAGE(PG8_SB(1, 0), cB + kstep, voffB); PG8_STAGE_A(PG8_SA(1, 0), cA + kstep, 0); PG8_STAGE(PG8_SB(1, 1), cB + hstepB + kstep, voffB);
        PG8_WAIT_V(6); PG8_BAR;
    }
    for (;;) {
        const bool has_next = S.next(ui + 1, nxt);
        const char* nA = has_next ? nxt.a : cA; const char* nB = has_next ? nxt.b : cB;
        if constexpr (GATHER) { if (has_next) S.fill_table(nxt, (ui + 1) & 1, tid); }
        const int nt = VARNT ? cur.nt : nt_c;
        for (int t = 0; t < nt; t += 2) {
            const bool last = (t == nt - 2);
            const char* a1 = cA + (size_t)(t + 1) * kstep;
            const char* a2 = last ? nA : cA + (size_t)(t + 2) * kstep; const char* b2 = last ? nB : cB + (size_t)(t + 2) * kstep;
            const char* a3 = a2 + kstep; const char* b3 = b2 + kstep;
            if constexpr (SP2) {
            PG8_LDB(B0, 0, 0); PG8_LDB(B1, 0, 1); PG8_SCHED; PG8_LDA(At, 0, 0); PG8_STAGE_A(PG8_SA(1, 1), a1, 1);
            PG8_WAIT_V(8); PG8_WAIT_L(0); PG8_BAR; PG8_MMA(0, 0, At, B0); PG8_MMA(0, 1, At, B1); PG8_BAR; PG8_SCHED;
            PG8_LDA(At, 0, 1);
            if constexpr (GATHER) { if (last && has_next) S.load_offsets(nxt, (ui + 1) & 1, gR, gC2, voA0, voA1); }
            PG8_STAGE(PG8_SB(0, 0), b2, voffB); PG8_STAGE(PG8_SB(0, 1), b2 + hstepB, voffB); PG8_STAGE_A(PG8_SA(0, 0), a2, 0);
            PG8_WAIT_V(8); PG8_WAIT_L(0); PG8_BAR; PG8_MMA(1, 0, At, B0); PG8_MMA(1, 1, At, B1); PG8_BAR; PG8_SCHED;
            PG8_LDB(B0, 1, 0); PG8_LDB(B1, 1, 1); PG8_SCHED; PG8_LDA(At, 1, 0); PG8_STAGE_A(PG8_SA(0, 1), a2, 1);
            PG8_WAIT_V(8); PG8_WAIT_L(0); PG8_BAR; PG8_MMA(0, 0, At, B0); PG8_MMA(0, 1, At, B1); PG8_BAR; PG8_SCHED;
            PG8_LDA(At, 1, 1); PG8_STAGE(PG8_SB(1, 0), b3, voffB); PG8_STAGE(PG8_SB(1, 1), b3 + hstepB, voffB); PG8_STAGE_A(PG8_SA(1, 0), a3, 0);
            PG8_WAIT_V(8); PG8_WAIT_L(0); PG8_BAR; PG8_MMA(1, 0, At, B0); PG8_MMA(1, 1, At, B1); PG8_BAR; PG8_SCHED;
            } else {
            PG8_LDB(B0, 0, 0); PG8_SCHED; PG8_LDA(At, 0, 0); PG8_STAGE_A(PG8_SA(1, 1), a1, 1);
            PG8_WAIT_L(8); PG8_BAR; PG8_WAIT_L(0); PG8_MMA(0, 0, At, B0); PG8_BAR; PG8_SCHED;
            PG8_LDB(B1, 0, 1); PG8_STAGE(PG8_SB(0, 0), b2, voffB);
            PG8_BAR; PG8_WAIT_L(0); PG8_MMA(0, 1, At, B1); PG8_BAR;
            PG8_LDA(At, 0, 1); PG8_STAGE_A(PG8_SA(0, 0), a2, 0);
            PG8_BAR; PG8_WAIT_L(0); PG8_MMA(1, 0, At, B0); PG8_BAR; PG8_SCHED;
            PG8_STAGE(PG8_SB(0, 1), b2 + hstepB, voffB);
            PG8_WAIT_V(6); PG8_BAR; PG8_MMA(1, 1, At, B1); PG8_BAR;
            PG8_LDB(B0, 1, 0); PG8_SCHED; PG8_LDA(At, 1, 0); PG8_STAGE_A(PG8_SA(0, 1), a2, 1);
            PG8_WAIT_L(8); PG8_BAR; PG8_WAIT_L(0); PG8_MMA(0, 0, At, B0); PG8_BAR; PG8_SCHED;
            PG8_LDB(B1, 1, 1); PG8_STAGE(PG8_SB(1, 0), b3, voffB);
            PG8_BAR; PG8_WAIT_L(0); PG8_MMA(0, 1, At, B1); PG8_BAR;
            PG8_LDA(At, 1, 1); PG8_STAGE_A(PG8_SA(1, 0), a3, 0);
            PG8_BAR; PG8_WAIT_L(0); PG8_MMA(1, 0, At, B0); PG8_BAR; PG8_SCHED;
            PG8_STAGE(PG8_SB(1, 1), b3 + hstepB, voffB);
            PG8_WAIT_V(6); PG8_BAR; PG8_MMA(1, 1, At, B1); PG8_BAR;
            }
        }
        if constexpr (ALIGN_EPI) { if (wr == 0) PG8_BAR; }
        E(acc, cur, wr, wc, fr, fq);
        if (REP_EPI > 1 && !VARNT) { for (int _r = 1; _r < REP_EPI; ++_r) E(acc, cur, wr, wc, fr, fq); }
        if (!has_next) break;
        if (!(VARNT && cur.cont))
#pragma unroll
        for (int a = 0; a < 2; ++a)
#pragma unroll
            for (int b = 0; b < 2; ++b)
#pragma unroll
                for (int m = 0; m < 4; ++m)
#pragma unroll
                    for (int n = 0; n < 2; ++n) acc[a][b][m][n] = (f32x4){0.f, 0.f, 0.f, 0.f};
        cur = nxt; cA = nA; cB = nB; ++ui;
        if constexpr (ALIGN_EPI) { if (wr == 1) PG8_BAR; }
    }
    PG8_WAIT_V(0);
    if constexpr (!ALIGN_EPI) { if (wr == 0) PG8_BAR; }
    PG8_BAR;
#undef PG8_SA
#undef PG8_SB
#undef PG8_STAGE
#undef PG8_LDA
#undef PG8_LDB
#undef PG8_MMA
#undef PG8_WAIT_V
#undef PG8_WAIT_L
#undef PG8_BAR
#undef PG8_SCHED
}
}
using pg8::Unit;

struct Args { const float* in[25]; float* out; unsigned char* ws; };
enum { I_X = 0, I_C, I_CTX, I_CCTX, I_WADA, I_BADA, I_NORM1, I_NORM2, I_WIN, I_RETDECAY, I_CONVW, I_POOLW, I_POOLSCALE, I_WRETOUT, I_WCONVOUT, I_WPOOLOUT, I_WO,
       I_WRG, I_BRG, I_WRE, I_BRE, I_W1, I_W3, I_W2, I_FINALNORM };

struct KArgs {
    __device__ __forceinline__ const char __attribute__((address_space(4)))* base() const { const char __attribute__((address_space(4)))* kp = (const char __attribute__((address_space(4)))*)__builtin_amdgcn_kernarg_segment_ptr(); asm volatile("" : "+s"(kp)); return kp; }
    __device__ __forceinline__ const float* in(int i) const { return *(const float* const __attribute__((address_space(4)))*)(base() + 8 * i); }
    __device__ __forceinline__ float* out() const { return *(float* const __attribute__((address_space(4)))*)(base() + 200); }
    __device__ __forceinline__ unsigned char* wsp() const { return *(unsigned char* const __attribute__((address_space(4)))*)(base() + 208); }
};
struct InProxy { __device__ __forceinline__ const float* operator[](int i) const { return KArgs().in(i); } };
struct DArgs { InProxy in; float* out; unsigned char* ws; };
__device__ __forceinline__ bf16_t* xrow_ptr(const DArgs& a, int row) { return (bf16_t*)(a.ws + WS_X) + (size_t)row * D; }

__device__ __forceinline__ void p0_mod(const DArgs& a, LAS unsigned char* lds, int tid, int wid, int lane) {
    LAS float* s = (LAS float*)lds;
    LAS float* red = (LAS float*)(lds + 17 * 1024 * 4);
    const float* c = a.in[I_C]; const float* cc = a.in[I_CCTX];
    for (int i = tid; i < 17 * 1024; i += 512) { const int r = i >> 10, k = i & 1023; const float v = r < 16 ? c[r * 1024 + k] : cc[k]; s[i] = silu_f(v); }
    __syncthreads();
    float* MOD = (float*)(a.ws + WS_MOD);
    for (int it = blockIdx.x; it < DEPTH * 96; it += gridDim.x) {
        const int l = it / 96, nb = it % 96, n = nb * 64 + lane;
        const float* W = a.in[I_WADA] + (size_t)l * D * NMOD + n;
        float acc[17];
#pragma unroll
        for (int r = 0; r < 17; ++r) acc[r] = 0.f;
        for (int k4 = 0; k4 < 32; ++k4) {
            const int k = wid * 128 + k4 * 4;
            const float w0 = W[(size_t)k * NMOD], w1 = W[(size_t)(k + 1) * NMOD], w2 = W[(size_t)(k + 2) * NMOD], w3 = W[(size_t)(k + 3) * NMOD];
#pragma unroll
            for (int r = 0; r < 17; ++r) { const f32x4 sv = *(const LAS f32x4*)(s + r * 1024 + k); acc[r] += sv[0] * w0 + sv[1] * w1 + sv[2] * w2 + sv[3] * w3; }
        }
#pragma unroll
        for (int r = 0; r < 17; ++r) red[(wid * 17 + r) * 64 + lane] = acc[r];
        __syncthreads();
        for (int i = tid; i < 17 * 64; i += 512) { const int r = i >> 6, nn = i & 63; float v = 0.f;
#pragma unroll
            for (int w = 0; w < 8; ++w) v += red[(w * 17 + r) * 64 + nn];
            MOD[((size_t)l * 17 + r) * NMOD + nb * 64 + nn] = v + a.in[I_BADA][(size_t)l * NMOD + nb * 64 + nn]; }
        __syncthreads();
    }
    if (blockIdx.x == gridDim.x - 1) {
        float* TAB = (float*)(a.ws + WS_TAB);
        if (tid < 32) { const float x = a.in[I_RETDECAY][tid]; TAB[tid] = -log1pf(expf(-x)) * 1.4426950408889634f; }
        for (int i = tid; i < 2048; i += 512) { const int v = i >> 5, f = i & 31; const float inv = powf(10000.0f, -(float)f / 32.0f); float sn, cs; sincosf((float)v * inv, &sn, &cs);
            TAB[32 + i] = cs; TAB[32 + 2048 + i] = sn; }
    }
}

template <class F>
__device__ __forceinline__ void cvt_item(const float* W, int N, int k0, int n0, float scale, LAS float* scr, int lane, const F& dstrow) {
    const int kk0 = lane >> 3, nq = lane & 7;
    f32x4 v[8];
#pragma unroll
    for (int i = 0; i < 8; ++i) v[i] = *(const f32x4*)(W + (size_t)(k0 + kk0 + 8 * i) * N + n0 + 4 * nq);
#pragma unroll
    for (int i = 0; i < 8; ++i) { LAS float* d = scr + (kk0 + 8 * i) * 33 + 4 * nq; d[0] = v[i][0]; d[1] = v[i][1]; d[2] = v[i][2]; d[3] = v[i][3]; }
    LDS_WAIT(); asm volatile("" ::: "memory");
    const int c = lane & 7;
#pragma unroll
    for (int j = 0; j < 4; ++j) { const int n = (lane >> 3) + 8 * j; const LAS float* sp = scr + (8 * c) * 33 + n;
        u32x4 o; o.x = cvt_pk_bf16(sp[0 * 33] * scale, sp[1 * 33] * scale); o.y = cvt_pk_bf16(sp[2 * 33] * scale, sp[3 * 33] * scale);
        o.z = cvt_pk_bf16(sp[4 * 33] * scale, sp[5 * 33] * scale); o.w = cvt_pk_bf16(sp[6 * 33] * scale, sp[7 * 33] * scale);
        *(u32x4*)(dstrow(n0 + n) + k0 + 8 * c) = o; }
    LDS_WAIT(); asm volatile("" ::: "memory");
}
__device__ __forceinline__ int win_row(int n) {
    if (n < 1024) { const int sec = n >> 9, c = n & 511, head = c >> 7, d = c & 127, half = d >> 6, idx = d & 63;
        return sec * 512 + (head >> 1) * 256 + half * 128 + (head & 1) * 64 + idx; }
    if (n >= 3584 && n < 4608) { const int isx = n >= 4096, i = isx ? n - 4096 : n - 3584; return 3584 + (i >> 7) * 256 + isx * 128 + (i & 127); }
    return n;
}
__device__ __forceinline__ void convert_weights(const DArgs& a, int l, LAS unsigned char* lds, int wid, int lane) {
    LAS float* scr = (LAS float*)(lds + wid * 8448);
    const int gw = blockIdx.x * 8 + wid, NGW = gridDim.x * 8;
    bf16_t* WIN = (bf16_t*)(a.ws + WS_WIN); bf16_t* WRET = (bf16_t*)(a.ws + WS_WRET); bf16_t* WCONV = (bf16_t*)(a.ws + WS_WCONV); bf16_t* WO = (bf16_t*)(a.ws + WS_WO);
    bf16_t* W13 = (bf16_t*)(a.ws + WS_W13); bf16_t* W2 = (bf16_t*)(a.ws + WS_W2); bf16_t* WPOOL = (bf16_t*)(a.ws + WS_WPOOL);
    constexpr int I0 = 16 * 256, I1 = 16 * 32, I2 = 8 * 32, I3 = 16 * 32, I4 = 16 * 256, I5 = 16 * 256, I6 = 16 * 256, I7 = 512;
    constexpr int NIT = I0 + I1 + I2 + I3 + I4 + I5 + I6 + I7;
    for (int it0 = gw; it0 < NIT; it0 += NGW) {
        int r = __builtin_amdgcn_readfirstlane(it0);
        if (r < I0) { const int kb = r / 256, nb = r % 256, n0 = nb * 32; const float sc = (n0 >= 512 && n0 < 1024) ? 0.08838834764831845f : 1.0f;
            cvt_item(a.in[I_WIN] + (size_t)l * D * 8192, 8192, kb * 64, n0, sc, scr, lane, [&](int n) { return WIN + (size_t)win_row(n) * 1024; }); continue; } r -= I0;
        if (r < I1) { const int kb = r / 32, nb = r % 32; cvt_item(a.in[I_WRETOUT] + (size_t)l * 1024 * 1024, 1024, kb * 64, nb * 32, 1.f, scr, lane, [&](int n) { return WRET + (size_t)n * 1024; }); continue; } r -= I1;
        if (r < I2) { const int kb = r / 32, nb = r % 32; cvt_item(a.in[I_WCONVOUT] + (size_t)l * 512 * 1024, 1024, kb * 64, nb * 32, 1.f, scr, lane, [&](int n) { return WCONV + (size_t)n * 1024; }); continue; } r -= I2;
        if (r < I3) { const int kb = r / 32, nb = r % 32; cvt_item(a.in[I_WO] + (size_t)l * 1024 * 1024, 1024, kb * 64, nb * 32, 1.f, scr, lane, [&](int n) { return WO + (size_t)n * 1024; }); continue; } r -= I3;
        if (r < I4 + I5) { const int is3 = r >= I4; if (is3) r -= I4; const int e = r / 256, q = r % 256, kb = q / 16, nb = q % 16;
            const float* src = a.in[is3 ? I_W3 : I_W1] + ((size_t)l * 16 + e) * 1024 * 512;
            cvt_item(src, 512, kb * 64, nb * 32, 1.f, scr, lane, [&](int n) { return W13 + ((size_t)e * 1024 + (n >> 7) * 256 + is3 * 128 + (n & 127)) * 1024; }); continue; } r -= I4 + I5;
        if (r < I6) { const int e = r / 256, q = r % 256, kb = q / 32, nb = q % 32;
            cvt_item(a.in[I_W2] + ((size_t)l * 16 + e) * 512 * 1024, 1024, kb * 64, nb * 32, 1.f, scr, lane, [&](int n) { return W2 + ((size_t)e * 1024 + n) * 512; }); continue; } r -= I6;
        {
            const int g = r / 128, q = r % 128, cb = q / 16, nb = q % 16, n = nb * 64 + lane;
            const float* pw = a.in[I_POOLW] + ((size_t)l * 4 + g) * 128 * 128 + (size_t)cb * 16 * 128;
            const float* sc = a.in[I_POOLSCALE] + (size_t)l * 512 + g * 128;
            const float* wpo = a.in[I_WPOOLOUT] + ((size_t)l * 512 + g * 128) * 1024 + n;
            float acc[16];
#pragma unroll
            for (int cc = 0; cc < 16; ++cc) acc[cc] = 0.f;
            for (int d = 0; d < 128; ++d) { const float w = wpo[(size_t)d * 1024] * sc[d];
#pragma unroll
                for (int cc = 0; cc < 16; ++cc) acc[cc] += pw[cc * 128 + d] * w; }
            u32x4 o0, o1; o0.x = cvt_pk_bf16(acc[0], acc[1]); o0.y = cvt_pk_bf16(acc[2], acc[3]); o0.z = cvt_pk_bf16(acc[4], acc[5]); o0.w = cvt_pk_bf16(acc[6], acc[7]);
            o1.x = cvt_pk_bf16(acc[8], acc[9]); o1.y = cvt_pk_bf16(acc[10], acc[11]); o1.z = cvt_pk_bf16(acc[12], acc[13]); o1.w = cvt_pk_bf16(acc[14], acc[15]);
            bf16_t* dst = WCONV + (size_t)n * 1024 + 512 + g * 128 + cb * 16; *(u32x4*)dst = o0; *(u32x4*)(dst + 8) = o1;
        }
    }
}

template <int MODE>
__device__ __forceinline__ void phase_n1(const DArgs& a, int l, int wid, int lane) {
    const int gw = blockIdx.x * 8 + wid, NGW = gridDim.x * 8;
    const float* MOD = (const float*)(a.ws + WS_MOD);
    const float* nw = a.in[I_NORM1] + (size_t)l * D;
    bf16_t* H = (bf16_t*)(a.ws + WS_H);
    f32x4 px[4], pg[4], pg1[4]; u32x2 py0[4], py1[4], pya[4], pxb[4];
    const int* SLOTOF = (const int*)(a.ws + WS_SLOTOF); const float* ROUTEC = (const float*)(a.ws + WS_ROUTEC); const bf16_t* YS = (const bf16_t*)(a.ws + WS_YS);
    int sl0 = 0, sl1 = 0; float cw0 = 0.f, cw1 = 0.f, cc0 = 0.f, cc1 = 0.f;
#define N1_SLOTS(rw) do { if (MODE != 0) { sl0 = SLOTOF[2 * (size_t)(rw)]; sl1 = SLOTOF[2 * (size_t)(rw) + 1]; cw0 = ROUTEC[2 * (size_t)(rw)]; cw1 = ROUTEC[2 * (size_t)(rw) + 1]; } } while (0)
#define N1_PRELOAD(rw) do { const int _b = (rw) / TPB, _r = (rw) - _b * TPB, _m = _r < CL ? 16 : _b; \
        if (MODE == 0) { const float* _src = _r < CL ? a.in[I_CTX] + (size_t)(_b * CL + _r) * D : a.in[I_X] + (size_t)(_b * SEQ + (_r - CL)) * D; \
            _Pragma("unroll") for (int j = 0; j < 4; ++j) px[j] = *(const f32x4*)(_src + 4 * lane + 256 * j); } \
        else { const bf16_t* _xp = xrow_ptr(a, (rw)); const float* _g = MOD + ((size_t)(l - 1) * 17 + _m) * NMOD + 5 * D; \
            const bf16_t* _y0 = YS + (size_t)sl0 * D; const bf16_t* _y1 = YS + (size_t)sl1 * D; cc0 = cw0; cc1 = cw1; \
            _Pragma("unroll") for (int j = 0; j < 4; ++j) { const int c = 4 * lane + 256 * j; pxb[j] = *(const u32x2*)(_xp + c); pg[j] = *(const f32x4*)(_g + c); pg1[j] = *(const f32x4*)(_g - 3 * D + c); py0[j] = *(const u32x2*)(_y0 + c); py1[j] = *(const u32x2*)(_y1 + c); \
                pya[j] = *(const u32x2*)((const bf16_t*)(a.ws + WS_YATT) + (size_t)(rw) * D + c); } } } while (0)
    if (gw < T) { N1_SLOTS(gw); N1_PRELOAD(gw); if (gw + NGW < T) N1_SLOTS(gw + NGW); }
    for (int row = gw; row < T; row += NGW) {
        const int b = row / TPB, r = row - b * TPB, mrow = r < CL ? 16 : b;
        bf16_t* xp = xrow_ptr(a, row);
        f32x4 v[4];
        if (MODE == 0) {
#pragma unroll
            for (int j = 0; j < 4; ++j) v[j] = px[j];
        } else {
            const float c0 = cc0, c1 = cc1;
#pragma unroll
            for (int j = 0; j < 4; ++j) { const f32x4 g = pg[j], g1 = pg1[j]; const u32x2 p0 = py0[j], p1 = py1[j], pa = pya[j], xb = pxb[j]; f32x4 x = {bf_lo(xb.x), bf_hi(xb.x), bf_lo(xb.y), bf_hi(xb.y)};
                x[0] += g1[0] * bf_lo(pa.x); x[1] += g1[1] * bf_hi(pa.x); x[2] += g1[2] * bf_lo(pa.y); x[3] += g1[3] * bf_hi(pa.y);
                v[j][0] = x[0] + g[0] * (c0 * bf_lo(p0.x) + c1 * bf_lo(p1.x)); v[j][1] = x[1] + g[1] * (c0 * bf_hi(p0.x) + c1 * bf_hi(p1.x));
                v[j][2] = x[2] + g[2] * (c0 * bf_lo(p0.y) + c1 * bf_lo(p1.y)); v[j][3] = x[3] + g[3] * (c0 * bf_hi(p0.y) + c1 * bf_hi(p1.y)); }
        }
        if (row + NGW < T) { N1_PRELOAD(row + NGW); if (row + 2 * NGW < T) N1_SLOTS(row + 2 * NGW); }
        float ss = 0.f;
#pragma unroll
        for (int j = 0; j < 4; ++j) { u32x2 o; o.x = cvt_pk_bf16(v[j][0], v[j][1]); o.y = cvt_pk_bf16(v[j][2], v[j][3]); *(u32x2*)(xp + 4 * lane + 256 * j) = o; ss += (v[j][0] * v[j][0] + v[j][1] * v[j][1]) + (v[j][2] * v[j][2] + v[j][3] * v[j][3]); }
        const float rr = rsqrtf(wave_sum(ss) * (1.0f / D) + EPS);
        const float* sh = MOD + ((size_t)l * 17 + mrow) * NMOD; const float* sc = sh + D;
#pragma unroll
        for (int j = 0; j < 4; ++j) { const int c = 4 * lane + 256 * j; const f32x4 w = *(const f32x4*)(nw + c), s1 = *(const f32x4*)(sc + c), s0 = *(const f32x4*)(sh + c);
            f32x4 h; for (int q = 0; q < 4; ++q) h[q] = v[j][q] * rr * w[q] * (1.0f + s1[q]) + s0[q];
            u32x2 o; o.x = cvt_pk_bf16(h[0], h[1]); o.y = cvt_pk_bf16(h[2], h[3]); *(u32x2*)(H + (size_t)row * D + c) = o; }
    }
}

__device__ __forceinline__ void phase_n2(const DArgs& a, int l, LAS unsigned char* ldsb, int tid, int wid, int lane, const int skip, const bool dry = false) {
    const float* MOD = (const float*)(a.ws + WS_MOD);
    const float* nw = a.in[I_NORM2] + (size_t)l * D;
    bf16_t* H = (bf16_t*)(a.ws + WS_H);
    const bf16_t* YATT = (const bf16_t*)(a.ws + WS_YATT);
    const float* wrg = a.in[I_WRG] + (size_t)l * D * 4; const float* wre = a.in[I_WRE] + (size_t)l * D * 16;
    const float* brg = a.in[I_BRG] + l * 4; const float* bre = a.in[I_BRE] + l * 16;
    float* ROUTEC = (float*)(a.ws + WS_ROUTEC); int* LIST = (int*)(a.ws + WS_LIST);
    unsigned* gcnt = (unsigned*)(a.ws + WS_CTL) + CW_CNT + 64 * l;
    LAS int* re = (LAS int*)(ldsb + LC_RE); LAS int* lcnt = (LAS int*)(ldsb + LC_LCNT);
    const int rpw = (T + (int)gridDim.x - 1) / (int)gridDim.x, row0 = blockIdx.x * rpw, row1 = (row0 + rpw < T) ? row0 + rpw : T;
    LAS float* wl = (LAS float*)ldsb;
    for (int i = tid; i < 1024 * 4; i += 512) { const int c = i >> 2, z = i & 3; wl[z * 1024 + c] = wrg[i]; }
    for (int i = tid; i < 1024 * 16; i += 512) { const int c = i >> 4, z = i & 15; wl[(4 + z) * 1024 + c] = wre[i]; }
    if (tid < 48) lcnt[tid] = 0;
    __syncthreads();
    f32x4 pg[2][4]; u32x2 pp[2][4], px[2][4];
    int ln = lane;
#define N2_PRELOAD(s_, rw) do { const int _b = (rw) / TPB, _r = (rw) - _b * TPB, _m = _r < CL ? 16 : _b; const bf16_t* _xp = xrow_ptr(a, (rw)); const float* _g = MOD + ((size_t)l * 17 + _m) * NMOD + 2 * D; \
        _Pragma("unroll") for (int j = 0; j < 4; ++j) { const int c = 4 * ln + 256 * j; px[s_][j] = *(const u32x2*)(_xp + c); pg[s_][j] = *(const f32x4*)(_g + c); pp[s_][j] = *(const u32x2*)(YATT + (size_t)(rw) * D + c); } } while (0)
    for (int row = row0 + wid; row < row1; row += 16) {
        asm volatile("" : "+v"(ln));
        const int rws[2] = {row, row + 8 < row1 ? row + 8 : row};
        N2_PRELOAD(0, rws[0]); N2_PRELOAD(1, rws[1]);
        f32x4 v[2][4];
        const float gs = dry ? 0.f : 1.f;
#pragma unroll
        for (int s2 = 0; s2 < 2; ++s2)
#pragma unroll
            for (int j = 0; j < 4; ++j) { const u32x2 xb = px[s2][j]; const f32x4 x = {bf_lo(xb.x), bf_hi(xb.x), bf_lo(xb.y), bf_hi(xb.y)}, g = pg[s2][j]; const u32x2 p = pp[s2][j];
                v[s2][j][0] = x[0] + gs * g[0] * bf_lo(p.x); v[s2][j][1] = x[1] + gs * g[1] * bf_hi(p.x); v[s2][j][2] = x[2] + gs * g[2] * bf_lo(p.y); v[s2][j][3] = x[3] + gs * g[3] * bf_hi(p.y); }
        bool act[2]; int mrow[2];
#pragma unroll
        for (int s2 = 0; s2 < 2; ++s2) { const int rw = rws[s2], b = rw / TPB, r = rw - b * TPB; mrow[s2] = r < CL ? 16 : b; const bool present = (s2 == 0) || (row + 8 < row1);
            act[s2] = present && !(skip && r < CL);
            if (present && skip && r < CL && lane == 0) { re[rw - row0] = -1; re[160 + rw - row0] = -1; } }
        if (!act[0] && !act[1]) continue;
        float rr[2];
#pragma unroll
        for (int s2 = 0; s2 < 2; ++s2) { float ss = 0.f;
#pragma unroll
            for (int j = 0; j < 4; ++j) ss += (v[s2][j][0] * v[s2][j][0] + v[s2][j][1] * v[s2][j][1]) + (v[s2][j][2] * v[s2][j][2] + v[s2][j][3] * v[s2][j][3]);
            rr[s2] = rsqrtf(wave_sum(ss) * (1.0f / D) + EPS); }
        f32x2 lg[2][20];
#pragma unroll
        for (int s2 = 0; s2 < 2; ++s2)
#pragma unroll
            for (int q = 0; q < 20; ++q) lg[s2][q] = (f32x2){0.f, 0.f};
#pragma unroll
        for (int j = 0; j < 4; ++j) { const int c = 4 * ln + 256 * j; const f32x4 w = *(const f32x4*)(nw + c);
            f32x4 h[2];
#pragma unroll
            for (int s2 = 0; s2 < 2; ++s2) { const float* sh = MOD + ((size_t)l * 17 + mrow[s2]) * NMOD + 3 * D; const f32x4 s1 = *(const f32x4*)(sh + D + c), s0 = *(const f32x4*)(sh + c);
#pragma unroll
                for (int q = 0; q < 4; ++q) h[s2][q] = v[s2][j][q] * rr[s2] * w[q] * (1.0f + s1[q]) + s0[q];
                { u32x2 o; o.x = cvt_pk_bf16(h[s2][0], h[s2][1]); o.y = cvt_pk_bf16(h[s2][2], h[s2][3]); *(u32x2*)(H + (size_t)rws[s2] * D + c) = o; } }
#pragma unroll
            for (int z = 0; z < 20; ++z) { const f32x4 w4 = *(const LAS f32x4*)(wl + z * 1024 + c); const f32x2 wa2 = {w4[0], w4[1]}, wb2 = {w4[2], w4[3]};
                lg[0][z] += (f32x2){h[0][0], h[0][1]} * wa2; lg[0][z] += (f32x2){h[0][2], h[0][3]} * wb2; lg[1][z] += (f32x2){h[1][0], h[1][1]} * wa2; lg[1][z] += (f32x2){h[1][2], h[1][3]} * wb2;
                if ((z & 3) == 3) asm volatile("" : "+v"(lg[0][z - 3]), "+v"(lg[0][z - 2]), "+v"(lg[0][z - 1]), "+v"(lg[0][z]), "+v"(lg[1][z - 3]), "+v"(lg[1][z - 2]), "+v"(lg[1][z - 1]), "+v"(lg[1][z])); }
            asm volatile("" ::: "memory"); }
#define N2_ROUTE(s2) if (act[s2]) { \
            const int rw = rws[s2]; \
            float lgs[20]; \
            _Pragma("unroll") for (int k4 = 0; k4 < 5; ++k4) { const float u4 = wave_sum4(lg[s2][4 * k4][0] + lg[s2][4 * k4][1], lg[s2][4 * k4 + 1][0] + lg[s2][4 * k4 + 1][1], lg[s2][4 * k4 + 2][0] + lg[s2][4 * k4 + 2][1], lg[s2][4 * k4 + 3][0] + lg[s2][4 * k4 + 3][1]); \
                lgs[4 * k4] = lane_val(u4, 0); lgs[4 * k4 + 2] = lane_val(u4, 16); lgs[4 * k4 + 1] = lane_val(u4, 32); lgs[4 * k4 + 3] = lane_val(u4, 48); } \
            float g0 = lgs[0] + brg[0], g1 = lgs[1] + brg[1], g2 = lgs[2] + brg[2], g3 = lgs[3] + brg[3]; \
            int gi = 0; float gm = g0; if (g1 > gm) { gm = g1; gi = 1; } if (g2 > gm) { gm = g2; gi = 2; } if (g3 > gm) { gm = g3; gi = 3; } \
            const float gtop = 1.0f / (expf(g0 - gm) + expf(g1 - gm) + expf(g2 - gm) + expf(g3 - gm)); \
            float e[4]; \
            _Pragma("unroll") \
            for (int i = 0; i < 4; ++i) { const float v0 = lgs[4 + i] + bre[i], v1 = lgs[8 + i] + bre[4 + i], v2 = lgs[12 + i] + bre[8 + i], v3 = lgs[16 + i] + bre[12 + i]; \
                e[i] = gi == 0 ? v0 : gi == 1 ? v1 : gi == 2 ? v2 : v3; } \
            int ia = 0; float va = e[0]; if (e[1] > va) { va = e[1]; ia = 1; } if (e[2] > va) { va = e[2]; ia = 2; } if (e[3] > va) { va = e[3]; ia = 3; } \
            int ib = -1; float vb = -3.0e38f; \
            _Pragma("unroll") \
            for (int i = 0; i < 4; ++i) if (i != ia && e[i] > vb) { vb = e[i]; ib = i; } \
            const float wa = 1.0f / (1.0f + expf(vb - va)), wb = 1.0f - wa; \
            if (lane == 0 && !dry) { const int e0 = gi * 4 + ia, e1 = gi * 4 + ib; const int li = rw - row0; re[li] = e0; re[160 + li] = e1; \
                ROUTEC[(size_t)rw * 2] = wa * gtop; ROUTEC[(size_t)rw * 2 + 1] = wb * gtop; \
                __hip_atomic_fetch_add(lcnt + e0, 1, __ATOMIC_RELAXED, __HIP_MEMORY_SCOPE_WORKGROUP); __hip_atomic_fetch_add(lcnt + e1, 1, __ATOMIC_RELAXED, __HIP_MEMORY_SCOPE_WORKGROUP); } \
        }
        N2_ROUTE(0) N2_ROUTE(1)
#undef N2_ROUTE
    }
#undef N2_PRELOAD
    __syncthreads();
    if (dry) return;
    if (tid < 16) { lcnt[16 + tid] = (int)__hip_atomic_fetch_add(gcnt + tid, (unsigned)lcnt[tid], __ATOMIC_RELAXED, __HIP_MEMORY_SCOPE_AGENT); }
    __syncthreads();
    const int nr = row1 - row0;
    if (tid < 2 * nr && re[(tid & 1) * 160 + (tid >> 1)] >= 0) { const int li = tid >> 1, rk = tid & 1; const int e = re[rk * 160 + li];
        const int p = lcnt[16 + e] + __hip_atomic_fetch_add(lcnt + 32 + e, 1, __ATOMIC_RELAXED, __HIP_MEMORY_SCOPE_WORKGROUP);
        LIST[(size_t)e * T + p] = ((row0 + li) << 1) | rk; }
    __syncthreads();
}

__device__ __forceinline__ void phase_final(const DArgs& a, int wid, int lane, float poison) {
    const int gw = blockIdx.x * 8 + wid, NGW = gridDim.x * 8;
    const float* MOD = (const float*)(a.ws + WS_MOD);
    const float* nw = a.in[I_FINALNORM];
    const int* SLOTOF = (const int*)(a.ws + WS_SLOTOF); const float* ROUTEC = (const float*)(a.ws + WS_ROUTEC); const bf16_t* YS = (const bf16_t*)(a.ws + WS_YS);
    int sl0 = 0, sl1 = 0; float cw0 = 0.f, cw1 = 0.f;
#define FN_ROW(q_) (((q_) / SEQ) * TPB + CL + ((q_) % SEQ))
    if (gw < NB * SEQ) { const int r0 = FN_ROW(gw); sl0 = SLOTOF[2 * (size_t)r0]; sl1 = SLOTOF[2 * (size_t)r0 + 1]; cw0 = ROUTEC[2 * (size_t)r0]; cw1 = ROUTEC[2 * (size_t)r0 + 1]; }
    for (int lr = gw; lr < NB * SEQ; lr += NGW) {
        const int b = lr / SEQ, row = b * TPB + CL + (lr - b * SEQ);
        const bf16_t* xp = xrow_ptr(a, row); float* op = a.out + (size_t)lr * D;
        const float* gt2 = MOD + ((size_t)(DEPTH - 1) * 17 + b) * NMOD + 5 * D; const float* gt1 = gt2 - 3 * D;
        const bf16_t* y0 = YS + (size_t)sl0 * D; const bf16_t* y1 = YS + (size_t)sl1 * D; const bf16_t* ya = (const bf16_t*)(a.ws + WS_YATT) + (size_t)row * D;
        const float c0 = cw0, c1 = cw1;
        if (lr + NGW < NB * SEQ) { const int rn = FN_ROW(lr + NGW); sl0 = SLOTOF[2 * (size_t)rn]; sl1 = SLOTOF[2 * (size_t)rn + 1]; cw0 = ROUTEC[2 * (size_t)rn]; cw1 = ROUTEC[2 * (size_t)rn + 1]; }
        f32x4 v[4]; float ss = 0.f;
#pragma unroll
        for (int j = 0; j < 4; ++j) { const int c = 4 * lane + 256 * j; const u32x2 xb = *(const u32x2*)(xp + c); f32x4 x = {bf_lo(xb.x), bf_hi(xb.x), bf_lo(xb.y), bf_hi(xb.y)}; const f32x4 g = *(const f32x4*)(gt2 + c), g1 = *(const f32x4*)(gt1 + c);
            const u32x2 p0 = *(const u32x2*)(y0 + c), p1 = *(const u32x2*)(y1 + c), pa = *(const u32x2*)(ya + c);
            x[0] += g1[0] * bf_lo(pa.x); x[1] += g1[1] * bf_hi(pa.x); x[2] += g1[2] * bf_lo(pa.y); x[3] += g1[3] * bf_hi(pa.y);
            v[j][0] = x[0] + g[0] * (c0 * bf_lo(p0.x) + c1 * bf_lo(p1.x)); v[j][1] = x[1] + g[1] * (c0 * bf_hi(p0.x) + c1 * bf_hi(p1.x));
            v[j][2] = x[2] + g[2] * (c0 * bf_lo(p0.y) + c1 * bf_lo(p1.y)); v[j][3] = x[3] + g[3] * (c0 * bf_hi(p0.y) + c1 * bf_hi(p1.y));
            ss += (v[j][0] * v[j][0] + v[j][1] * v[j][1]) + (v[j][2] * v[j][2] + v[j][3] * v[j][3]); }
        const float rr = rsqrtf(wave_sum(ss) * (1.0f / D) + EPS);
#pragma unroll
        for (int j = 0; j < 4; ++j) { const int c = 4 * lane + 256 * j; const f32x4 w = *(const f32x4*)(nw + c);
            f32x4 o; for (int q = 0; q < 4; ++q) o[q] = poison != 0.f ? poison : v[j][q] * rr * w[q];
            *(f32x4*)(op + c) = o; }
    }
}

struct SchedInproj {
    const char* H; const char* W; int G, w, nA, skip;
    __device__ __forceinline__ bool next(int i, Unit& u) const {
        int L; if (i < 4) L = i * G + w; else { if (w < nA) return false; L = 4 * G + (i - 4) * (G - nA) + (w - nA); }
        const int nMn = skip ? 32 : 36;
        if (L < nMn * 28) { int pm, pi; pg8::tile_map(L, nMn, 28, pm, pi); if (skip) pm = (pm >> 3) * 9 + 1 + (pm & 7); const int wt = pi < 4 ? pi : pi + 4;
            u.a = H + (size_t)pm * 256 * 2048; u.b = W + (size_t)wt * 256 * 2048; u.pm = pm; u.pn = wt; u.kind = 0; u.nt = 16; u.cont = 0; return true; }
        L -= nMn * 28;
        if (L < 6 * 36) { int pi, pn; pg8::tile_map(L, 6, 36, pi, pn); const int wt = pi + 2;
            u.a = W + (size_t)wt * 256 * 2048; u.b = H + (size_t)pn * 256 * 2048; u.pm = wt; u.pn = pn; u.kind = 1; u.nt = 16; u.cont = 0; return true; }
        return false;
    }
};
struct EpiInproj {
    static constexpr bool PERM = true;
    unsigned char* ws; const float* lg2;
    const float* ropec; const float* ropes; bf16_t* gate;
    template <int ACT> __device__ __forceinline__ void plain(const f32x4 (&acc)[2][2][4][2], bf16_t* dst, int ld, int row0, int col0) const {
#pragma unroll
        for (int ai = 0; ai < 2; ++ai)
#pragma unroll
            for (int m = 0; m < 4; ++m) { bf16_t* rowp = dst + (size_t)(row0 + ai * 128 + m * 16) * ld + col0;
#pragma unroll
                for (int bj = 0; bj < 2; ++bj) { f32x4 v0 = acc[ai][bj][m][0], v1 = acc[ai][bj][m][1];
                    if (ACT == 1) { for (int q = 0; q < 4; ++q) { v0[q] = silu_f(v0[q]); v1[q] = silu_f(v1[q]); } }
                    if (ACT == 2) { for (int q = 0; q < 4; ++q) { v0[q] = sigmoid_f(v0[q]); v1[q] = sigmoid_f(v1[q]); } }
                    *(u32x4*)(rowp + bj * 128) = pack8(v0, v1); } }
    }
    __device__ __forceinline__ void operator()(const f32x4 (&acc)[2][2][4][2], const Unit& u, int wr, int wc, int fr, int fq) const {
        if (u.kind == 0) {
            const int wt = u.pn, row0 = u.pm * 256 + wr * 64 + fr, cl = wc * 32 + 8 * fq;
            if (wt < 4) {
                const int isk = wt >> 1, t = wt & 1, head = 2 * t + (wc >> 1), idx0 = 32 * (wc & 1) + 8 * fq;
                bf16_t* dA = (bf16_t*)(ws + (isk ? WS_KF : WS_QF));
#pragma unroll
                for (int ai = 0; ai < 2; ++ai)
#pragma unroll
                    for (int m = 0; m < 4; ++m) {
                        const int gr = row0 + ai * 128 + m * 16, r = gr % TPB;
                        f32x4 c0 = {1.f, 1.f, 1.f, 1.f}, c1 = c0, s0 = {0.f, 0.f, 0.f, 0.f}, s1 = s0;
                        if (r >= CL) { const int pos = r - CL, v = (wc & 1) ? (pos & 63) : (pos >> 6); const float* cp = ropec + v * 32 + 8 * fq; const float* sp = ropes + v * 32 + 8 * fq;
                            c0 = *(const f32x4*)cp; c1 = *(const f32x4*)(cp + 4); s0 = *(const f32x4*)sp; s1 = *(const f32x4*)(sp + 4); }
                        const f32x4 x10 = acc[ai][0][m][0], x11 = acc[ai][0][m][1], x20 = acc[ai][1][m][0], x21 = acc[ai][1][m][1];
                        const f32x4 o10 = x10 * c0 - x20 * s0, o11 = x11 * c1 - x21 * s1, o20 = x10 * s0 + x20 * c0, o21 = x11 * s1 + x21 * c1;
                        bf16_t* pa = dA + (size_t)gr * 512 + head * 128 + idx0;
                        *(u32x4*)pa = pack8(o10, o11); *(u32x4*)(pa + 64) = pack8(o20, o21);
                    }
            } else if (wt < 12) plain<1>(acc, (bf16_t*)(ws + WS_GS), 1024, row0, (wt - 8) * 256 + cl);
            else if (wt < 14) plain<0>(acc, (bf16_t*)(ws + WS_CB), 512, row0, (wt - 12) * 256 + cl);
            else if (wt < 18) { bf16_t* dst = (bf16_t*)(ws + WS_CU);
#pragma unroll
                for (int ai = 0; ai < 2; ++ai)
#pragma unroll
                    for (int m = 0; m < 4; ++m)
                        *(u32x4*)(dst + (size_t)(row0 + ai * 128 + m * 16) * 512 + (wt - 14) * 128 + cl) = pack8(acc[ai][0][m][0] * acc[ai][1][m][0], acc[ai][0][m][1] * acc[ai][1][m][1]);
            } else if (wt < 20) plain<0>(acc, (bf16_t*)(ws + WS_PI), 512, row0, (wt - 18) * 256 + cl);
            else {
                unsigned char* gp = (unsigned char*)gate + (size_t)((wt - 20) >> 2) * TG * 1024 + ((wt - 20) & 3) * 256 + (wc * 4 + fq) * 16;
#pragma unroll
                for (int ai = 0; ai < 2; ++ai)
#pragma unroll
                    for (int m = 0; m < 4; ++m) { u32x4 w;
#pragma unroll
                        for (int bj = 0; bj < 2; ++bj) { unsigned lo = 0u, hi = 0u;
#pragma unroll
                            for (int q = 0; q < 4; ++q) { lo |= (unsigned)(sigmoid_f(acc[ai][bj][m][0][q]) * 255.0f + 0.5f) << (8 * q); hi |= (unsigned)(sigmoid_f(acc[ai][bj][m][1][q]) * 255.0f + 0.5f) << (8 * q); }
                            if (bj == 0) { w.x = lo; w.y = hi; } else { w.z = lo; w.w = hi; } }
                        *(u32x4*)(gp + (size_t)(row0 + ai * 128 + m * 16) * 1024) = w; }
            }
        } else {
            const int wt = u.pm, tok0 = u.pn * 256 + wc * 32 + 8 * fq;
            if (wt < 4) {
                const int t = wt - 2, head = 2 * t + wr; const float lgf = lg2[head], lgb = lg2[4 + head];
                bf16_t* dF = (bf16_t*)(ws + WS_KTF); bf16_t* dB = (bf16_t*)(ws + WS_KTB);
#pragma unroll
                for (int m = 0; m < 4; ++m) { const int idx = 16 * m + fr;
#pragma unroll
                    for (int bj = 0; bj < 2; ++bj) { f32x4 o1[2], o2[2], sF[2], sB[2];
#pragma unroll
                        for (int n = 0; n < 2; ++n) { const int g0 = tok0 + bj * 128 + 4 * n, r0 = g0 % TPB; const f32x4 x1 = acc[0][bj][m][n], x2 = acc[1][bj][m][n];
                            f32x4 cs = {1.f, 1.f, 1.f, 1.f}, sn = {0.f, 0.f, 0.f, 0.f};
                            if (r0 >= CL) { const int pos = r0 - CL;
                                if (m < 2) { const float c = ropec[(pos >> 6) * 32 + idx], s = ropes[(pos >> 6) * 32 + idx]; cs = (f32x4){c, c, c, c}; sn = (f32x4){s, s, s, s}; }
                                else { const int v = pos & 63;
#pragma unroll
                                    for (int j = 0; j < 4; ++j) { cs[j] = ropec[(v + j) * 32 + idx - 32]; sn[j] = ropes[(v + j) * 32 + idx - 32]; } } }
                            o1[n] = x1 * cs - x2 * sn; o2[n] = x1 * sn + x2 * cs;
#pragma unroll
                            for (int j = 0; j < 4; ++j) { const float fi = (float)((g0 + j) & 127); sF[n][j] = __builtin_amdgcn_exp2f(-fi * lgf); sB[n][j] = __builtin_amdgcn_exp2f(fi * lgb); } }
                        const size_t r1 = (size_t)(head * 128 + idx) * TG + tok0 + bj * 128, r2 = r1 + (size_t)64 * TG;
                        *(u32x4*)(dF + r1) = pack8(o1[0] * sF[0], o1[1] * sF[1]); *(u32x4*)(dF + r2) = pack8(o2[0] * sF[0], o2[1] * sF[1]);
                        *(u32x4*)(dB + r1) = pack8(o1[0] * sB[0], o1[1] * sB[1]); *(u32x4*)(dB + r2) = pack8(o2[0] * sB[0], o2[1] * sB[1]);
                    } }
            } else {
                bf16_t* dst = (bf16_t*)(ws + WS_VT); const int e0 = (wt - 4) * 256 + wr * 64 + fr;
#pragma unroll
                for (int ai = 0; ai < 2; ++ai)
#pragma unroll
                    for (int m = 0; m < 4; ++m)
#pragma unroll
                        for (int bj = 0; bj < 2; ++bj) *(u32x4*)(dst + (size_t)(e0 + ai * 128 + m * 16) * TG + tok0 + bj * 128) = pack8(acc[ai][bj][m][0], acc[ai][bj][m][1]);
            }
        }
    }
};

struct SchedPlain {
    const char* A; const char* B; size_t astep, bstep; int nM, nN, G, c, skip;
    __device__ __forceinline__ bool next(int i, Unit& u) const {
        const int L = i * G + c; if (L >= nM * nN) return false;
        int pm, pn; pg8::tile_map(L, nM, nN, pm, pn); if (skip) pm = (pm >> 3) * 9 + 1 + (pm & 7);
        u.a = A + (size_t)pm * astep; u.b = B + (size_t)pn * bstep; u.pm = pm; u.pn = pn; u.kind = 0; u.nt = 0; u.cont = 0; return true;
    }
};
struct SchedG4 {
    const char* YRET; const char* YCP; const char* WRET; const char* WCP; int nM, G, c, skip;
    __device__ __forceinline__ bool next(int i, Unit& u) const {
        const int mac = i / 3, sub = i - mac * 3, L = mac * G + c; if (L >= nM * 4) return false;
        int pm, pn; pg8::tile_map(L, nM, 4, pm, pn); if (skip) pm = (pm >> 3) * 9 + 1 + (pm & 7);
        const size_t ao = (size_t)pm * 256 * 2048, bo = (size_t)pn * 256 * 2048;
        u.a = sub == 0 ? YRET + ao : YCP + ao + (sub == 2 ? 1024 : 0); u.b = sub == 0 ? WRET + bo : WCP + bo + (sub == 2 ? 1024 : 0);
        u.pm = pm; u.pn = pn; u.kind = sub; u.nt = sub == 0 ? 16 : 8; u.cont = sub != 2; return true;
    }
};
struct EpiG4 {
    static constexpr bool PERM = true;
    const unsigned char* gate;    bf16_t* merged;
    __device__ __forceinline__ void operator()(f32x4 (&acc)[2][2][4][2], const Unit& u, int wr, int wc, int fr, int fq) const {
        const int row0 = u.pm * 256 + wr * 64 + fr, col0 = u.pn * 256 + wc * 32 + 8 * fq, k = u.kind;
        const unsigned char* gk = gate + (size_t)k * TG * 1024 + u.pn * 256 + (wc * 4 + fq) * 16;
#pragma unroll
        for (int ai = 0; ai < 2; ++ai)
#pragma unroll
            for (int m = 0; m < 4; ++m) { const int row = row0 + ai * 128 + m * 16;
                const u32x4 g = *(const u32x4*)(gk + (size_t)row * 1024); u32x4 h = g; if (k < 2) h = *(const u32x4*)(gk + (size_t)TG * 1024 + (size_t)row * 1024);
#pragma unroll
                for (int bj = 0; bj < 2; ++bj) { const int col = col0 + bj * 128;
                    const unsigned g0 = bj ? g.z : g.x, g1 = bj ? g.w : g.y, h0 = bj ? h.z : h.x, h1 = bj ? h.w : h.y;
                    f32x4 v0 = acc[ai][bj][m][0], v1 = acc[ai][bj][m][1];
#pragma unroll
                    for (int q = 0; q < 4; ++q) {
                        const float n0 = fmaxf((float)((g0 >> (8 * q)) & 255u), 2.55e-16f), n1 = fmaxf((float)((g1 >> (8 * q)) & 255u), 2.55e-16f);
                        const float d0 = fmaxf((float)((h0 >> (8 * q)) & 255u), 2.55e-16f), d1 = fmaxf((float)((h1 >> (8 * q)) & 255u), 2.55e-16f);
                        v0[q] *= k < 2 ? n0 * __builtin_amdgcn_rcpf(d0) : n0 * (1.0f / 255.0f); v1[q] *= k < 2 ? n1 * __builtin_amdgcn_rcpf(d1) : n1 * (1.0f / 255.0f); }
                    if (k < 2) { acc[ai][bj][m][0] = v0; acc[ai][bj][m][1] = v1; }
                    else *(u32x4*)(merged + (size_t)row * 1024 + col) = pack8(v0, v1); } }
    }
};
struct EpiPlainBf16 {
    static constexpr bool PERM = true;
    bf16_t* O; int ld;
    __device__ __forceinline__ void operator()(const f32x4 (&acc)[2][2][4][2], const Unit& u, int wr, int wc, int fr, int fq) const {
        const int row0 = u.pm * 256 + wr * 64 + fr, col0 = u.pn * 256 + wc * 32 + 8 * fq;
#pragma unroll
        for (int ai = 0; ai < 2; ++ai)
#pragma unroll
            for (int m = 0; m < 4; ++m)
#pragma unroll
                for (int bj = 0; bj < 2; ++bj) *(u32x4*)(O + (size_t)(row0 + ai * 128 + m * 16) * ld + col0 + bj * 128) = pack8(acc[ai][bj][m][0], acc[ai][bj][m][1]);
    }
};

struct SchedMoe {
    const char* A; const char* W; size_t astep, wrow; const LAS int* tile_e; int ntiles, G, c;
    __device__ __forceinline__ bool next(int i, Unit& u) const {
        const int L = i * G + c; if (L >= ntiles * 4) return false;
        int tile, pn; pg8::tile_map(L, ntiles, 4, tile, pn); const int e = tile_e[tile];
        u.a = A + (size_t)tile * astep; u.b = W + ((size_t)e * 1024 + pn * 256) * wrow; u.pm = tile; u.pn = pn; u.kind = e; u.nt = 0; u.cont = 0; return true;
    }
};
struct SchedMoeG {
    const char* A; const char* W; const LAS int* tile_e; const LAS int* cnt; const LAS int* poff; const int* LIST; LAS int* tbl; int ntiles, G, c;
    __device__ __forceinline__ bool next(int i, Unit& u) const {
        const int L = i * G + c; if (L >= ntiles * 4) return false;
        int tile, pn; pg8::tile_map(L, ntiles, 4, tile, pn); const int e = tile_e[tile];
        u.a = A; u.b = W + ((size_t)e * 1024 + pn * 256) * 2048; u.pm = tile; u.pn = pn; u.kind = e; u.nt = 0; u.cont = 0; return true;
    }
    __device__ __forceinline__ void fill_table(const Unit& u, int buf, int tid) const {
        if (tid < 256) { const int e = u.kind; const int* src = LIST + (size_t)e * T + (u.pm * 256 - poff[e]) + tid;
            __builtin_amdgcn_global_load_lds((const unsigned*)src, (LAS unsigned*)(tbl + buf * 256 + (tid & ~63)), 4, 0, 0); }
    }
    __device__ __forceinline__ void load_offsets(const Unit& u, int buf, const int (&gR)[2], const int (&gC2)[2], unsigned (&vo0)[2], unsigned (&vo1)[2]) const {
        const int e = u.kind, pb = u.pm * 256 - poff[e], n = cnt[e];
#pragma unroll
        for (int i = 0; i < 2; ++i) { const int r0 = gR[i], r1 = 128 + gR[i]; const int e0 = tbl[buf * 256 + r0], e1 = tbl[buf * 256 + r1];
            vo0[i] = (unsigned)((pb + r0 < n) ? (e0 >> 1) : 0) * 2048u + (unsigned)gC2[i]; vo1[i] = (unsigned)((pb + r1 < n) ? (e1 >> 1) : 0) * 2048u + (unsigned)gC2[i]; }
    }
};
namespace pg8 { template <> struct sched_gather<SchedMoeG> { static constexpr bool value = true; }; }
struct EpiMoeUp {
    static constexpr bool PERM = true;
    bf16_t* ACT;
    __device__ __forceinline__ void operator()(const f32x4 (&acc)[2][2][4][2], const Unit& u, int wr, int wc, int fr, int fq) const {
        const int row0 = u.pm * 256 + wr * 64 + fr, col0 = u.pn * 128 + wc * 32 + 8 * fq;
#pragma unroll
        for (int ai = 0; ai < 2; ++ai)
#pragma unroll
            for (int m = 0; m < 4; ++m) { f32x4 v0, v1;
#pragma unroll
                for (int q = 0; q < 4; ++q) { v0[q] = silu_fast(acc[ai][0][m][0][q]) * acc[ai][1][m][0][q]; v1[q] = silu_fast(acc[ai][0][m][1][q]) * acc[ai][1][m][1][q]; }
                *(u32x4*)(ACT + (size_t)(row0 + ai * 128 + m * 16) * 512 + col0) = pack8(v0, v1); }
    }
};

template <int NROWS, bool PERMROWS>
__device__ __forceinline__ void dma_tile(LAS unsigned char* ldst, const char* gsrc, size_t row_stride, int tid) {
#pragma unroll
    for (int i = 0; i < NROWS * 16 / 512; ++i) {
        const int q = tid + 512 * i, row = q >> 4, cg = q & 15;
        const int srow = PERMROWS ? ((row & ~31) + pg8::perm32(row & 31)) : row;
        const char* src = gsrc + (size_t)srow * row_stride + ((cg ^ (row & 15)) << 4);
        __builtin_amdgcn_global_load_lds((const unsigned*)src, (LAS unsigned*)(ldst + ((tid & ~63) + 512 * i) * 16), 16, 0, 0);
    }
}
__device__ __forceinline__ bf16x8 lds_frag(const LAS unsigned char* base, int row, int gk) { return *(const LAS bf16x8*)(base + row * 256 + ((gk ^ (row & 15)) << 4)); }

#ifndef CP_DEFER_PCT
#define CP_DEFER_PCT 50
#endif
#ifndef CP_DEFER_PCT_LAST
#define CP_DEFER_PCT_LAST 10
#endif
constexpr int CP_TOTAL = TG * 16 + TG * 16;
constexpr int CP_DEFER_A = (CP_TOTAL / 100 * CP_DEFER_PCT) / 512 * 512, CP_DEFER_B = (CP_TOTAL / 100 * CP_DEFER_PCT_LAST) / 512 * 512;
#define CP_DEFER (skipctx ? CP_DEFER_B : CP_DEFER_A)
constexpr int NCHAIN = BG * 4 * 2 * 4;
template <int NROWS>
__device__ __forceinline__ void dma_tile128(LAS unsigned char* ldst, const char* gsrc, size_t row_stride, int tid) {
#pragma unroll
    for (int i = 0; i < NROWS * 8 / 512; ++i) {
        const int q = tid + 512 * i, row = q >> 3, cg = q & 7;
        const char* src = gsrc + (size_t)row * row_stride + ((cg ^ ((row >> 1) & 7)) << 4);
        __builtin_amdgcn_global_load_lds((const unsigned*)src, (LAS unsigned*)(ldst + ((tid & ~63) + 512 * i) * 16), 16, 0, 0);
    }
}
__device__ __forceinline__ bf16x8 lds_frag128(const LAS unsigned char* base, int row, int gk) { return *(const LAS bf16x8*)(base + row * 128 + ((gk ^ ((row >> 1) & 7)) << 4)); }

__device__ __forceinline__ void chain_unit(const DArgs& a, int unit, const float* lg2p, LAS unsigned char* lds, int tid, int wid, int lane) {
    const int eq = unit & 3, dir = (unit >> 2) & 1, h = (unit >> 3) & 3, bb = unit >> 5, fr = lane & 15, fq = lane >> 4;
    const char* VT = (const char*)(a.ws + WS_VT) + (size_t)(h * 256 + eq * 64) * TG * 2;
    const char* KT = (const char*)(a.ws + (dir ? WS_KTB : WS_KTF)) + (size_t)(h * 128) * TG * 2;
    bf16_t* ST = (bf16_t*)(a.ws + WS_STATES) + ((size_t)((bb * 4 + h) * 2 + dir) * NCH) * 256 * 128;
    const float dec = exp2f(128.0f * lg2p[dir * 4 + h]);
    f32x4 acc[4];
#pragma unroll
    for (int m = 0; m < 4; ++m) acc[m] = (f32x4){0.f, 0.f, 0.f, 0.f};
#define CH_ORDER(s) (dir == 0 ? (s) : ((s) < 2 ? 1 - (s) : 19 - (s)))
#define CH_LOAD(hs) do { const int _h = (hs) < 2 * NCH ? (hs) : 2 * NCH - 1; const int _c = CH_ORDER(_h >> 1); const size_t _tb = (size_t)(bb * TPB + _c * 128 + (_h & 1) * 64) * 2; \
        LAS unsigned char* _sl = lds + ((hs) % 5) * 24576; dma_tile128<64>(_sl, VT + _tb, (size_t)TG * 2, tid); dma_tile128<128>(_sl + 8192, KT + _tb, (size_t)TG * 2, tid); } while (0)
#define CH_MMA(hs) do { const LAS unsigned char* buf = lds + ((hs) % 5) * 24576; \
        _Pragma("unroll") for (int ks = 0; ks < 2; ++ks) { const bf16x8 kf = lds_frag128(buf + 8192, wid * 16 + fr, 4 * ks + fq); \
            _Pragma("unroll") for (int m = 0; m < 4; ++m) acc[m] = __builtin_amdgcn_mfma_f32_16x16x32_bf16(kf, lds_frag128(buf, 16 * m + fr, 4 * ks + fq), acc[m], 0, 0, 0); } } while (0)
#define CH_SYNC() do { asm volatile("s_waitcnt vmcnt(11)" ::: "memory"); LDS_WAIT(); __builtin_amdgcn_s_barrier(); asm volatile("" ::: "memory"); } while (0)
    CH_LOAD(0); CH_LOAD(1); CH_LOAD(2); CH_LOAD(3);
    asm volatile("s_waitcnt vmcnt(9)" ::: "memory"); LDS_WAIT(); __builtin_amdgcn_s_barrier(); asm volatile("" ::: "memory");
    for (int s = 0; s < NCH; ++s) {
        const int hs = 2 * s;
        if (s > 0) CH_SYNC();
        u32x2 pub[4];
#pragma unroll
        for (int m = 0; m < 4; ++m) { acc[m] = acc[m] * dec; pub[m].x = cvt_pk_bf16(acc[m][0], acc[m][1]); pub[m].y = cvt_pk_bf16(acc[m][2], acc[m][3]); }
        CH_LOAD(hs + 4);
        CH_MMA(hs);
        {
            const int _c = CH_ORDER(s); bf16_t* sp = ST + (size_t)_c * 256 * 128 + (size_t)(eq * 64 + 16 * (fq & 1) + fr) * 128 + wid * 16 + 8 * (fq >> 1);
#pragma unroll
            for (int mp = 0; mp < 2; ++mp) { unsigned ax = pub[2 * mp].x, ay = pub[2 * mp].y, bx = pub[2 * mp + 1].x, by = pub[2 * mp + 1].y;
                asm volatile("s_nop 1\n\tv_permlane16_swap_b32 %0, %1\n\tv_permlane16_swap_b32 %2, %3\n\ts_nop 1" : "+v"(ax), "+v"(bx), "+v"(ay), "+v"(by));
                const u32x4 w = {ax, ay, bx, by}; *(u32x4*)(sp + (size_t)mp * 32 * 128) = w; }
        }
        CH_SYNC();
        CH_MMA(hs + 1);
        CH_LOAD(hs + 5);
    }
    asm volatile("s_waitcnt vmcnt(0)" ::: "memory"); LDS_WAIT(); __builtin_amdgcn_s_barrier(); asm volatile("" ::: "memory");
#undef CH_ORDER
#undef CH_LOAD
#undef CH_MMA
#undef CH_SYNC
}
__device__ __forceinline__ void conv_pool(const DArgs& a, int l, int worker, int nworkers, int tid, const int skip, const int it0, const int it1) {
    const bf16_t* CU = (const bf16_t*)(a.ws + WS_CU); const bf16_t* CBp = (const bf16_t*)(a.ws + WS_CB); const bf16_t* PI = (const bf16_t*)(a.ws + WS_PI);
    bf16_t* YCONV = (bf16_t*)(a.ws + WS_YCONV); bf16_t* POOLED = (bf16_t*)(a.ws + WS_POOLED);
    const float* cw = a.in[I_CONVW] + (size_t)l * 3 * 512;
    const int nitem = TG * 16;
    for (int it = it0 + worker * 512 + tid; it < it1; it += nworkers * 512) {
        const int ispool = it >= nitem, q = ispool ? it - nitem : it;
        if (!ispool) {
            const int c0 = (q & 63) * 8, gr0 = (q >> 6) * 4;
            const int r = gr0 % TPB, lo = r < CL ? 0 : CL, hi = r < CL ? CL : TPB;
            if (skip && r < CL) continue;
            u32x4 u[6], bv[4];
            u[0] = (u32x4){0u, 0u, 0u, 0u}; u[5] = u[0];
            if (r > lo) u[0] = *(const u32x4*)(CU + (size_t)(gr0 - 1) * 512 + c0);
#pragma unroll
            for (int j = 0; j < 4; ++j) { u[1 + j] = *(const u32x4*)(CU + (size_t)(gr0 + j) * 512 + c0); bv[j] = *(const u32x4*)(CBp + (size_t)(gr0 + j) * 512 + c0); }
            if (r + 4 < hi) u[5] = *(const u32x4*)(CU + (size_t)(gr0 + 4) * 512 + c0);
            const f32x4 w00 = *(const f32x4*)(cw + c0), w01 = *(const f32x4*)(cw + c0 + 4), w10 = *(const f32x4*)(cw + 512 + c0), w11 = *(const f32x4*)(cw + 512 + c0 + 4),
                        w20 = *(const f32x4*)(cw + 1024 + c0), w21 = *(const f32x4*)(cw + 1024 + c0 + 4);
#pragma unroll
            for (int j = 0; j < 4; ++j) { const u32x4 u0 = u[j], u1 = u[j + 1], u2 = u[j + 2], b = bv[j]; f32x4 o0, o1;
                o0[0] = bf_lo(b.x) * (w00[0] * bf_lo(u0.x) + w10[0] * bf_lo(u1.x) + w20[0] * bf_lo(u2.x)); o0[1] = bf_hi(b.x) * (w00[1] * bf_hi(u0.x) + w10[1] * bf_hi(u1.x) + w20[1] * bf_hi(u2.x));
                o0[2] = bf_lo(b.y) * (w00[2] * bf_lo(u0.y) + w10[2] * bf_lo(u1.y) + w20[2] * bf_lo(u2.y)); o0[3] = bf_hi(b.y) * (w00[3] * bf_hi(u0.y) + w10[3] * bf_hi(u1.y) + w20[3] * bf_hi(u2.y));
                o1[0] = bf_lo(b.z) * (w01[0] * bf_lo(u0.z) + w11[0] * bf_lo(u1.z) + w21[0] * bf_lo(u2.z)); o1[1] = bf_hi(b.z) * (w01[1] * bf_hi(u0.z) + w11[1] * bf_hi(u1.z) + w21[1] * bf_hi(u2.z));
                o1[2] = bf_lo(b.w) * (w01[2] * bf_lo(u0.w) + w11[2] * bf_lo(u1.w) + w21[2] * bf_lo(u2.w)); o1[3] = bf_hi(b.w) * (w01[3] * bf_hi(u0.w) + w11[3] * bf_hi(u1.w) + w21[3] * bf_hi(u2.w));
                *(u32x4*)(YCONV + (size_t)(gr0 + j) * 1024 + c0) = pack8(o0, o1); }
        } else {
            const int cbl = q & 15; const int rest = q >> 4; const int g2 = rest / (TG / 4), gr0 = 4 * (rest - g2 * (TG / 4)), cc0 = g2 * 128 + cbl * 8;
            const int r0 = gr0 % TPB, lo2 = r0 < CL ? 0 : CL, hi2 = r0 < CL ? CL : TPB, base2 = gr0 - r0, tl0 = r0 - lo2, n = hi2 - lo2;
            if (skip && r0 < CL) continue;
            const int win = 2 << g2, hw = win >> 1;
            f32x4 s0[4], s1[4]; u32x4 pc[4];
#pragma unroll
            for (int j = 0; j < 4; ++j) { s0[j] = (f32x4){0.f, 0.f, 0.f, 0.f}; s1[j] = s0[j]; pc[j] = (u32x4){0u, 0u, 0u, 0u}; }
            const bf16_t* prow = PI + (size_t)(base2 + lo2) * 512 + cc0;
#pragma unroll
            for (int k = 0; k < 19; ++k) { const int sidx = tl0 - hw + k;
                if (k < win + 3 && sidx >= 0 && sidx < n) { const u32x4 p = *(const u32x4*)(prow + (size_t)sidx * 512);
                    const f32x4 f0 = {bf_lo(p.x), bf_hi(p.x), bf_lo(p.y), bf_hi(p.y)}, f1 = {bf_lo(p.z), bf_hi(p.z), bf_lo(p.w), bf_hi(p.w)};
#pragma unroll
                    for (int j = 0; j < 4; ++j) { if (k >= j && k - j < win) { s0[j] += f0; s1[j] += f1; } if (k - j == hw) pc[j] = p; } } }
#pragma unroll
            for (int j = 0; j < 4; ++j) { const int tl = tl0 + j; int sa = tl - hw; if (sa < 0) sa = 0; int sb = tl + win - hw; if (sb > n) sb = n;
                const float inv = 1.0f / (float)(sb - sa); const u32x4 p = pc[j]; f32x4 o0, o1;
                o0[0] = s0[j][0] * inv - bf_lo(p.x); o0[1] = s0[j][1] * inv - bf_hi(p.x); o0[2] = s0[j][2] * inv - bf_lo(p.y); o0[3] = s0[j][3] * inv - bf_hi(p.y);
                o1[0] = s1[j][0] * inv - bf_lo(p.z); o1[1] = s1[j][1] * inv - bf_hi(p.z); o1[2] = s1[j][2] * inv - bf_lo(p.w); o1[3] = s1[j][3] * inv - bf_hi(p.w);
                *(u32x4*)(YCONV + (size_t)(gr0 + j) * 1024 + 512 + cc0) = pack8(o0, o1); }
        }
    }
}

__device__ __forceinline__ void finalize_unit(const DArgs& a, int unit, const float* lg2p, LAS unsigned char* lds, int tid, int wid, int lane) {
    asm volatile("" : "+v"(tid)); lane = tid & 63;
    const int c = unit % NCH, h = (unit / NCH) & 3, bb = unit / (NCH * 4), fr = lane & 15, fq = lane >> 4;
    const int tok0 = bb * TPB + c * 128;
    const float lgf = lg2p[h], lgb = lg2p[4 + h];
    LAS unsigned char* R0 = lds; LAS unsigned char* R1 = lds + 65536;
    const char* QF = (const char*)(a.ws + WS_QF);
    dma_tile<128, false>(R0, (const char*)(a.ws + WS_KF) + ((size_t)tok0 * 512 + h * 128) * 2, 1024, tid);
    bf16x8 qf[4];
    { const size_t ro = ((size_t)(tok0 + wid * 16 + fr) * 512 + h * 128 + 8 * fq) * 2;
#pragma unroll
      for (int ks = 0; ks < 4; ++ks) qf[ks] = *(const bf16x8*)(QF + ro + ks * 64); }
    asm volatile("" ::: "memory");
    const char* ST = (const char*)(a.ws + WS_STATES) + ((size_t)((bb * 4 + h) * 2) * NCH + c) * 256 * 128 * 2;
    dma_tile<128, true>(R0 + 32768, ST, 256, tid);
    dma_tile<256, true>(R1, (const char*)(a.ws + WS_VT) + ((size_t)(h * 256) * TG + tok0) * 2, (size_t)TG * 2, tid);
    asm volatile("s_waitcnt vmcnt(12)" ::: "memory"); __builtin_amdgcn_s_barrier(); asm volatile("" ::: "memory");
    bf16x8 pf[4];
    const int i = wid * 16 + fr;
    {
        f32x4 sc[8];
#pragma unroll
        for (int n = 0; n < 8; ++n) sc[n] = (f32x4){0.f, 0.f, 0.f, 0.f};
#pragma unroll
        for (int ks = 0; ks < 4; ++ks)
#pragma unroll
            for (int n = 0; n < 8; ++n) sc[n] = __builtin_amdgcn_mfma_f32_16x16x32_bf16(lds_frag(R0, 16 * n + fr, 4 * ks + fq), qf[ks], sc[n], 0, 0, 0);
#pragma unroll
        for (int n = 0; n < 8; ++n)
#pragma unroll
            for (int jj = 0; jj < 4; ++jj) { const int d = i - (16 * n + 4 * fq + jj); const float w = d == 0 ? 2.0f : __builtin_amdgcn_exp2f(d > 0 ? lgf * (float)d : lgb * (float)(-d)); sc[n][jj] *= w; }
#pragma unroll
        for (int ks = 0; ks < 4; ++ks) { u32x4 w; w.x = cvt_pk_bf16(sc[2 * ks][0], sc[2 * ks][1]); w.y = cvt_pk_bf16(sc[2 * ks][2], sc[2 * ks][3]);
            w.z = cvt_pk_bf16(sc[2 * ks + 1][0], sc[2 * ks + 1][1]); w.w = cvt_pk_bf16(sc[2 * ks + 1][2], sc[2 * ks + 1][3]); pf[ks] = __builtin_bit_cast(bf16x8, w); }
    }
    asm volatile("s_waitcnt vmcnt(0)" ::: "memory"); LDS_WAIT(); __builtin_amdgcn_s_barrier(); asm volatile("" ::: "memory");
    dma_tile<128, true>(R0, ST + (size_t)128 * 256, 256, tid);
    f32x4 o[16];
#pragma unroll
    for (int n = 0; n < 16; ++n) o[n] = (f32x4){0.f, 0.f, 0.f, 0.f};
#pragma unroll
    for (int ks = 0; ks < 4; ++ks)
#pragma unroll
        for (int n = 0; n < 16; ++n) { const int row = 16 * n + fr; const LAS unsigned char* rp = R1 + row * 256 + (fq & 1) * 8;
            const u32x2 p1 = *(const LAS u32x2*)(rp + (((4 * ks + (fq >> 1)) ^ (row & 15)) << 4)), p2 = *(const LAS u32x2*)(rp + (((4 * ks + 2 + (fq >> 1)) ^ (row & 15)) << 4));
            const u32x4 w = {p1.x, p1.y, p2.x, p2.y};
            o[n] = __builtin_amdgcn_mfma_f32_16x16x32_bf16(__builtin_bit_cast(bf16x8, w), pf[ks], o[n], 0, 0, 0); }
    { const float r1 = __builtin_amdgcn_exp2f(-lgf * (float)i);
#pragma unroll
      for (int n = 0; n < 16; ++n) o[n] = o[n] * r1; }
#pragma unroll
    for (int ks = 0; ks < 4; ++ks)
#pragma unroll
        for (int n = 0; n < 8; ++n) o[n] = __builtin_amdgcn_mfma_f32_16x16x32_bf16(lds_frag(R0 + 32768, 16 * n + fr, 4 * ks + fq), qf[ks], o[n], 0, 0, 0);
    asm volatile("s_waitcnt vmcnt(0) lgkmcnt(0)" ::: "memory"); __builtin_amdgcn_s_barrier(); asm volatile("" ::: "memory");
    dma_tile<256, true>(R1, ST + (size_t)NCH * 256 * 128 * 2, 256, tid);
#pragma unroll
    for (int ks = 0; ks < 4; ++ks)
#pragma unroll
        for (int n = 8; n < 16; ++n) o[n] = __builtin_amdgcn_mfma_f32_16x16x32_bf16(lds_frag(R0, 16 * (n - 8) + fr, 4 * ks + fq), qf[ks], o[n], 0, 0, 0);
    { const float r2 = __builtin_amdgcn_exp2f((lgf + lgb) * (float)i);
#pragma unroll
      for (int n = 0; n < 16; ++n) o[n] = o[n] * r2; }
    asm volatile("s_waitcnt vmcnt(0) lgkmcnt(0)" ::: "memory"); __builtin_amdgcn_s_barrier(); asm volatile("" ::: "memory");
    const size_t ro = (size_t)(tok0 + wid * 16 + fr) * 1024 + h * 256 + 8 * fq;
    const bf16_t* GS = (const bf16_t*)(a.ws + WS_GS) + ro; bf16_t* YR = (bf16_t*)(a.ws + WS_YRET) + ro;
    u32x4 gsv[8];
#pragma unroll
    for (int p = 0; p < 8; ++p) gsv[p] = *(const u32x4*)(GS + 32 * p);
    asm volatile("" ::: "memory");
#pragma unroll
    for (int ks = 0; ks < 4; ++ks)
#pragma unroll
        for (int n = 0; n < 16; ++n) o[n] = __builtin_amdgcn_mfma_f32_16x16x32_bf16(lds_frag(R1, 16 * n + fr, 4 * ks + fq), qf[ks], o[n], 0, 0, 0);
    { const float r3 = __builtin_amdgcn_exp2f(-lgb * (float)i);
#pragma unroll
      for (int n = 0; n < 16; ++n) o[n] = o[n] * r3; }
    float s = 0.f;
#pragma unroll
    for (int n = 0; n < 16; ++n) s += (o[n][0] + o[n][1]) + (o[n][2] + o[n][3]);
    s = rows4_sum(s);
    const float mu = s * (1.0f / 256.0f); float q = 0.f;
#pragma unroll
    for (int n = 0; n < 16; ++n) { o[n] = o[n] - mu; q += (o[n][0] * o[n][0] + o[n][1] * o[n][1]) + (o[n][2] * o[n][2] + o[n][3] * o[n][3]); }
    q = rows4_sum(q);
    const float rstd = rsqrtf(q * (1.0f / 256.0f) + EPS);
#pragma unroll
    for (int p = 0; p < 8; ++p) { const u32x4 g = gsv[p]; f32x4 v0 = o[2 * p] * rstd, v1 = o[2 * p + 1] * rstd;
        v0[0] *= bf_lo(g.x); v0[1] *= bf_hi(g.x); v0[2] *= bf_lo(g.y); v0[3] *= bf_hi(g.y); v1[0] *= bf_lo(g.z); v1[1] *= bf_hi(g.z); v1[2] *= bf_lo(g.w); v1[3] *= bf_hi(g.w);
        *(u32x4*)(YR + 32 * p) = pack8(v0, v1); }
    LDS_WAIT(); __builtin_amdgcn_s_barrier(); asm volatile("" ::: "memory");
}

__device__ __forceinline__ void finalize_ctx_unit(const DArgs& a, int unit, const float* lg2p, LAS unsigned char* lds, int tid, int wid, int lane) {
    asm volatile("" : "+v"(tid)); lane = tid & 63;
    const int c = unit & 1, h = (unit >> 1) & 3, bb = unit >> 3, fr = lane & 15, fq = lane >> 4;
    const int tok0 = bb * TPB + c * 128, tokx = bb * TPB + (1 - c) * 128;
    const float lgf = lg2p[h], lgb = lg2p[4 + h];
    LAS unsigned char* R0 = lds; LAS unsigned char* R1 = lds + 65536;
    const char* QF = (const char*)(a.ws + WS_QF);
    dma_tile<128, false>(R0, (const char*)(a.ws + WS_KF) + ((size_t)tok0 * 512 + h * 128) * 2, 1024, tid);
    dma_tile<128, false>(R0 + 32768, (const char*)(a.ws + WS_KF) + ((size_t)tokx * 512 + h * 128) * 2, 1024, tid);
    dma_tile<256, true>(R1, (const char*)(a.ws + WS_VT) + ((size_t)(h * 256) * TG + tok0) * 2, (size_t)TG * 2, tid);
    bf16x8 qf[4];
    { const size_t ro = ((size_t)(tok0 + wid * 16 + fr) * 512 + h * 128 + 8 * fq) * 2;
#pragma unroll
      for (int ks = 0; ks < 4; ++ks) qf[ks] = *(const bf16x8*)(QF + ro + ks * 64); }
    asm volatile("s_waitcnt vmcnt(0)" ::: "memory"); __builtin_amdgcn_s_barrier(); asm volatile("" ::: "memory");
    bf16x8 pf[2][4];
    const int i = wid * 16 + fr;
#pragma unroll
    for (int kc = 0; kc < 2; ++kc) {
        const LAS unsigned char* Kb = R0 + kc * 32768; const int off = kc == 0 ? 0 : (c ? 128 : -128);
        f32x4 sc[8];
#pragma unroll
        for (int n = 0; n < 8; ++n) sc[n] = (f32x4){0.f, 0.f, 0.f, 0.f};
#pragma unroll
        for (int ks = 0; ks < 4; ++ks)
#pragma unroll
            for (int n = 0; n < 8; ++n) sc[n] = __builtin_amdgcn_mfma_f32_16x16x32_bf16(lds_frag(Kb, 16 * n + fr, 4 * ks + fq), qf[ks], sc[n], 0, 0, 0);
#pragma unroll
        for (int n = 0; n < 8; ++n)
#pragma unroll
            for (int jj = 0; jj < 4; ++jj) { const int d = i + off - (16 * n + 4 * fq + jj); const float w = d == 0 ? 2.0f : __builtin_amdgcn_exp2f(d > 0 ? lgf * (float)d : lgb * (float)(-d)); sc[n][jj] *= w; }
#pragma unroll
        for (int ks = 0; ks < 4; ++ks) { u32x4 w; w.x = cvt_pk_bf16(sc[2 * ks][0], sc[2 * ks][1]); w.y = cvt_pk_bf16(sc[2 * ks][2], sc[2 * ks][3]);
            w.z = cvt_pk_bf16(sc[2 * ks + 1][0], sc[2 * ks + 1][1]); w.w = cvt_pk_bf16(sc[2 * ks + 1][2], sc[2 * ks + 1][3]); pf[kc][ks] = __builtin_bit_cast(bf16x8, w); }
    }
    LDS_WAIT(); __builtin_amdgcn_s_barrier(); asm volatile("" ::: "memory");
    dma_tile<256, true>(R0, (const char*)(a.ws + WS_VT) + ((size_t)(h * 256) * TG + tokx) * 2, (size_t)TG * 2, tid);
    f32x4 o[16];
#pragma unroll
    for (int n = 0; n < 16; ++n) o[n] = (f32x4){0.f, 0.f, 0.f, 0.f};
#pragma unroll
    for (int kc = 0; kc < 2; ++kc) {
        const LAS unsigned char* Vb = kc == 0 ? R1 : R0;
        if (kc == 1) { asm volatile("s_waitcnt vmcnt(0) lgkmcnt(0)" ::: "memory"); __builtin_amdgcn_s_barrier(); asm volatile("" ::: "memory"); }
#pragma unroll
        for (int ks = 0; ks < 4; ++ks)
#pragma unroll
            for (int n = 0; n < 16; ++n) { const int row = 16 * n + fr; const LAS unsigned char* rp = Vb + row * 256 + (fq & 1) * 8;
                const u32x2 p1 = *(const LAS u32x2*)(rp + (((4 * ks + (fq >> 1)) ^ (row & 15)) << 4)), p2 = *(const LAS u32x2*)(rp + (((4 * ks + 2 + (fq >> 1)) ^ (row & 15)) << 4));
                const u32x4 w = {p1.x, p1.y, p2.x, p2.y};
                o[n] = __builtin_amdgcn_mfma_f32_16x16x32_bf16(__builtin_bit_cast(bf16x8, w), pf[kc][ks], o[n], 0, 0, 0); }
    }
    float s = 0.f;
#pragma unroll
    for (int n = 0; n < 16; ++n) s += (o[n][0] + o[n][1]) + (o[n][2] + o[n][3]);
    s = rows4_sum(s);
    const float mu = s * (1.0f / 256.0f); float q = 0.f;
#pragma unroll
    for (int n = 0; n < 16; ++n) { o[n] = o[n] - mu; q += (o[n][0] * o[n][0] + o[n][1] * o[n][1]) + (o[n][2] * o[n][2] + o[n][3] * o[n][3]); }
    q = rows4_sum(q);
    const float rstd = rsqrtf(q * (1.0f / 256.0f) + EPS);
    const size_t ro = (size_t)(tok0 + wid * 16 + fr) * 1024 + h * 256 + 8 * fq;
    const bf16_t* GS = (const bf16_t*)(a.ws + WS_GS) + ro; bf16_t* YR = (bf16_t*)(a.ws + WS_YRET) + ro;
#pragma unroll
    for (int p = 0; p < 8; ++p) { const u32x4 g = *(const u32x4*)(GS + 32 * p); f32x4 v0 = o[2 * p] * rstd, v1 = o[2 * p + 1] * rstd;
        v0[0] *= bf_lo(g.x); v0[1] *= bf_hi(g.x); v0[2] *= bf_lo(g.y); v0[3] *= bf_hi(g.y); v1[0] *= bf_lo(g.z); v1[1] *= bf_hi(g.z); v1[2] *= bf_lo(g.w); v1[3] *= bf_hi(g.w);
        *(u32x4*)(YR + 32 * p) = pack8(v0, v1); }
    LDS_WAIT(); __builtin_amdgcn_s_barrier(); asm volatile("" ::: "memory");
}

__global__ void __launch_bounds__(512, 2) fwd_kernel(Args kargs_unused) {
    DArgs a; a.out = KArgs().out(); a.ws = KArgs().wsp();
    extern __shared__ __attribute__((aligned(16))) unsigned char lds_raw[];
    LAS unsigned char* lds = (LAS unsigned char*)lds_raw;
    int tid = threadIdx.x, lane = tid & 63, wid = __builtin_amdgcn_readfirstlane(tid >> 6);
    int G = gridDim.x, bid = blockIdx.x;
#define PHASE_FENCE() do { asm volatile("" : "+v"(tid)); lane = tid & 63; wid = __builtin_amdgcn_readfirstlane(tid >> 6); \
        { unsigned _l = __builtin_amdgcn_readfirstlane((unsigned)(size_t)lds); asm volatile("" : "+s"(_l)); lds = (LAS unsigned char*)(size_t)_l; } \
        G = __builtin_amdgcn_readfirstlane(G); bid = __builtin_amdgcn_readfirstlane(bid); asm volatile("" : "+s"(G), "+s"(bid)); \
        a.out = KArgs().out(); a.ws = KArgs().wsp(); } while (0)
    for (int u = tid; u < (LDS_BYTES - LC_OFF) / 4; u += 512) ((LAS unsigned*)(lds + LC_OFF))[u] = 0u;
    __syncthreads();
    unsigned* ctl = (unsigned*)(a.ws + WS_CTL);
    const XcdBarrier bar = xcd_barrier_post(ctl + CW_BAR, (volatile LAS unsigned*)(lds + LC_BAR));
#define GRID_BAR() do { for (int _r = 0; _r < REP_BAR; ++_r) { XcdBarrier _b = bar; asm volatile("" : "+s"(_b.bar)); xcd_barrier(_b); } PHASE_FENCE(); } while (0)
#define TAB ((const float*)(a.ws + WS_TAB))

#ifndef DBG_POISON
#define DBG_POISON 0
#endif
    if (DBG_POISON) {
        u32x4* p4 = (u32x4*)(a.ws + 1 * MiB); const size_t n4 = (WS_END - 1 * MiB) / 16; const u32x4 pz = {0xffffffffu, 0xffffffffu, 0xffffffffu, 0xffffffffu};
        for (size_t i = (size_t)bid * 512 + tid; i < n4; i += (size_t)G * 512) p4[i] = pz;
        u32x4* o4 = (u32x4*)a.out; const size_t m4 = (size_t)NB * SEQ * D / 4;
        for (size_t i = (size_t)bid * 512 + tid; i < m4; i += (size_t)G * 512) o4[i] = pz;
        GRID_BAR();
    }
#ifndef X_NO_P0
    for (int rep = 0; rep < REP_P0; ++rep) { p0_mod(a, lds, tid, wid, lane); __syncthreads(); }
    for (int rep = 0; rep < REP_CVT; ++rep) { convert_weights(a, 0, lds, wid, lane); __syncthreads(); }
#endif
    GRID_BAR();

    for (int l = 0; l < DEPTH; ++l) {
#define lg2 (TAB + l * 8)
        const int skipctx = (l == DEPTH - 1) ? 1 : 0;
#ifndef X_NO_N1
        if (l > 0) for (int rep = 0; rep < REP_CVT; ++rep) { convert_weights(a, l, lds, wid, lane); __syncthreads(); }
        if (l == 0) { for (int rep = 0; rep < REP_N1; ++rep) phase_n1<0>(a, l, wid, lane); } else phase_n1<1>(a, l, wid, lane);
#endif
        GRID_BAR();
        for (int g = 0; g <= NG; ++g) {
#ifndef NO_OVERLAP
#define NO_OVERLAP 0
#endif
            const int nG4 = g == 0 ? 0 : (skipctx ? 128 : 144);
            if (bid < nG4) {
#ifndef X_NO_OUTPROJ
                for (int rep = 0; rep < REP_G4; ++rep) { PHASE_FENCE();
                    const int gp = g - 1;
                    const unsigned char* GATE = (const unsigned char*)(a.ws + ((gp & 1) ? WS_GATE1 : WS_GATE0)); bf16_t* MG = (bf16_t*)(a.ws + WS_MERGED) + (size_t)gp * TG * 1024;
                    SchedG4 S{(const char*)(a.ws + WS_YRET), (const char*)(a.ws + WS_YCONV), (const char*)(a.ws + WS_WRET), (const char*)(a.ws + WS_WCONV), skipctx ? TG / 256 / 9 * 8 : TG / 256, nG4, bid, skipctx};
                    EpiG4 E{GATE, MG};
                    pg8::gemm_phase<1024, 1024, 1024, EpiG4, SchedG4, true, true, true>(lds, tid, S, E);
                }
#endif
            }
            if (g == NG && bid >= nG4) {
                PHASE_FENCE();
                const int ntg = skipctx ? TG / 256 / 9 * 8 : TG / 256;
                SchedPlain S{(const char*)(a.ws + WS_MERGED), (const char*)(a.ws + WS_WO), (size_t)256 * 2048, (size_t)256 * 2048, (NG - 1) * ntg, 4, G - nG4, bid - nG4, skipctx};
                EpiPlainBf16 E{(bf16_t*)(a.ws + WS_YATT), 1024};
                pg8::gemm_phase<1024, 1024, 1024, EpiPlainBf16, SchedPlain, true, true>(lds, tid, S, E);
            }
            if (g < NG) {
#ifndef X_NO_INPROJ
                for (int rep = 0; rep < REP_G1; ++rep) { PHASE_FENCE();
                    SchedInproj S{(const char*)(a.ws + WS_H) + (size_t)g * TG * 2048, (const char*)(a.ws + WS_WIN), G, bid, nG4, skipctx};
                    EpiInproj E{a.ws, lg2, TAB + 32, TAB + 32 + 2048, (bf16_t*)(a.ws + ((g & 1) ? WS_GATE1 : WS_GATE0))};
                    pg8::gemm_phase<1024, 1024, 1024, EpiInproj, SchedInproj, true, true>(lds, tid, S, E);
                }
#endif
            }
            GRID_BAR();
            if (g == NG) break;
#ifndef X_NO_CHAIN
            for (int rep = 0; rep < REP_G2; ++rep) {
            if (bid < NCHAIN) {
                const int cu = (((bid & 7) + 8 * (bid >> 5)) << 2) | ((bid >> 3) & 3);
                for (int r2 = 0; r2 < REP_CH; ++r2) chain_unit(a, cu, lg2, lds, tid, wid, lane); }
            else if (skipctx) { for (int r2 = 0; r2 < REP_CP; ++r2) conv_pool(a, l, bid - NCHAIN, G - NCHAIN, tid, skipctx, 0, CP_TOTAL - CP_DEFER); }
            else {
                const int w = bid - NCHAIN, nv = 2 * (G - NCHAIN) - 32;
                if (w < 32) { finalize_ctx_unit(a, w, lg2, lds, tid, wid, lane); conv_pool(a, l, w, nv, tid, skipctx, 0, CP_TOTAL - CP_DEFER); }
                else { conv_pool(a, l, 32 + 2 * (w - 32), nv, tid, skipctx, 0, CP_TOTAL - CP_DEFER); conv_pool(a, l, 33 + 2 * (w - 32), nv, tid, skipctx, 0, CP_TOTAL - CP_DEFER); }
            }
            }
#endif
            GRID_BAR();
#ifndef X_NO_FIN
            for (int rep = 0; rep < REP_G3; ++rep)
            for (int u = bid; u < BG * 4 * 16; u += G) finalize_unit(a, (u >> 4) * NCH + 2 + (u & 15), lg2, lds, tid, wid, lane);
            conv_pool(a, l, bid, G, tid, skipctx, CP_TOTAL - CP_DEFER, CP_TOTAL);
#endif
            GRID_BAR();
        }
#ifndef X_NO_WO
        for (int rep = 0; rep < REP_WO; ++rep) { PHASE_FENCE();
            SchedPlain S{(const char*)(a.ws + WS_MERGED) + (size_t)(NG - 1) * TG * 2048, (const char*)(a.ws + WS_WO), (size_t)256 * 2048, (size_t)256 * 2048, skipctx ? TG / 256 / 9 * 8 : TG / 256, 4, G, bid, skipctx};
            EpiPlainBf16 E{(bf16_t*)(a.ws + WS_YATT) + (size_t)(NG - 1) * TG * 1024, 1024};
            pg8::gemm_phase<1024, 1024, 1024, EpiPlainBf16, SchedPlain, true, true>(lds, tid, S, E);
        }
#endif
        GRID_BAR();
#ifndef X_NO_N2
        for (int rep = 1; rep < REP_N2; ++rep) { phase_n2(a, l, lds, tid, wid, lane, skipctx, true); __syncthreads(); }
        phase_n2(a, l, lds, tid, wid, lane, skipctx);
#endif
        GRID_BAR();
        {
            LAS int* cnt = (LAS int*)(lds + LC_CNT); LAS int* poff = (LAS int*)(lds + LC_POFF); LAS int* tile_e = (LAS int*)(lds + LC_TILEE); LAS int* ntl = (LAS int*)(lds + LC_NT);
            if (tid == 0) { int off = 0;
_Pragma("unroll 1")
                for (int e = 0; e < 16; ++e) { const int n = (int)xb_ld(ctl + CW_CNT + 64 * l + e); cnt[e] = n; poff[e] = off; const int nt = (n + 255) >> 8;
                    for (int t = 0; t < nt; ++t) tile_e[(off >> 8) + t] = e; off += nt << 8; } poff[16] = off; ntl[0] = off >> 8; }
            __syncthreads();
            const int ntiles = ntl[0];
            {
                int* SLOTOF = (int*)(a.ws + WS_SLOTOF); const int* LISTp = (const int*)(a.ws + WS_LIST);
                for (int idx = bid * 512 + tid; idx < ntiles * 256; idx += G * 512) { const int e = tile_e[idx >> 8], p = idx - poff[e]; if (p < cnt[e]) SLOTOF[LISTp[(size_t)e * T + p]] = idx; }
            }
#ifndef X_NO_M1
            for (int rep = 0; rep < REP_M1; ++rep) { PHASE_FENCE(); SchedMoeG S{(const char*)(a.ws + WS_H), (const char*)(a.ws + WS_W13), tile_e, cnt, poff, (const int*)(a.ws + WS_LIST), (LAS int*)(lds + LC_GTBL), ntiles, G, bid};
              EpiMoeUp E{(bf16_t*)(a.ws + WS_ACT)};
              pg8::gemm_phase<1024, 1024, 1024, EpiMoeUp, SchedMoeG, true, true>(lds, tid, S, E); }
#endif
            GRID_BAR();
#ifndef X_NO_M2
            for (int rep = 0; rep < REP_M2; ++rep) { PHASE_FENCE(); SchedMoe S{(const char*)(a.ws + WS_ACT), (const char*)(a.ws + WS_W2), (size_t)256 * 1024, (size_t)1024, tile_e, ntiles, G, bid};
              EpiPlainBf16 E{(bf16_t*)(a.ws + WS_YS), 1024};
              pg8::gemm_phase<512, 512, 512, EpiPlainBf16, SchedMoe, true, true>(lds, tid, S, E); }
#endif
            GRID_BAR();
        }
    }
    {
        float poison = 0.f;
        const unsigned err = xb_ld(ctl + CW_ERR), tmo = xb_ld(ctl + CW_BAR + XB_TMO);
        if (err) poison = sqrtf((float)err); else if (tmo) poison = sqrtf(90.f);
        phase_final(a, wid, lane, poison);
    }
}

extern "C" void kernel_launch(void* const* d_in, const int* in_sizes, int n_in, void* d_out, int out_size, void* d_ws, size_t ws_size, hipStream_t stream) {
    static int grid = 0;
    if (grid == 0) {
        if (n_in != 25 || ws_size < WS_END) { fprintf(stderr, "kernel_launch: unexpected n_in %d / ws_size %zu\n", n_in, ws_size); grid = -1; return; }
        int dev = 0, cus = 0, per_cu = 0;
        if (hipGetDevice(&dev) != hipSuccess || hipDeviceGetAttribute(&cus, hipDeviceAttributeMultiprocessorCount, dev) != hipSuccess) { grid = -1; return; }
        if (hipFuncSetAttribute((const void*)fwd_kernel, hipFuncAttributeMaxDynamicSharedMemorySize, LDS_BYTES) != hipSuccess) { grid = -1; return; }
        if (hipOccupancyMaxActiveBlocksPerMultiprocessor(&per_cu, (const void*)fwd_kernel, 512, LDS_BYTES) != hipSuccess || per_cu < 1) fprintf(stderr, "kernel_launch: occupancy query says %d\n", per_cu);
        (void)hipGetLastError();
        grid = cus;
    }
    if (grid < 0) return;
    if (hipMemsetAsync((char*)d_ws + WS_CTL, 0, 1 * MiB, stream) != hipSuccess) return;
    Args a{};
    for (int i = 0; i < 25; ++i) a.in[i] = (const float*)d_in[i];
    a.out = (float*)d_out; a.ws = (unsigned char*)d_ws;
    hipLaunchKernelGGL(fwd_kernel, dim3(grid), dim3(512), LDS_BYTES, stream, a);
}
```

```cpp
#include <hip/hip_runtime.h>
#include <cstdio>
#include <cstdint>

#ifndef REP_G1
#define REP_G1 1
#endif
#ifndef REP_G2
#define REP_G2 1
#endif
#ifndef REP_G3
#define REP_G3 1
#endif
#ifndef REP_G4
#define REP_G4 1
#endif
#ifndef REP_WO
#define REP_WO 1
#endif
#ifndef REP_M0
#define REP_M0 1
#endif
#ifndef REP_M1
#define REP_M1 1
#endif
#ifndef REP_M2
#define REP_M2 1
#endif
#ifndef REP_CVT
#define REP_CVT 1
#endif
#ifndef REP_P0
#define REP_P0 1
#endif
#ifndef REP_N1
#define REP_N1 1
#endif
#ifndef REP_BAR
#define REP_BAR 1
#endif
#ifndef REP_N2
#define REP_N2 1
#endif
#ifndef REP_CH
#define REP_CH 1
#endif
#ifndef REP_EPI
#define REP_EPI 1
#endif
#ifndef REP_CP
#define REP_CP 1
#endif
#define LAS __attribute__((address_space(3)))
typedef unsigned short bf16_t;
typedef short bf16x8 __attribute__((ext_vector_type(8)));
typedef short bf16x4 __attribute__((ext_vector_type(4)));
typedef float f32x4 __attribute__((ext_vector_type(4)));
typedef float f32x2 __attribute__((ext_vector_type(2)));
typedef unsigned u32x4 __attribute__((ext_vector_type(4)));
typedef unsigned u32x2 __attribute__((ext_vector_type(2)));

constexpr int D = 1024, NB = 16, SEQ = 2048, CL = 256, TPB = SEQ + CL  , T = NB * TPB  , DEPTH = 4;
constexpr int NG = 4, BG = NB / NG, TG = BG * TPB;
constexpr int NCH = TPB / 128;
constexpr float EPS = 1e-6f;
constexpr int NMOD = 6 * D;

constexpr size_t MiB = 1u << 20;
constexpr size_t WS_CTL = 0;
constexpr size_t WS_MOD = 1 * MiB;
constexpr size_t WS_TAB = WS_MOD + (size_t)DEPTH * 17 * NMOD * 4;
constexpr size_t WS_WIN = 3 * MiB;
constexpr size_t WS_WRET = WS_WIN + 16 * MiB;
constexpr size_t WS_WCONV = WS_WRET + 2 * MiB;
constexpr size_t WS_WPOOL = WS_WCONV + 1 * MiB;
constexpr size_t WS_WO = WS_WPOOL + 1 * MiB;
constexpr size_t WS_W13 = WS_WO + 2 * MiB;
constexpr size_t WS_W2 = WS_W13 + 32 * MiB;
constexpr size_t WS_XC = WS_W2 + 16 * MiB;
constexpr size_t WS_H = WS_XC + 16 * MiB;
constexpr size_t WS_PROJ = WS_H + 72 * MiB;
constexpr size_t SEC = (size_t)TG * 512 * 2;
constexpr size_t WS_QF = WS_PROJ, WS_QB = WS_QF + SEC, WS_KF = WS_QB + SEC, WS_KB = WS_KF + SEC, WS_KTF = WS_KB + SEC, WS_KTB = WS_KTF + SEC;
constexpr size_t WS_VT = WS_KTB + SEC, WS_GS = WS_VT + 2 * SEC, WS_CB = WS_GS + 2 * SEC, WS_CU = WS_CB + SEC, WS_PI = WS_CU + SEC;
constexpr size_t WS_GATE0 = WS_PI + SEC, WS_GATE1 = WS_GATE0 + 6 * SEC;
constexpr size_t WS_PROJ_END = WS_GATE1 + 6 * SEC;
constexpr size_t WS_H2S = WS_PROJ;
constexpr size_t WS_ACT = WS_PROJ + 152 * MiB;
constexpr size_t WS_STATES = WS_PROJ_END;
constexpr size_t WS_YRET = WS_STATES + 36 * MiB;
constexpr size_t WS_YCONV = WS_YRET + 18 * MiB;
constexpr size_t WS_POOLED = WS_YCONV + 9 * MiB;
constexpr size_t WS_MERGEDF = WS_POOLED + 9 * MiB;
constexpr size_t WS_X = WS_MERGEDF + 36 * MiB;
constexpr size_t WS_YATT = WS_X + 72 * MiB;
constexpr size_t WS_YS = WS_YATT + 72 * MiB;
constexpr size_t WS_MERGED = WS_YS;
constexpr size_t WS_ROUTEC = WS_YS + 152 * MiB;
constexpr size_t WS_SLOTOF = WS_ROUTEC + 512 * 1024;
constexpr size_t WS_LIST = WS_ROUTEC + 1 * MiB;
constexpr size_t WS_END = WS_LIST + 3 * MiB;
static_assert(WS_PROJ_END - WS_PROJ == 25 * SEC, "proj");
static_assert(WS_ACT + (size_t)(2 * T + 4096) * 512 * 2 <= WS_X && WS_H2S + (size_t)(2 * T + 4096) * 1024 * 2 <= WS_ACT, "moe alias");
static_assert(WS_END <= 798 * MiB, "workspace");
constexpr int CW_ERR = 16;
constexpr int CW_BAR = 4096;
constexpr int CW_CNT = 16384;

constexpr int LDS_BYTES = 147456;
constexpr int LC_OFF = 131072;
constexpr int LC_BAR = LC_OFF + 32;
constexpr int LC_CNT = LC_OFF + 256;
constexpr int LC_POFF = LC_OFF + 384;
constexpr int LC_NT = LC_OFF + 480;
constexpr int LC_TILEE = LC_OFF + 512;
constexpr int LC_RE = LC_OFF + 2048;
constexpr int LC_LCNT = LC_OFF + 3584;
constexpr int LC_GTBL = LC_OFF + 4096;

__device__ __forceinline__ unsigned cvt_pk_bf16(float lo, float hi) { unsigned r; asm volatile("s_nop 0\n\tv_cvt_pk_bf16_f32 %0, %1, %2" : "=v"(r) : "v"(lo), "v"(hi)); return r; }
__device__ __forceinline__ float bf_lo(unsigned w) { return __uint_as_float(w << 16); }
__device__ __forceinline__ float bf_hi(unsigned w) { return __uint_as_float(w & 0xffff0000u); }
template <int CTRL> __device__ __forceinline__ float dpp_add(float v) { return v + __builtin_bit_cast(float, __builtin_amdgcn_update_dpp(0, __builtin_bit_cast(int, v), CTRL, 0xF, 0xF, true)); }
__device__ __forceinline__ float row16_sum(float v) { v = dpp_add<0xB1>(v); v = dpp_add<0x4E>(v); v = dpp_add<0x141>(v); v = dpp_add<0x140>(v); return v; }
__device__ __forceinline__ float swap32_sum(float a, float b) { const auto r = __builtin_amdgcn_permlane32_swap(__builtin_bit_cast(unsigned, a), __builtin_bit_cast(unsigned, b), false, false);
    return __builtin_bit_cast(float, (unsigned)r[0]) + __builtin_bit_cast(float, (unsigned)r[1]); }
__device__ __forceinline__ float swap16_sum(float a, float b) { const auto r = __builtin_amdgcn_permlane16_swap(__builtin_bit_cast(unsigned, a), __builtin_bit_cast(unsigned, b), false, false);
    return __builtin_bit_cast(float, (unsigned)r[0]) + __builtin_bit_cast(float, (unsigned)r[1]); }
__device__ __forceinline__ float wave_sum4(float v0, float v1, float v2, float v3) { return row16_sum(swap16_sum(swap32_sum(v0, v1), swap32_sum(v2, v3))); }
__device__ __forceinline__ float wave_sum(float v) { const float r = row16_sum(v); const float t = swap16_sum(r, r); return swap32_sum(t, t); }
__device__ __forceinline__ float rows4_sum(float v) { const float t = swap16_sum(v, v); return swap32_sum(t, t); }
__device__ __forceinline__ float lane_val(float v, int l) { return __builtin_bit_cast(float, __builtin_amdgcn_readlane(__builtin_bit_cast(int, v), l)); }
__device__ __forceinline__ float fast_exp(float x) { return __builtin_amdgcn_exp2f(x * 1.4426950408889634f); }
__device__ __forceinline__ float silu_f(float x) { return x * __builtin_amdgcn_rcpf(1.0f + fast_exp(-x)); }
__device__ __forceinline__ float sigmoid_f(float x) { return __builtin_amdgcn_rcpf(1.0f + fast_exp(-x)); }
__device__ __forceinline__ float silu_fast(float x) { return x * __builtin_amdgcn_rcpf(1.0f + fast_exp(-x)); }
__device__ __forceinline__ float sigmoid_fast(float x) { return __builtin_amdgcn_rcpf(1.0f + fast_exp(-x)); }
__device__ __forceinline__ u32x4 pack8(const f32x4 a, const f32x4 b) { u32x4 w; w.x = cvt_pk_bf16(a[0], a[1]); w.y = cvt_pk_bf16(a[2], a[3]); w.z = cvt_pk_bf16(b[0], b[1]); w.w = cvt_pk_bf16(b[2], b[3]); return w; }
#define LDS_WAIT() asm volatile("s_waitcnt lgkmcnt(0)" ::: "memory")
#define VM_WAIT() asm volatile("s_waitcnt vmcnt(0)" ::: "memory")

#define XB_TMO      128
#define XB_XCNT(j)  (256  + 64 * (j))
#define XB_XSUB(j)  (1280 + 64 * (j))
#define XB_XGEN(j)  (2304 + 64 * (j))
#define XB_TOP      3328
#define XB_TOPGEN   3392
#define XCD_BAR_WORDS 3456
#define XB_SPIN_CAP (1u << 18)
__device__ __forceinline__ unsigned xb_ld(unsigned* p)              { return __hip_atomic_load(p, __ATOMIC_RELAXED, __HIP_MEMORY_SCOPE_AGENT); }
__device__ __forceinline__ unsigned xb_add(unsigned* p, unsigned v) { return __hip_atomic_fetch_add(p, v, __ATOMIC_RELAXED, __HIP_MEMORY_SCOPE_AGENT); }
__device__ __forceinline__ unsigned xb_xcc_id() { return (unsigned)__builtin_amdgcn_s_getreg((3 << 11) | 20) & 0xFu; }
#define XB_SPIN(cond, bar) do { unsigned _sp = 0; while (cond) { __builtin_amdgcn_s_sleep(1); \
    if ((++_sp & 255u) == 0u) { if (xb_ld(&(bar)[XB_TMO])) break; if (_sp > XB_SPIN_CAP) { atomicAdd(&(bar)[XB_TMO], 1u); break; } } } } while (0)
struct XcdBarrier { unsigned* bar; unsigned x; volatile LAS unsigned* st; };
__device__ __forceinline__ XcdBarrier xcd_barrier_post(unsigned* bar, volatile LAS unsigned* st) {
    XcdBarrier b; b.bar = bar; b.x = xb_xcc_id(); b.st = st;
    if (threadIdx.x == 0) (void)xb_add(&bar[XB_XCNT(b.x)], 1u);
    return b;
}
__device__ __forceinline__ void xcd_barrier_complete(unsigned* bar, unsigned x, unsigned& nloc, unsigned& nx) {
    const unsigned G = gridDim.x * gridDim.y * gridDim.z;
    unsigned sum, cnt, mine, sp = 0u;
    for (;;) {
        sum = 0u; cnt = 0u; mine = 0u;
#pragma unroll 1
        for (unsigned j = 0; j < 16; ++j) { const unsigned c = xb_ld(&bar[XB_XCNT(j)]); sum += c; cnt += (c > 0u) ? 1u : 0u; mine = (j == x) ? c : mine; }
        if (sum == G) break;
        __builtin_amdgcn_s_sleep(1);
        if ((++sp & 255u) == 0u) { if (xb_ld(&bar[XB_TMO])) break; if (sp > XB_SPIN_CAP) { atomicAdd(&bar[XB_TMO], 1u); break; } }
    }
    nloc = mine > 0u ? mine : 1u; nx = cnt > 0u ? cnt : 1u;
}
__device__ __forceinline__ void xcd_barrier(const XcdBarrier& b) {
    asm volatile("s_waitcnt vmcnt(0)" ::: "memory");
    __syncthreads();
    if (threadIdx.x == 0) {
        unsigned* bar = b.bar;
        __builtin_amdgcn_s_waitcnt(0);
        unsigned nloc = b.st[0], nx = b.st[1];
        if (nloc == 0u) { xcd_barrier_complete(bar, b.x, nloc, nx); b.st[0] = nloc; b.st[1] = nx; }
        const unsigned old = xb_add(&bar[XB_XSUB(b.x)], 1u);
        const unsigned gen = old / nloc;
        if (old + 1u == (gen + 1u) * nloc) {
            __builtin_amdgcn_fence(__ATOMIC_RELEASE, "agent");
            asm volatile("s_waitcnt vmcnt(0)" ::: "memory");
            const unsigned og = xb_add(&bar[XB_TOP], 1u);
            const unsigned tg = og / nx;
            if (og + 1u == (tg + 1u) * nx) xb_add(&bar[XB_TOPGEN], 1u);
            else XB_SPIN(xb_ld(&bar[XB_TOPGEN]) == tg, bar);
            __builtin_amdgcn_fence(__ATOMIC_ACQUIRE, "agent");
            xb_add(&bar[XB_XGEN(b.x)], 1u);
            asm volatile("s_waitcnt vmcnt(0)" ::: "memory");
        } else {
            XB_SPIN(xb_ld(&bar[XB_XGEN(b.x)]) == gen, bar);
            __builtin_amdgcn_fence(__ATOMIC_ACQUIRE, "agent");
            asm volatile("s_waitcnt vmcnt(0)" ::: "memory");
        }
    }
    __syncthreads();
}

namespace pg8 {
constexpr int BM = 256, BK = 64, HALF = 128, HTB = HALF * BK * 2, STAGE_BYTES = 8 * HTB, NXCD = 8, WGM = 8;
__host__ __device__ __forceinline__ int lds_byte(int r, int c) { const int st = (r >> 4) * 2 + (c >> 5), rr = r & 15, cc = c & 31, ob = rr * 64 + cc * 2; return st * 1024 + (ob ^ (((ob >> 9) & 1) << 5)); }
__host__ __device__ __forceinline__ void stage_rc(int b, int& R, int& C) { const int st = b / 1024, sb = b % 1024, swz = sb ^ (((sb >> 9) & 1) << 5); R = (st >> 1) * 16 + swz / 64; C = (st & 1) * 32 + (swz % 64) / 2; }
__host__ __device__ __forceinline__ int perm32(int rho) { const int n = rho >> 4, i = rho & 15; return 8 * (i >> 2) + 4 * n + (i & 3); }

struct Unit { const char* a; const char* b; int pm, pn, kind, nt, cont; };

__device__ __forceinline__ void tile_map(int L, int nM, int nN, int& pm, int& pn) {
    const int nwg = nM * nN; int wgid = L;
    { const int q = nwg / NXCD, r = nwg % NXCD, xcd = wgid % NXCD, off = wgid / NXCD; wgid = (xcd < r ? xcd * (q + 1) : r * (q + 1) + (xcd - r) * q) + off; }
    const int nig = WGM * nN, gid = wgid / nig, fm = gid * WGM, gsz = (nM - fm) < WGM ? (nM - fm) : WGM;
    pm = fm + ((wgid % nig) % gsz); pn = (wgid % nig) / gsz;
}

template <class S_> struct sched_gather { static constexpr bool value = false; };
template <int K, int lda, int ldb, class Epi, class Sched, bool ALIGN_EPI, bool SP2, bool VARNT = false>
__device__ __forceinline__ void gemm_phase(LAS unsigned char* lds, const int tid, const Sched& S, const Epi& E) {
    const int wid = __builtin_amdgcn_readfirstlane(tid >> 6), lane = tid & 63, wr = wid >> 2, wc = wid & 3, fr = lane & 15, fq = lane >> 4;
    constexpr int nt_c = K / BK;
    unsigned voffA[2], voffB[2];
#pragma unroll
    for (int i = 0; i < 2; ++i) { int R, C; stage_rc(tid * 16 + i * 8192, R, C); const int Rb = Epi::PERM ? ((R & ~31) + perm32(R & 31)) : R;
        voffA[i] = (unsigned)(R * lda + C) * 2u; voffB[i] = (unsigned)(Rb * ldb + C) * 2u; }
    constexpr bool GATHER = sched_gather<Sched>::value;
    int gR[2], gC2[2];
#pragma unroll
    for (int i = 0; i < 2; ++i) { int R, C; stage_rc(tid * 16 + i * 8192, R, C); gR[i] = R; gC2[i] = C * 2; }
    unsigned voA0[2] = {voffA[0], voffA[1]}, voA1[2] = {voffA[0], voffA[1]};
    constexpr size_t kstep = (size_t)(BK * 2);
    constexpr size_t hstepA = (size_t)HALF * lda * 2, hstepB = (size_t)HALF * ldb * 2;
    const unsigned ldsw = (unsigned)wid * 1024u;
    const int aoff = lds_byte(wr * 64 + fr, fq * 8), boff = lds_byte(wc * 32 + fr, fq * 8);
#define PG8_SA(b, h) (((b) * 2 + (h)) * HTB)
#define PG8_SB(b, h) ((4 + (b) * 2 + (h)) * HTB)
#define PG8_STAGE(bufoff, gbase, voff) do { _Pragma("unroll") for (int _i = 0; _i < 2; ++_i) \
        __builtin_amdgcn_global_load_lds((const unsigned*)((const char*)(gbase) + (voff)[_i]), (LAS unsigned*)(lds + (bufoff) + ldsw + _i * 8192), 16, 0, 0); } while (0)
#define PG8_STAGE_A(bufoff, gbase, h) do { if constexpr (GATHER) { if ((h) == 0) PG8_STAGE(bufoff, gbase, voA0); else PG8_STAGE(bufoff, gbase, voA1); } \
        else { PG8_STAGE(bufoff, (gbase) + ((h) ? hstepA : 0), voffA); } } while (0)
#define PG8_LDA(dst, b, h) do { _Pragma("unroll") for (int m = 0; m < 4; ++m) _Pragma("unroll") for (int k = 0; k < 2; ++k) dst[m][k] = *(const LAS bf16x8*)(lds + PG8_SA(b, h) + aoff + m * 2048 + k * 1024); } while (0)
#define PG8_LDB(dst, b, h) do { _Pragma("unroll") for (int n = 0; n < 2; ++n) _Pragma("unroll") for (int k = 0; k < 2; ++k) dst[n][k] = *(const LAS bf16x8*)(lds + PG8_SB(b, h) + boff + n * 2048 + k * 1024); } while (0)
#define PG8_MMA(ai, bj, At, Bt) do { __builtin_amdgcn_s_setprio(1); _Pragma("unroll") for (int m = 0; m < 4; ++m) _Pragma("unroll") for (int n = 0; n < 2; ++n) _Pragma("unroll") for (int k = 0; k < 2; ++k) \
        acc[ai][bj][m][n] = __builtin_amdgcn_mfma_f32_16x16x32_bf16(Bt[n][k], At[m][k], acc[ai][bj][m][n], 0, 0, 0); __builtin_amdgcn_s_setprio(0); } while (0)
#define PG8_WAIT_V(n) asm volatile("s_waitcnt vmcnt(" #n ")" ::: "memory")
#define PG8_WAIT_L(n) asm volatile("s_waitcnt lgkmcnt(" #n ")" ::: "memory")
#define PG8_BAR __builtin_amdgcn_s_barrier()
#define PG8_SCHED __builtin_amdgcn_sched_barrier(0)
    Unit cur, nxt; int ui = 0;
    if (!S.next(0, cur)) return;
    f32x4 acc[2][2][4][2];
#pragma unroll
    for (int a = 0; a < 2; ++a)
#pragma unroll
        for (int b = 0; b < 2; ++b)
#pragma unroll
            for (int m = 0; m < 4; ++m)
#pragma unroll
                for (int n = 0; n < 2; ++n) acc[a][b][m][n] = (f32x4){0.f, 0.f, 0.f, 0.f};
    bf16x8 At[4][2], B0[2][2], B1[2][2];
    const char* cA = cur.a; const char* cB = cur.b;
    if constexpr (GATHER) {
        S.fill_table(cur, 0, tid); asm volatile("s_waitcnt vmcnt(0)" ::: "memory"); __builtin_amdgcn_s_barrier(); asm volatile("" ::: "memory");
        S.load_offsets(cur, 0, gR, gC2, voA0, voA1);
    }
    if constexpr (SP2) {
        PG8_STAGE(PG8_SB(0, 0), cB, voffB); PG8_STAGE(PG8_SB(0, 1), cB + hstepB, voffB); PG8_STAGE_A(PG8_SA(0, 0), cA, 0); PG8_STAGE_A(PG8_SA(0, 1), cA, 1);
        if (wr == 1) PG8_BAR;
        PG8_WAIT_V(2); PG8_BAR;
        PG8_STAGE(PG8_SB(1, 0), cB + kstep, voffB); PG8_STAGE_A(PG8_SA(1, 0), cA + kstep, 0); PG8_STAGE(PG8_SB(1, 1), cB + hstepB + kstep, voffB);
        PG8_WAIT_V(6); PG8_BAR;
    } else {
        PG8_STAGE(PG8_SB(0, 0), cB, voffB); PG8_STAGE_A(PG8_SA(0, 0), cA, 0); PG8_STAGE(PG8_SB(0, 1), cB + hstepB, voffB); PG8_STAGE_A(PG8_SA(0, 1), cA, 1);
        if (wr == 1) PG8_BAR;
        PG8_WAIT_V(4); PG8_BAR;
        PG8_STAGE(PG8_SB(1, 0), cB + kstep, voffB); PG8_STAGE_A(PG8_SA(1, 0), cA + kstep, 0); PG8_STAGE(PG8_SB(1, 1), cB + hstepB + kstep, voffB);
        PG8_WAIT_V(6); PG8_BAR;
    }
    for (;;) {
        const bool has_next = S.next(ui + 1, nxt);
        const char* nA = has_next ? nxt.a : cA; const char* nB = has_next ? nxt.b : cB;
        if constexpr (GATHER) { if (has_next) S.fill_table(nxt, (ui + 1) & 1, tid); }
        const int nt = VARNT ? cur.nt : nt_c;
        for (int t = 0; t < nt; t += 2) {
            const bool last = (t == nt - 2);
            const char* a1 = cA + (size_t)(t + 1) * kstep;
            const char* a2 = last ? nA : cA + (size_t)(t + 2) * kstep; const char* b2 = last ? nB : cB + (size_t)(t + 2) * kstep;
            const char* a3 = a2 + kstep; const char* b3 = b2 + kstep;
            if constexpr (SP2) {
            PG8_LDB(B0, 0, 0); PG8_LDB(B1, 0, 1); PG8_SCHED; PG8_LDA(At, 0, 0); PG8_STAGE_A(PG8_SA(1, 1), a1, 1);
            PG8_WAIT_V(8); PG8_WAIT_L(0); PG8_BAR; PG8_MMA(0, 0, At, B0); PG8_MMA(0, 1, At, B1); PG8_BAR; PG8_SCHED;
            PG8_LDA(At, 0, 1);
            if constexpr (GATHER) { if (last && has_next) S.load_offsets(nxt, (ui + 1) & 1, gR, gC2, voA0, voA1); }
            PG8_STAGE(PG8_SB(0, 0), b2, voffB); PG8_STAGE(PG8_SB(0, 1), b2 + hstepB, voffB); PG8_STAGE_A(PG8_SA(0, 0), a2, 0);
            PG8_WAIT_V(8); PG8_WAIT_L(0); PG8_BAR; PG8_MMA(1, 0, At, B0); PG8_MMA(1, 1, At, B1); PG8_BAR; PG8_SCHED;
            PG8_LDB(B0, 1, 0); PG8_LDB(B1, 1, 1); PG8_SCHED; PG8_LDA(At, 1, 0); PG8_STAGE_A(PG8_SA(0, 1), a2, 1);
            PG8_WAIT_V(8); PG8_WAIT_L(0); PG8_BAR; PG8_MMA(0, 0, At, B0); PG8_MMA(0, 1, At, B1); PG8_BAR; PG8_SCHED;
            PG8_LDA(At, 1, 1); PG8_STAGE(PG8_SB(1, 0), b3, voffB); PG8_STAGE(PG8_SB(1, 1), b3 + hstepB, voffB); PG8_STAGE_A(PG8_SA(1, 0), a3, 0);
            PG8_WAIT_V(8); PG8_WAIT_L(0); PG8_BAR; PG8_MMA(1, 0, At, B0); PG8_MMA(1, 1, At, B1); PG8_BAR; PG8_SCHED;
            } else {
            PG8_LDB(B0, 0, 0); PG8_SCHED; PG8_LDA(At, 0, 0); PG8_STAGE_A(PG8_SA(1, 1), a1, 1);
            PG8_WAIT_L(8); PG8_BAR; PG8_WAIT_L(0); PG8_MMA(0, 0, At, B0); PG8_BAR; PG8_SCHED;
            PG8_LDB(B1, 0, 1); PG8_STAGE(PG8_SB(0, 0), b2, voffB);
            PG8_BAR; PG8_WAIT_L(0); PG8_MMA(0, 1, At, B1); PG8_BAR;
            PG8_LDA(At, 0, 1); PG8_STAGE_A(PG8_SA(0, 0), a2, 0);
            PG8_BAR; PG8_WAIT_L(0); PG8_MMA(1, 0, At, B0); PG8_BAR; PG8_SCHED;
            PG8_STAGE(PG8_SB(0, 1), b2 + hstepB, voffB);
            PG8_WAIT_V(6); PG8_BAR; PG8_MMA(1, 1, At, B1); PG8_BAR;
            PG8_LDB(B0, 1, 0); PG8_SCHED; PG8_LDA(At, 1, 0); PG8_STAGE_A(PG8_SA(0, 1), a2, 1);
            PG8_WAIT_L(8); PG8_BAR; PG8_WAIT_L(0); PG8_MMA(0, 0, At, B0); PG8_BAR; PG8_SCHED;
            PG8_LDB(B1, 1, 1); PG8_STAGE(PG8_SB(1, 0), b3, voffB);
            PG8_BAR; PG8_WAIT_L(0); PG8_MMA(0, 1, At, B1); PG8_BAR;
            PG8_LDA(At, 1, 1); PG8_STAGE_A(PG8_SA(1, 0), a3, 0);
            PG8_BAR; PG8_WAIT_L(0); PG8_MMA(1, 0, At, B0); PG8_BAR; PG8_SCHED;
            PG8_STAGE(PG8_SB(1, 1), b3 + hstepB, voffB);
            PG8_WAIT_V(6); PG8_BAR; PG8_MMA(1, 1, At, B1); PG8_BAR;
            }
        }
        if constexpr (ALIGN_EPI) { if (wr == 0) PG8_BAR; }
        E(acc, cur, wr, wc, fr, fq);
        if (REP_EPI > 1 && !VARNT) { for (int _r = 1; _r < REP_EPI; ++_r) E(acc, cur, wr, wc, fr, fq); }
        if (!has_next) break;
        if (!(VARNT && cur.cont))
#pragma unroll
        for (int a = 0; a < 2; ++a)
#pragma unroll
            for (int b = 0; b < 2; ++b)
#pragma unroll
                for (int m = 0; m < 4; ++m)
#pragma unroll
                    for (int n = 0; n < 2; ++n) acc[a][b][m][n] = (f32x4){0.f, 0.f, 0.f, 0.f};
        cur = nxt; cA = nA; cB = nB; ++ui;
        if constexpr (ALIGN_EPI) { if (wr == 1) PG8_BAR; }
    }
    PG8_WAIT_V(0);
    if constexpr (!ALIGN_EPI) { if (wr == 0) PG8_BAR; }
    PG8_BAR;
#undef PG8_SA
#undef PG8_SB
#undef PG8_STAGE
#undef PG8_LDA
#undef PG8_LDB
#undef PG8_MMA
#undef PG8_WAIT_V
#undef PG8_WAIT_L
#undef PG8_BAR
#undef PG8_SCHED
}
}
using pg8::Unit;

struct Args { const float* in[25]; float* out; unsigned char* ws; };
enum { I_X = 0, I_C, I_CTX, I_CCTX, I_WADA, I_BADA, I_NORM1, I_NORM2, I_WIN, I_RETDECAY, I_CONVW, I_POOLW, I_POOLSCALE, I_WRETOUT, I_WCONVOUT, I_WPOOLOUT, I_WO,
       I_WRG, I_BRG, I_WRE, I_BRE, I_W1, I_W3, I_W2, I_FINALNORM };

struct KArgs {
    __device__ __forceinline__ const char __attribute__((address_space(4)))* base() const { const char __attribute__((address_space(4)))* kp = (const char __attribute__((address_space(4)))*)__builtin_amdgcn_kernarg_segment_ptr(); asm volatile("" : "+s"(kp)); return kp; }
    __device__ __forceinline__ const float* in(int i) const { return *(const float* const __attribute__((address_space(4)))*)(base() + 8 * i); }
    __device__ __forceinline__ float* out() const { return *(float* const __attribute__((address_space(4)))*)(base() + 200); }
    __device__ __forceinline__ unsigned char* wsp() const { return *(unsigned char* const __attribute__((address_space(4)))*)(base() + 208); }
};
struct InProxy { __device__ __forceinline__ const float* operator[](int i) const { return KArgs().in(i); } };
struct DArgs { InProxy in; float* out; unsigned char* ws; };
__device__ __forceinline__ bf16_t* xrow_ptr(const DArgs& a, int row) { return (bf16_t*)(a.ws + WS_X) + (size_t)row * D; }

__device__ __forceinline__ void p0_mod(const DArgs& a, LAS unsigned char* lds, int tid, int wid, int lane) {
    LAS float* s = (LAS float*)lds;
    LAS float* red = (LAS float*)(lds + 17 * 1024 * 4);
    const float* c = a.in[I_C]; const float* cc = a.in[I_CCTX];
    for (int i = tid; i < 17 * 1024; i += 512) { const int r = i >> 10, k = i & 1023; const float v = r < 16 ? c[r * 1024 + k] : cc[k]; s[i] = silu_f(v); }
    __syncthreads();
    float* MOD = (float*)(a.ws + WS_MOD);
    for (int it = blockIdx.x; it < DEPTH * 96; it += gridDim.x) {
        const int l = it / 96, nb = it % 96, n = nb * 64 + lane;
        const float* W = a.in[I_WADA] + (size_t)l * D * NMOD + n;
        float acc[17];
#pragma unroll
        for (int r = 0; r < 17; ++r) acc[r] = 0.f;
        for (int k4 = 0; k4 < 32; ++k4) {
            const int k = wid * 128 + k4 * 4;
            const float w0 = W[(size_t)k * NMOD], w1 = W[(size_t)(k + 1) * NMOD], w2 = W[(size_t)(k + 2) * NMOD], w3 = W[(size_t)(k + 3) * NMOD];
#pragma unroll
            for (int r = 0; r < 17; ++r) { const f32x4 sv = *(const LAS f32x4*)(s + r * 1024 + k); acc[r] += sv[0] * w0 + sv[1] * w1 + sv[2] * w2 + sv[3] * w3; }
        }
#pragma unroll
        for (int r = 0; r < 17; ++r) red[(wid * 17 + r) * 64 + lane] = acc[r];
        __syncthreads();
        for (int i = tid; i < 17 * 64; i += 512) { const int r = i >> 6, nn = i & 63; float v = 0.f;
#pragma unroll
            for (int w = 0; w < 8; ++w) v += red[(w * 17 + r) * 64 + nn];
            MOD[((size_t)l * 17 + r) * NMOD + nb * 64 + nn] = v + a.in[I_BADA][(size_t)l * NMOD + nb * 64 + nn]; }
        __syncthreads();
    }
    if (blockIdx.x == gridDim.x - 1) {
        float* TAB = (float*)(a.ws + WS_TAB);
        if (tid < 32) { const float x = a.in[I_RETDECAY][tid]; TAB[tid] = -log1pf(expf(-x)) * 1.4426950408889634f; }
        for (int i = tid; i < 2048; i += 512) { const int v = i >> 5, f = i & 31; const float inv = powf(10000.0f, -(float)f / 32.0f); float sn, cs; sincosf((float)v * inv, &sn, &cs);
            TAB[32 + i] = cs; TAB[32 + 2048 + i] = sn; }
    }
}

template <class F>
__device__ __forceinline__ void cvt_item(const float* W, int N, int k0, int n0, float scale, LAS float* scr, int lane, const F& dstrow) {
    const int kk0 = lane >> 3, nq = lane & 7;
    f32x4 v[8];
#pragma unroll
    for (int i = 0; i < 8; ++i) v[i] = *(const f32x4*)(W + (size_t)(k0 + kk0 + 8 * i) * N + n0 + 4 * nq);
#pragma unroll
    for (int i = 0; i < 8; ++i) { LAS float* d = scr + (kk0 + 8 * i) * 33 + 4 * nq; d[0] = v[i][0]; d[1] = v[i][1]; d[2] = v[i][2]; d[3] = v[i][3]; }
    LDS_WAIT(); asm volatile("" ::: "memory");
    const int c = lane & 7;
#pragma unroll
    for (int j = 0; j < 4; ++j) { const int n = (lane >> 3) + 8 * j; const LAS float* sp = scr + (8 * c) * 33 + n;
        u32x4 o; o.x = cvt_pk_bf16(sp[0 * 33] * scale, sp[1 * 33] * scale); o.y = cvt_pk_bf16(sp[2 * 33] * scale, sp[3 * 33] * scale);
        o.z = cvt_pk_bf16(sp[4 * 33] * scale, sp[5 * 33] * scale); o.w = cvt_pk_bf16(sp[6 * 33] * scale, sp[7 * 33] * scale);
        *(u32x4*)(dstrow(n0 + n) + k0 + 8 * c) = o; }
    LDS_WAIT(); asm volatile("" ::: "memory");
}
__device__ __forceinline__ int win_row(int n) {
    if (n < 1024) { const int sec = n >> 9, c = n & 511, head = c >> 7, d = c & 127, half = d >> 6, idx = d & 63;
        return sec * 512 + (head >> 1) * 256 + half * 128 + (head & 1) * 64 + idx; }
    if (n >= 3584 && n < 4608) { const int isx = n >= 4096, i = isx ? n - 4096 : n - 3584; return 3584 + (i >> 7) * 256 + isx * 128 + (i & 127); }
    return n;
}
__device__ __forceinline__ void convert_weights(const DArgs& a, int l, LAS unsigned char* lds, int wid, int lane) {
    LAS float* scr = (LAS float*)(lds + wid * 8448);
    const int gw = blockIdx.x * 8 + wid, NGW = gridDim.x * 8;
    bf16_t* WIN = (bf16_t*)(a.ws + WS_WIN); bf16_t* WRET = (bf16_t*)(a.ws + WS_WRET); bf16_t* WCONV = (bf16_t*)(a.ws + WS_WCONV); bf16_t* WO = (bf16_t*)(a.ws + WS_WO);
    bf16_t* W13 = (bf16_t*)(a.ws + WS_W13); bf16_t* W2 = (bf16_t*)(a.ws + WS_W2); bf16_t* WPOOL = (bf16_t*)(a.ws + WS_WPOOL);
    constexpr int I0 = 16 * 256, I1 = 16 * 32, I2 = 8 * 32, I3 = 16 * 32, I4 = 16 * 256, I5 = 16 * 256, I6 = 16 * 256, I7 = 512;
    constexpr int NIT = I0 + I1 + I2 + I3 + I4 + I5 + I6 + I7;
    for (int it0 = gw; it0 < NIT; it0 += NGW) {
        int r = __builtin_amdgcn_readfirstlane(it0);
        if (r < I0) { const int kb = r / 256, nb = r % 256, n0 = nb * 32; const float sc = (n0 >= 512 && n0 < 1024) ? 0.08838834764831845f : 1.0f;
            cvt_item(a.in[I_WIN] + (size_t)l * D * 8192, 8192, kb * 64, n0, sc, scr, lane, [&](int n) { return WIN + (size_t)win_row(n) * 1024; }); continue; } r -= I0;
        if (r < I1) { const int kb = r / 32, nb = r % 32; cvt_item(a.in[I_WRETOUT] + (size_t)l * 1024 * 1024, 1024, kb * 64, nb * 32, 1.f, scr, lane, [&](int n) { return WRET + (size_t)n * 1024; }); continue; } r -= I1;
        if (r < I2) { const int kb = r / 32, nb = r % 32; cvt_item(a.in[I_WCONVOUT] + (size_t)l * 512 * 1024, 1024, kb * 64, nb * 32, 1.f, scr, lane, [&](int n) { return WCONV + (size_t)n * 1024; }); continue; } r -= I2;
        if (r < I3) { const int kb = r / 32, nb = r % 32; cvt_item(a.in[I_WO] + (size_t)l * 1024 * 1024, 1024, kb * 64, nb * 32, 1.f, scr, lane, [&](int n) { return WO + (size_t)n * 1024; }); continue; } r -= I3;
        if (r < I4 + I5) { const int is3 = r >= I4; if (is3) r -= I4; const int e = r / 256, q = r % 256, kb = q / 16, nb = q % 16;
            const float* src = a.in[is3 ? I_W3 : I_W1] + ((size_t)l * 16 + e) * 1024 * 512;
            cvt_item(src, 512, kb * 64, nb * 32, 1.f, scr, lane, [&](int n) { return W13 + ((size_t)e * 1024 + (n >> 7) * 256 + is3 * 128 + (n & 127)) * 1024; }); continue; } r -= I4 + I5;
        if (r < I6) { const int e = r / 256, q = r % 256, kb = q / 32, nb = q % 32;
            cvt_item(a.in[I_W2] + ((size_t)l * 16 + e) * 512 * 1024, 1024, kb * 64, nb * 32, 1.f, scr, lane, [&](int n) { return W2 + ((size_t)e * 1024 + n) * 512; }); continue; } r -= I6;
        {
            const int g = r / 128, q = r % 128, cb = q / 16, nb = q % 16, n = nb * 64 + lane;
            const float* pw = a.in[I_POOLW] + ((size_t)l * 4 + g) * 128 * 128 + (size_t)cb * 16 * 128;
            const float* sc = a.in[I_POOLSCALE] + (size_t)l * 512 + g * 128;
            const float* wpo = a.in[I_WPOOLOUT] + ((size_t)l * 512 + g * 128) * 1024 + n;
            float acc[16];
#pragma unroll
            for (int cc = 0; cc < 16; ++cc) acc[cc] = 0.f;
            for (int d = 0; d < 128; ++d) { const float w = wpo[(size_t)d * 1024] * sc[d];
#pragma unroll
                for (int cc = 0; cc < 16; ++cc) acc[cc] += pw[cc * 128 + d] * w; }
            u32x4 o0, o1; o0.x = cvt_pk_bf16(acc[0], acc[1]); o0.y = cvt_pk_bf16(acc[2], acc[3]); o0.z = cvt_pk_bf16(acc[4], acc[5]); o0.w = cvt_pk_bf16(acc[6], acc[7]);
            o1.x = cvt_pk_bf16(acc[8], acc[9]); o1.y = cvt_pk_bf16(acc[10], acc[11]); o1.z = cvt_pk_bf16(acc[12], acc[13]); o1.w = cvt_pk_bf16(acc[14], acc[15]);
            bf16_t* dst = WCONV + (size_t)n * 1024 + 512 + g * 128 + cb * 16; *(u32x4*)dst = o0; *(u32x4*)(dst + 8) = o1;
        }
    }
}

template <int MODE>
__device__ __forceinline__ void phase_n1(const DArgs& a, int l, int wid, int lane) {
    const int gw = blockIdx.x * 8 + wid, NGW = gridDim.x * 8;
    const float* MOD = (const float*)(a.ws + WS_MOD);
    const float* nw = a.in[I_NORM1] + (size_t)l * D;
    bf16_t* H = (bf16_t*)(a.ws + WS_H);
    f32x4 px[4], pg[4], pg1[4]; u32x2 py0[4], py1[4], pya[4], pxb[4];
    const int* SLOTOF = (const int*)(a.ws + WS_SLOTOF); const float* ROUTEC = (const float*)(a.ws + WS_ROUTEC); const bf16_t* YS = (const bf16_t*)(a.ws + WS_YS);
    int sl0 = 0, sl1 = 0; float cw0 = 0.f, cw1 = 0.f, cc0 = 0.f, cc1 = 0.f;
#define N1_SLOTS(rw) do { if (MODE != 0) { sl0 = SLOTOF[2 * (size_t)(rw)]; sl1 = SLOTOF[2 * (size_t)(rw) + 1]; cw0 = ROUTEC[2 * (size_t)(rw)]; cw1 = ROUTEC[2 * (size_t)(rw) + 1]; } } while (0)
#define N1_PRELOAD(rw) do { const int _b = (rw) / TPB, _r = (rw) - _b * TPB, _m = _r < CL ? 16 : _b; \
        if (MODE == 0) { const float* _src = _r < CL ? a.in[I_CTX] + (size_t)(_b * CL + _r) * D : a.in[I_X] + (size_t)(_b * SEQ + (_r - CL)) * D; \
            _Pragma("unroll") for (int j = 0; j < 4; ++j) px[j] = *(const f32x4*)(_src + 4 * lane + 256 * j); } \
        else { const bf16_t* _xp = xrow_ptr(a, (rw)); const float* _g = MOD + ((size_t)(l - 1) * 17 + _m) * NMOD + 5 * D; \
            const bf16_t* _y0 = YS + (size_t)sl0 * D; const bf16_t* _y1 = YS + (size_t)sl1 * D; cc0 = cw0; cc1 = cw1; \
            _Pragma("unroll") for (int j = 0; j < 4; ++j) { const int c = 4 * lane + 256 * j; pxb[j] = *(const u32x2*)(_xp + c); pg[j] = *(const f32x4*)(_g + c); pg1[j] = *(const f32x4*)(_g - 3 * D + c); py0[j] = *(const u32x2*)(_y0 + c); py1[j] = *(const u32x2*)(_y1 + c); \
                pya[j] = *(const u32x2*)((const bf16_t*)(a.ws + WS_YATT) + (size_t)(rw) * D + c); } } } while (0)
    if (gw < T) { N1_SLOTS(gw); N1_PRELOAD(gw); if (gw + NGW < T) N1_SLOTS(gw + NGW); }
    for (int row = gw; row < T; row += NGW) {
        const int b = row / TPB, r = row - b * TPB, mrow = r < CL ? 16 : b;
        bf16_t* xp = xrow_ptr(a, row);
        f32x4 v[4];
        if (MODE == 0) {
#pragma unroll
            for (int j = 0; j < 4; ++j) v[j] = px[j];
        } else {
            const float c0 = cc0, c1 = cc1;
#pragma unroll
            for (int j = 0; j < 4; ++j) { const f32x4 g = pg[j], g1 = pg1[j]; const u32x2 p0 = py0[j], p1 = py1[j], pa = pya[j], xb = pxb[j]; f32x4 x = {bf_lo(xb.x), bf_hi(xb.x), bf_lo(xb.y), bf_hi(xb.y)};
                x[0] += g1[0] * bf_lo(pa.x); x[1] += g1[1] * bf_hi(pa.x); x[2] += g1[2] * bf_lo(pa.y); x[3] += g1[3] * bf_hi(pa.y);
                v[j][0] = x[0] + g[0] * (c0 * bf_lo(p0.x) + c1 * bf_lo(p1.x)); v[j][1] = x[1] + g[1] * (c0 * bf_hi(p0.x) + c1 * bf_hi(p1.x));
                v[j][2] = x[2] + g[2] * (c0 * bf_lo(p0.y) + c1 * bf_lo(p1.y)); v[j][3] = x[3] + g[3] * (c0 * bf_hi(p0.y) + c1 * bf_hi(p1.y)); }
        }
        if (row + NGW < T) { N1_PRELOAD(row + NGW); if (row + 2 * NGW < T) N1_SLOTS(row + 2 * NGW); }
        float ss = 0.f;
#pragma unroll
        for (int j = 0; j < 4; ++j) { u32x2 o; o.x = cvt_pk_bf16(v[j][0], v[j][1]); o.y = cvt_pk_bf16(v[j][2], v[j][3]); *(u32x2*)(xp + 4 * lane + 256 * j) = o; ss += (v[j][0] * v[j][0] + v[j][1] * v[j][1]) + (v[j][2] * v[j][2] + v[j][3] * v[j][3]); }
        const float rr = rsqrtf(wave_sum(ss) * (1.0f / D) + EPS);
        const float* sh = MOD + ((size_t)l * 17 + mrow) * NMOD; const float* sc = sh + D;
#pragma unroll
        for (int j = 0; j < 4; ++j) { const int c = 4 * lane + 256 * j; const f32x4 w = *(const f32x4*)(nw + c), s1 = *(const f32x4*)(sc + c), s0 = *(const f32x4*)(sh + c);
            f32x4 h; for (int q = 0; q < 4; ++q) h[q] = v[j][q] * rr * w[q] * (1.0f + s1[q]) + s0[q];
            u32x2 o; o.x = cvt_pk_bf16(h[0], h[1]); o.y = cvt_pk_bf16(h[2], h[3]); *(u32x2*)(H + (size_t)row * D + c) = o; }
    }
}

__device__ __forceinline__ void phase_n2(const DArgs& a, int l, LAS unsigned char* ldsb, int tid, int wid, int lane, const int skip, const bool dry = false) {
    const float* MOD = (const float*)(a.ws + WS_MOD);
    const float* nw = a.in[I_NORM2] + (size_t)l * D;
    bf16_t* H = (bf16_t*)(a.ws + WS_H);
    const bf16_t* YATT = (const bf16_t*)(a.ws + WS_YATT);
    const float* wrg = a.in[I_WRG] + (size_t)l * D * 4; const float* wre = a.in[I_WRE] + (size_t)l * D * 16;
    const float* brg = a.in[I_BRG] + l * 4; const float* bre = a.in[I_BRE] + l * 16;
    float* ROUTEC = (float*)(a.ws + WS_ROUTEC); int* LIST = (int*)(a.ws + WS_LIST);
    unsigned* gcnt = (unsigned*)(a.ws + WS_CTL) + CW_CNT + 64 * l;
    LAS int* re = (LAS int*)(ldsb + LC_RE); LAS int* lcnt = (LAS int*)(ldsb + LC_LCNT);
    const int rpw = (T + (int)gridDim.x - 1) / (int)gridDim.x, row0 = blockIdx.x * rpw, row1 = (row0 + rpw < T) ? row0 + rpw : T;
    LAS float* wl = (LAS float*)ldsb;
    for (int i = tid; i < 1024 * 4; i += 512) { const int c = i >> 2, z = i & 3; wl[z * 1024 + c] = wrg[i]; }
    for (int i = tid; i < 1024 * 16; i += 512) { const int c = i >> 4, z = i & 15; wl[(4 + z) * 1024 + c] = wre[i]; }
    if (tid < 48) lcnt[tid] = 0;
    __syncthreads();
    f32x4 pg[2][4]; u32x2 pp[2][4], px[2][4];
    int ln = lane;
#define N2_PRELOAD(s_, rw) do { const int _b = (rw) / TPB, _r = (rw) - _b * TPB, _m = _r < CL ? 16 : _b; const bf16_t* _xp = xrow_ptr(a, (rw)); const float* _g = MOD + ((size_t)l * 17 + _m) * NMOD + 2 * D; \
        _Pragma("unroll") for (int j = 0; j < 4; ++j) { const int c = 4 * ln + 256 * j; px[s_][j] = *(const u32x2*)(_xp + c); pg[s_][j] = *(const f32x4*)(_g + c); pp[s_][j] = *(const u32x2*)(YATT + (size_t)(rw) * D + c); } } while (0)
    for (int row = row0 + wid; row < row1; row += 16) {
        asm volatile("" : "+v"(ln));
        const int rws[2] = {row, row + 8 < row1 ? row + 8 : row};
        N2_PRELOAD(0, rws[0]); N2_PRELOAD(1, rws[1]);
        f32x4 v[2][4];
        const float gs = dry ? 0.f : 1.f;
#pragma unroll
        for (int s2 = 0; s2 < 2; ++s2)
#pragma unroll
            for (int j = 0; j < 4; ++j) { const u32x2 xb = px[s2][j]; const f32x4 x = {bf_lo(xb.x), bf_hi(xb.x), bf_lo(xb.y), bf_hi(xb.y)}, g = pg[s2][j]; const u32x2 p = pp[s2][j];
                v[s2][j][0] = x[0] + gs * g[0] * bf_lo(p.x); v[s2][j][1] = x[1] + gs * g[1] * bf_hi(p.x); v[s2][j][2] = x[2] + gs * g[2] * bf_lo(p.y); v[s2][j][3] = x[3] + gs * g[3] * bf_hi(p.y); }
        bool act[2]; int mrow[2];
#pragma unroll
        for (int s2 = 0; s2 < 2; ++s2) { const int rw = rws[s2], b = rw / TPB, r = rw - b * TPB; mrow[s2] = r < CL ? 16 : b; const bool present = (s2 == 0) || (row + 8 < row1);
            act[s2] = present && !(skip && r < CL);
            if (present && skip && r < CL && lane == 0) { re[rw - row0] = -1; re[160 + rw - row0] = -1; } }
        if (!act[0] && !act[1]) continue;
        float rr[2];
#pragma unroll
        for (int s2 = 0; s2 < 2; ++s2) { float ss = 0.f;
#pragma unroll
            for (int j = 0; j < 4; ++j) ss += (v[s2][j][0] * v[s2][j][0] + v[s2][j][1] * v[s2][j][1]) + (v[s2][j][2] * v[s2][j][2] + v[s2][j][3] * v[s2][j][3]);
            rr[s2] = rsqrtf(wave_sum(ss) * (1.0f / D) + EPS); }
        f32x2 lg[2][20];
#pragma unroll
        for (int s2 = 0; s2 < 2; ++s2)
#pragma unroll
            for (int q = 0; q < 20; ++q) lg[s2][q] = (f32x2){0.f, 0.f};
#pragma unroll
        for (int j = 0; j < 4; ++j) { const int c = 4 * ln + 256 * j; const f32x4 w = *(const f32x4*)(nw + c);
            f32x4 h[2];
#pragma unroll
            for (int s2 = 0; s2 < 2; ++s2) { const float* sh = MOD + ((size_t)l * 17 + mrow[s2]) * NMOD + 3 * D; const f32x4 s1 = *(const f32x4*)(sh + D + c), s0 = *(const f32x4*)(sh + c);
#pragma unroll
                for (int q = 0; q < 4; ++q) h[s2][q] = v[s2][j][q] * rr[s2] * w[q] * (1.0f + s1[q]) + s0[q];
                { u32x2 o; o.x = cvt_pk_bf16(h[s2][0], h[s2][1]); o.y = cvt_pk_bf16(h[s2][2], h[s2][3]); *(u32x2*)(H + (size_t)rws[s2] * D + c) = o; } }
#pragma unroll
            for (int z = 0; z < 20; ++z) { const f32x4 w4 = *(const LAS f32x4*)(wl + z * 1024 + c); const f32x2 wa2 = {w4[0], w4[1]}, wb2 = {w4[2], w4[3]};
                lg[0][z] += (f32x2){h[0][0], h[0][1]} * wa2; lg[0][z] += (f32x2){h[0][2], h[0][3]} * wb2; lg[1][z] += (f32x2){h[1][0], h[1][1]} * wa2; lg[1][z] += (f32x2){h[1][2], h[1][3]} * wb2;
                if ((z & 3) == 3) asm volatile("" : "+v"(lg[0][z - 3]), "+v"(lg[0][z - 2]), "+v"(lg[0][z - 1]), "+v"(lg[0][z]), "+v"(lg[1][z - 3]), "+v"(lg[1][z - 2]), "+v"(lg[1][z - 1]), "+v"(lg[1][z])); }
            asm volatile("" ::: "memory"); }
#define N2_ROUTE(s2) if (act[s2]) { \
            const int rw = rws[s2]; \
            float lgs[20]; \
            _Pragma("unroll") for (int k4 = 0; k4 < 5; ++k4) { const float u4 = wave_sum4(lg[s2][4 * k4][0] + lg[s2][4 * k4][1], lg[s2][4 * k4 + 1][0] + lg[s2][4 * k4 + 1][1], lg[s2][4 * k4 + 2][0] + lg[s2][4 * k4 + 2][1], lg[s2][4 * k4 + 3][0] + lg[s2][4 * k4 + 3][1]); \
                lgs[4 * k4] = lane_val(u4, 0); lgs[4 * k4 + 2] = lane_val(u4, 16); lgs[4 * k4 + 1] = lane_val(u4, 32); lgs[4 * k4 + 3] = lane_val(u4, 48); } \
            float g0 = lgs[0] + brg[0], g1 = lgs[1] + brg[1], g2 = lgs[2] + brg[2], g3 = lgs[3] + brg[3]; \
            int gi = 0; float gm = g0; if (g1 > gm) { gm = g1; gi = 1; } if (g2 > gm) { gm = g2; gi = 2; } if (g3 > gm) { gm = g3; gi = 3; } \
            const float gtop = 1.0f / (expf(g0 - gm) + expf(g1 - gm) + expf(g2 - gm) + expf(g3 - gm)); \
            float e[4]; \
            _Pragma("unroll") \
            for (int i = 0; i < 4; ++i) { const float v0 = lgs[4 + i] + bre[i], v1 = lgs[8 + i] + bre[4 + i], v2 = lgs[12 + i] + bre[8 + i], v3 = lgs[16 + i] + bre[12 + i]; \
                e[i] = gi == 0 ? v0 : gi == 1 ? v1 : gi == 2 ? v2 : v3; } \
            int ia = 0; float va = e[0]; if (e[1] > va) { va = e[1]; ia = 1; } if (e[2] > va) { va = e[2]; ia = 2; } if (e[3] > va) { va = e[3]; ia = 3; } \
            int ib = -1; float vb = -3.0e38f; \
            _Pragma("unroll") \
            for (int i = 0; i < 4; ++i) if (i != ia && e[i] > vb) { vb = e[i]; ib = i; } \
            const float wa = 1.0f / (1.0f + expf(vb - va)), wb = 1.0f - wa; \
            if (lane == 0 && !dry) { const int e0 = gi * 4 + ia, e1 = gi * 4 + ib; const int li = rw - row0; re[li] = e0; re[160 + li] = e1; \
                ROUTEC[(size_t)rw * 2] = wa * gtop; ROUTEC[(size_t)rw * 2 + 1] = wb * gtop; \
                __hip_atomic_fetch_add(lcnt + e0, 1, __ATOMIC_RELAXED, __HIP_MEMORY_SCOPE_WORKGROUP); __hip_atomic_fetch_add(lcnt + e1, 1, __ATOMIC_RELAXED, __HIP_MEMORY_SCOPE_WORKGROUP); } \
        }
        N2_ROUTE(0) N2_ROUTE(1)
#undef N2_ROUTE
    }
#undef N2_PRELOAD
    __syncthreads();
    if (dry) return;
    if (tid < 16) { lcnt[16 + tid] = (int)__hip_atomic_fetch_add(gcnt + tid, (unsigned)lcnt[tid], __ATOMIC_RELAXED, __HIP_MEMORY_SCOPE_AGENT); }
    __syncthreads();
    const int nr = row1 - row0;
    if (tid < 2 * nr && re[(tid & 1) * 160 + (tid >> 1)] >= 0) { const int li = tid >> 1, rk = tid & 1; const int e = re[rk * 160 + li];
        const int p = lcnt[16 + e] + __hip_atomic_fetch_add(lcnt + 32 + e, 1, __ATOMIC_RELAXED, __HIP_MEMORY_SCOPE_WORKGROUP);
        LIST[(size_t)e * T + p] = ((row0 + li) << 1) | rk; }
    __syncthreads();
}

__device__ __forceinline__ void phase_final(const DArgs& a, int wid, int lane, float poison) {
    const int gw = blockIdx.x * 8 + wid, NGW = gridDim.x * 8;
    const float* MOD = (const float*)(a.ws + WS_MOD);
    const float* nw = a.in[I_FINALNORM];
    const int* SLOTOF = (const int*)(a.ws + WS_SLOTOF); const float* ROUTEC = (const float*)(a.ws + WS_ROUTEC); const bf16_t* YS = (const bf16_t*)(a.ws + WS_YS);
    int sl0 = 0, sl1 = 0; float cw0 = 0.f, cw1 = 0.f;
#define FN_ROW(q_) (((q_) / SEQ) * TPB + CL + ((q_) % SEQ))
    if (gw < NB * SEQ) { const int r0 = FN_ROW(gw); sl0 = SLOTOF[2 * (size_t)r0]; sl1 = SLOTOF[2 * (size_t)r0 + 1]; cw0 = ROUTEC[2 * (size_t)r0]; cw1 = ROUTEC[2 * (size_t)r0 + 1]; }
    for (int lr = gw; lr < NB * SEQ; lr += NGW) {
        const int b = lr / SEQ, row = b * TPB + CL + (lr - b * SEQ);
        const bf16_t* xp = xrow_ptr(a, row); float* op = a.out + (size_t)lr * D;
        const float* gt2 = MOD + ((size_t)(DEPTH - 1) * 17 + b) * NMOD + 5 * D; const float* gt1 = gt2 - 3 * D;
        const bf16_t* y0 = YS + (size_t)sl0 * D; const bf16_t* y1 = YS + (size_t)sl1 * D; const bf16_t* ya = (const bf16_t*)(a.ws + WS_YATT) + (size_t)row * D;
        const float c0 = cw0, c1 = cw1;
        if (lr + NGW < NB * SEQ) { const int rn = FN_ROW(lr + NGW); sl0 = SLOTOF[2 * (size_t)rn]; sl1 = SLOTOF[2 * (size_t)rn + 1]; cw0 = ROUTEC[2 * (size_t)rn]; cw1 = ROUTEC[2 * (size_t)rn + 1]; }
        f32x4 v[4]; float ss = 0.f;
#pragma unroll
        for (int j = 0; j < 4; ++j) { const int c = 4 * lane + 256 * j; const u32x2 xb = *(const u32x2*)(xp + c); f32x4 x = {bf_lo(xb.x), bf_hi(xb.x), bf_lo(xb.y), bf_hi(xb.y)}; const f32x4 g = *(const f32x4*)(gt2 + c), g1 = *(const f32x4*)(gt1 + c);
            const u32x2 p0 = *(const u32x2*)(y0 + c), p1 = *(const u32x2*)(y1 + c), pa = *(const u32x2*)(ya + c);
            x[0] += g1[0] * bf_lo(pa.x); x[1] += g1[1] * bf_hi(pa.x); x[2] += g1[2] * bf_lo(pa.y); x[3] += g1[3] * bf_hi(pa.y);
            v[j][0] = x[0] + g[0] * (c0 * bf_lo(p0.x) + c1 * bf_lo(p1.x)); v[j][1] = x[1] + g[1] * (c0 * bf_hi(p0.x) + c1 * bf_hi(p1.x));
            v[j][2] = x[2] + g[2] * (c0 * bf_lo(p0.y) + c1 * bf_lo(p1.y)); v[j][3] = x[3] + g[3] * (c0 * bf_hi(p0.y) + c1 * bf_hi(p1.y));
            ss += (v[j][0] * v[j][0] + v[j][1] * v[j][1]) + (v[j][2] * v[j][2] + v[j][3] * v[j][3]); }
        const float rr = rsqrtf(wave_sum(ss) * (1.0f / D) + EPS);
#pragma unroll
        for (int j = 0; j < 4; ++j) { const int c = 4 * lane + 256 * j; const f32x4 w = *(const f32x4*)(nw + c);
            f32x4 o; for (int q = 0; q < 4; ++q) o[q] = poison != 0.f ? poison : v[j][q] * rr * w[q];
            *(f32x4*)(op + c) = o; }
    }
}

struct SchedInproj {
    const char* H; const char* W; int G, w, nA, skip;
    __device__ __forceinline__ bool next(int i, Unit& u) const {
        int L; if (i < 4) L = i * G + w; else { if (w < nA) return false; L = 4 * G + (i - 4) * (G - nA) + (w - nA); }
        const int nMn = skip ? 32 : 36;
        if (L < nMn * 28) { int pm, pi; pg8::tile_map(L, nMn, 28, pm, pi); if (skip) pm = (pm >> 3) * 9 + 1 + (pm & 7); const int wt = pi < 4 ? pi : pi + 4;
            u.a = H + (size_t)pm * 256 * 2048; u.b = W + (size_t)wt * 256 * 2048; u.pm = pm; u.pn = wt; u.kind = 0; u.nt = 16; u.cont = 0; return true; }
        L -= nMn * 28;
        if (L < 6 * 36) { int pi, pn; pg8::tile_map(L, 6, 36, pi, pn); const int wt = pi + 2;
            u.a = W + (size_t)wt * 256 * 2048; u.b = H + (size_t)pn * 256 * 2048; u.pm = wt; u.pn = pn; u.kind = 1; u.nt = 16; u.cont = 0; return true; }
        return false;
    }
};
struct EpiInproj {
    static constexpr bool PERM = true;
    unsigned char* ws; const float* lg2;
    const float* ropec; const float* ropes; bf16_t* gate;
    template <int ACT> __device__ __forceinline__ void plain(const f32x4 (&acc)[2][2][4][2], bf16_t* dst, int ld, int row0, int col0) const {
#pragma unroll
        for (int ai = 0; ai < 2; ++ai)
#pragma unroll
            for (int m = 0; m < 4; ++m) { bf16_t* rowp = dst + (size_t)(row0 + ai * 128 + m * 16) * ld + col0;
#pragma unroll
                for (int bj = 0; bj < 2; ++bj) { f32x4 v0 = acc[ai][bj][m][0], v1 = acc[ai][bj][m][1];
                    if (ACT == 1) { for (int q = 0; q < 4; ++q) { v0[q] = silu_f(v0[q]); v1[q] = silu_f(v1[q]); } }
                    if (ACT == 2) { for (int q = 0; q < 4; ++q) { v0[q] = sigmoid_f(v0[q]); v1[q] = sigmoid_f(v1[q]); } }
                    *(u32x4*)(rowp + bj * 128) = pack8(v0, v1); } }
    }
    __device__ __forceinline__ void operator()(const f32x4 (&acc)[2][2][4][2], const Unit& u, int wr, int wc, int fr, int fq) const {
        if (u.kind == 0) {
            const int wt = u.pn, row0 = u.pm * 256 + wr * 64 + fr, cl = wc * 32 + 8 * fq;
            if (wt < 4) {
                const int isk = wt >> 1, t = wt & 1, head = 2 * t + (wc >> 1), idx0 = 32 * (wc & 1) + 8 * fq;
                bf16_t* dA = (bf16_t*)(ws + (isk ? WS_KF : WS_QF));
#pragma unroll
                for (int ai = 0; ai < 2; ++ai)
#pragma unroll
                    for (int m = 0; m < 4; ++m) {
                        const int gr = row0 + ai * 128 + m * 16, r = gr % TPB;
                        f32x4 c0 = {1.f, 1.f, 1.f, 1.f}, c1 = c0, s0 = {0.f, 0.f, 0.f, 0.f}, s1 = s0;
                        if (r >= CL) { const int pos = r - CL, v = (wc & 1) ? (pos & 63) : (pos >> 6); const float* cp = ropec + v * 32 + 8 * fq; const float* sp = ropes + v * 32 + 8 * fq;
                            c0 = *(const f32x4*)cp; c1 = *(const f32x4*)(cp + 4); s0 = *(const f32x4*)sp; s1 = *(const f32x4*)(sp + 4); }
                        const f32x4 x10 = acc[ai][0][m][0], x11 = acc[ai][0][m][1], x20 = acc[ai][1][m][0], x21 = acc[ai][1][m][1];
                        const f32x4 o10 = x10 * c0 - x20 * s0, o11 = x11 * c1 - x21 * s1, o20 = x10 * s0 + x20 * c0, o21 = x11 * s1 + x21 * c1;
                        bf16_t* pa = dA + (size_t)gr * 512 + head * 128 + idx0;
                        *(u32x4*)pa = pack8(o10, o11); *(u32x4*)(pa + 64) = pack8(o20, o21);
                    }
            } else if (wt < 12) plain<1>(acc, (bf16_t*)(ws + WS_GS), 1024, row0, (wt - 8) * 256 + cl);
            else if (wt < 14) plain<0>(acc, (bf16_t*)(ws + WS_CB), 512, row0, (wt - 12) * 256 + cl);
            else if (wt < 18) { bf16_t* dst = (bf16_t*)(ws + WS_CU);
#pragma unroll
                for (int ai = 0; ai < 2; ++ai)
#pragma unroll
                    for (int m = 0; m < 4; ++m)
                        *(u32x4*)(dst + (size_t)(row0 + ai * 128 + m * 16) * 512 + (wt - 14) * 128 + cl) = pack8(acc[ai][0][m][0] * acc[ai][1][m][0], acc[ai][0][m][1] * acc[ai][1][m][1]);
            } else if (wt < 20) plain<0>(acc, (bf16_t*)(ws + WS_PI), 512, row0, (wt - 18) * 256 + cl);
            else {
                unsigned char* gp = (unsigned char*)gate + (size_t)((wt - 20) >> 2) * TG * 1024 + ((wt - 20) & 3) * 256 + (wc * 4 + fq) * 16;
#pragma unroll
                for (int ai = 0; ai < 2; ++ai)
#pragma unroll
                    for (int m = 0; m < 4; ++m) { u32x4 w;
#pragma unroll
                        for (int bj = 0; bj < 2; ++bj) { unsigned lo = 0u, hi = 0u;
#pragma unroll
                            for (int q = 0; q < 4; ++q) { lo |= (unsigned)(sigmoid_f(acc[ai][bj][m][0][q]) * 255.0f + 0.5f) << (8 * q); hi |= (unsigned)(sigmoid_f(acc[ai][bj][m][1][q]) * 255.0f + 0.5f) << (8 * q); }
                            if (bj == 0) { w.x = lo; w.y = hi; } else { w.z = lo; w.w = hi; } }
                        *(u32x4*)(gp + (size_t)(row0 + ai * 128 + m * 16) * 1024) = w; }
            }
        } else {
            const int wt = u.pm, tok0 = u.pn * 256 + wc * 32 + 8 * fq;
            if (wt < 4) {
                const int t = wt - 2, head = 2 * t + wr; const float lgf = lg2[head], lgb = lg2[4 + head];
                bf16_t* dF = (bf16_t*)(ws + WS_KTF); bf16_t* dB = (bf16_t*)(ws + WS_KTB);
#pragma unroll
                for (int m = 0; m < 4; ++m) { const int idx = 16 * m + fr;
#pragma unroll
                    for (int bj = 0; bj < 2; ++bj) { f32x4 o1[2], o2[2], sF[2], sB[2];
#pragma unroll
                        for (int n = 0; n < 2; ++n) { const int g0 = tok0 + bj * 128 + 4 * n, r0 = g0 % TPB; const f32x4 x1 = acc[0][bj][m][n], x2 = acc[1][bj][m][n];
                            f32x4 cs = {1.f, 1.f, 1.f, 1.f}, sn = {0.f, 0.f, 0.f, 0.f};
                            if (r0 >= CL) { const int pos = r0 - CL;
                                if (m < 2) { const float c = ropec[(pos >> 6) * 32 + idx], s = ropes[(pos >> 6) * 32 + idx]; cs = (f32x4){c, c, c, c}; sn = (f32x4){s, s, s, s}; }
                                else { const int v = pos & 63;
#pragma unroll
                                    for (int j = 0; j < 4; ++j) { cs[j] = ropec[(v + j) * 32 + idx - 32]; sn[j] = ropes[(v + j) * 32 + idx - 32]; } } }
                            o1[n] = x1 * cs - x2 * sn; o2[n] = x1 * sn + x2 * cs;
#pragma unroll
                            for (int j = 0; j < 4; ++j) { const float fi = (float)((g0 + j) & 127); sF[n][j] = __builtin_amdgcn_exp2f(-fi * lgf); sB[n][j] = __builtin_amdgcn_exp2f(fi * lgb); } }
                        const size_t r1 = (size_t)(head * 128 + idx) * TG + tok0 + bj * 128, r2 = r1 + (size_t)64 * TG;
                        *(u32x4*)(dF + r1) = pack8(o1[0] * sF[0], o1[1] * sF[1]); *(u32x4*)(dF + r2) = pack8(o2[0] * sF[0], o2[1] * sF[1]);
                        *(u32x4*)(dB + r1) = pack8(o1[0] * sB[0], o1[1] * sB[1]); *(u32x4*)(dB + r2) = pack8(o2[0] * sB[0], o2[1] * sB[1]);
                    } }
            } else {
                bf16_t* dst = (bf16_t*)(ws + WS_VT); const int e0 = (wt - 4) * 256 + wr * 64 + fr;
#pragma unroll
                for (int ai = 0; ai < 2; ++ai)
#pragma unroll
                    for (int m = 0; m < 4; ++m)
#pragma unroll
                        for (int bj = 0; bj < 2; ++bj) *(u32x4*)(dst + (size_t)(e0 + ai * 128 + m * 16) * TG + tok0 + bj * 128) = pack8(acc[ai][bj][m][0], acc[ai][bj][m][1]);
            }
        }
    }
};

struct SchedPlain {
    const char* A; const char* B; size_t astep, bstep; int nM, nN, G, c, skip;
    __device__ __forceinline__ bool next(int i, Unit& u) const {
        const int L = i * G + c; if (L >= nM * nN) return false;
        int pm, pn; pg8::tile_map(L, nM, nN, pm, pn); if (skip) pm = (pm >> 3) * 9 + 1 + (pm & 7);
        u.a = A + (size_t)pm * astep; u.b = B + (size_t)pn * bstep; u.pm = pm; u.pn = pn; u.kind = 0; u.nt = 0; u.cont = 0; return true;
    }
};
struct SchedG4 {
    const char* YRET; const char* YCP; const char* WRET; const char* WCP; int nM, G, c, skip;
    __device__ __forceinline__ bool next(int i, Unit& u) const {
        const int mac = i / 3, sub = i - mac * 3, L = mac * G + c; if (L >= nM * 4) return false;
        int pm, pn; pg8::tile_map(L, nM, 4, pm, pn); if (skip) pm = (pm >> 3) * 9 + 1 + (pm & 7);
        const size_t ao = (size_t)pm * 256 * 2048, bo = (size_t)pn * 256 * 2048;
        u.a = sub == 0 ? YRET + ao : YCP + ao + (sub == 2 ? 1024 : 0); u.b = sub == 0 ? WRET + bo : WCP + bo + (sub == 2 ? 1024 : 0);
        u.pm = pm; u.pn = pn; u.kind = sub; u.nt = sub == 0 ? 16 : 8; u.cont = sub != 2; return true;
    }
};
struct EpiG4 {
    static constexpr bool PERM = true;
    const unsigned char* gate;    bf16_t* merged;
    __device__ __forceinline__ void operator()(f32x4 (&acc)[2][2][4][2], const Unit& u, int wr, int wc, int fr, int fq) const {
        const int row0 = u.pm * 256 + wr * 64 + fr, col0 = u.pn * 256 + wc * 32 + 8 * fq, k = u.kind;
        const unsigned char* gk = gate + (size_t)k * TG * 1024 + u.pn * 256 + (wc * 4 + fq) * 16;
#pragma unroll
        for (int ai = 0; ai < 2; ++ai)
#pragma unroll
            for (int m = 0; m < 4; ++m) { const int row = row0 + ai * 128 + m * 16;
                const u32x4 g = *(const u32x4*)(gk + (size_t)row * 1024); u32x4 h = g; if (k < 2) h = *(const u32x4*)(gk + (size_t)TG * 1024 + (size_t)row * 1024);
#pragma unroll
                for (int bj = 0; bj < 2; ++bj) { const int col = col0 + bj * 128;
                    const unsigned g0 = bj ? g.z : g.x, g1 = bj ? g.w : g.y, h0 = bj ? h.z : h.x, h1 = bj ? h.w : h.y;
                    f32x4 v0 = acc[ai][bj][m][0], v1 = acc[ai][bj][m][1];
#pragma unroll
                    for (int q = 0; q < 4; ++q) {
                        const float n0 = fmaxf((float)((g0 >> (8 * q)) & 255u), 2.55e-16f), n1 = fmaxf((float)((g1 >> (8 * q)) & 255u), 2.55e-16f);
                        const float d0 = fmaxf((float)((h0 >> (8 * q)) & 255u), 2.55e-16f), d1 = fmaxf((float)((h1 >> (8 * q)) & 255u), 2.55e-16f);
                        v0[q] *= k < 2 ? n0 * __builtin_amdgcn_rcpf(d0) : n0 * (1.0f / 255.0f); v1[q] *= k < 2 ? n1 * __builtin_amdgcn_rcpf(d1) : n1 * (1.0f / 255.0f); }
                    if (k < 2) { acc[ai][bj][m][0] = v0; acc[ai][bj][m][1] = v1; }
                    else *(u32x4*)(merged + (size_t)row * 1024 + col) = pack8(v0, v1); } }
    }
};
struct EpiPlainBf16 {
    static constexpr bool PERM = true;
    bf16_t* O; int ld;
    __device__ __forceinline__ void operator()(const f32x4 (&acc)[2][2][4][2], const Unit& u, int wr, int wc, int fr, int fq) const {
        const int row0 = u.pm * 256 + wr * 64 + fr, col0 = u.pn * 256 + wc * 32 + 8 * fq;
#pragma unroll
        for (int ai = 0; ai < 2; ++ai)
#pragma unroll
            for (int m = 0; m < 4; ++m)
#pragma unroll
                for (int bj = 0; bj < 2; ++bj) *(u32x4*)(O + (size_t)(row0 + ai * 128 + m * 16) * ld + col0 + bj * 128) = pack8(acc[ai][bj][m][0], acc[ai][bj][m][1]);
    }
};

struct SchedMoe {
    const char* A; const char* W; size_t astep, wrow; const LAS int* tile_e; int ntiles, G, c;
    __device__ __forceinline__ bool next(int i, Unit& u) const {
        const int L = i * G + c; if (L >= ntiles * 4) return false;
        int tile, pn; pg8::tile_map(L, ntiles, 4, tile, pn); const int e = tile_e[tile];
        u.a = A + (size_t)tile * astep; u.b = W + ((size_t)e * 1024 + pn * 256) * wrow; u.pm = tile; u.pn = pn; u.kind = e; u.nt = 0; u.cont = 0; return true;
    }
};
struct SchedMoeG {
    const char* A; const char* W; const LAS int* tile_e; const LAS int* cnt; const LAS int* poff; const int* LIST; LAS int* tbl; int ntiles, G, c;
    __device__ __forceinline__ bool next(int i, Unit& u) const {
        const int L = i * G + c; if (L >= ntiles * 4) return false;
        int tile, pn; pg8::tile_map(L, ntiles, 4, tile, pn); const int e = tile_e[tile];
        u.a = A; u.b = W + ((size_t)e * 1024 + pn * 256) * 2048; u.pm = tile; u.pn = pn; u.kind = e; u.nt = 0; u.cont = 0; return true;
    }
    __device__ __forceinline__ void fill_table(const Unit& u, int buf, int tid) const {
        if (tid < 256) { const int e = u.kind; const int* src = LIST + (size_t)e * T + (u.pm * 256 - poff[e]) + tid;
            __builtin_amdgcn_global_load_lds((const unsigned*)src, (LAS unsigned*)(tbl + buf * 256 + (tid & ~63)), 4, 0, 0); }
    }
    __device__ __forceinline__ void load_offsets(const Unit& u, int buf, const int (&gR)[2], const int (&gC2)[2], unsigned (&vo0)[2], unsigned (&vo1)[2]) const {
        const int e = u.kind, pb = u.pm * 256 - poff[e], n = cnt[e];
#pragma unroll
        for (int i = 0; i < 2; ++i) { const int r0 = gR[i], r1 = 128 + gR[i]; const int e0 = tbl[buf * 256 + r0], e1 = tbl[buf * 256 + r1];
            vo0[i] = (unsigned)((pb + r0 < n) ? (e0 >> 1) : 0) * 2048u + (unsigned)gC2[i]; vo1[i] = (unsigned)((pb + r1 < n) ? (e1 >> 1) : 0) * 2048u + (unsigned)gC2[i]; }
    }
};
namespace pg8 { template <> struct sched_gather<SchedMoeG> { static constexpr bool value = true; }; }
struct EpiMoeUp {
    static constexpr bool PERM = true;
    bf16_t* ACT;
    __device__ __forceinline__ void operator()(const f32x4 (&acc)[2][2][4][2], const Unit& u, int wr, int wc, int fr, int fq) const {
        const int row0 = u.pm * 256 + wr * 64 + fr, col0 = u.pn * 128 + wc * 32 + 8 * fq;
#pragma unroll
        for (int ai = 0; ai < 2; ++ai)
#pragma unroll
            for (int m = 0; m < 4; ++m) { f32x4 v0, v1;
#pragma unroll
                for (int q = 0; q < 4; ++q) { v0[q] = silu_fast(acc[ai][0][m][0][q]) * acc[ai][1][m][0][q]; v1[q] = silu_fast(acc[ai][0][m][1][q]) * acc[ai][1][m][1][q]; }
                *(u32x4*)(ACT + (size_t)(row0 + ai * 128 + m * 16) * 512 + col0) = pack8(v0, v1); }
    }
};

template <int NROWS, bool PERMROWS>
__device__ __forceinline__ void dma_tile(LAS unsigned char* ldst, const char* gsrc, size_t row_stride, int tid) {
#pragma unroll
    for (int i = 0; i < NROWS * 16 / 512; ++i) {
        const int q = tid + 512 * i, row = q >> 4, cg = q & 15;
        const int srow = PERMROWS ? ((row & ~31) + pg8::perm32(row & 31)) : row;
        const char* src = gsrc + (size_t)srow * row_stride + ((cg ^ (row & 15)) << 4);
        __builtin_amdgcn_global_load_lds((const unsigned*)src, (LAS unsigned*)(ldst + ((tid & ~63) + 512 * i) * 16), 16, 0, 0);
    }
}
__device__ __forceinline__ bf16x8 lds_frag(const LAS unsigned char* base, int row, int gk) { return *(const LAS bf16x8*)(base + row * 256 + ((gk ^ (row & 15)) << 4)); }

#ifndef CP_DEFER_PCT
#define CP_DEFER_PCT 50
#endif
#ifndef CP_DEFER_PCT_LAST
#define CP_DEFER_PCT_LAST 10
#endif
constexpr int CP_TOTAL = TG * 16 + TG * 16;
constexpr int CP_DEFER_A = (CP_TOTAL / 100 * CP_DEFER_PCT) / 512 * 512, CP_DEFER_B = (CP_TOTAL / 100 * CP_DEFER_PCT_LAST) / 512 * 512;
#define CP_DEFER (skipctx ? CP_DEFER_B : CP_DEFER_A)
constexpr int NCHAIN = BG * 4 * 2 * 4;
template <int NROWS>
__device__ __forceinline__ void dma_tile128(LAS unsigned char* ldst, const char* gsrc, size_t row_stride, int tid) {
#pragma unroll
    for (int i = 0; i < NROWS * 8 / 512; ++i) {
        const int q = tid + 512 * i, row = q >> 3, cg = q & 7;
        const char* src = gsrc + (size_t)row * row_stride + ((cg ^ ((row >> 1) & 7)) << 4);
        __builtin_amdgcn_global_load_lds((const unsigned*)src, (LAS unsigned*)(ldst + ((tid & ~63) + 512 * i) * 16), 16, 0, 0);
    }
}
__device__ __forceinline__ bf16x8 lds_frag128(const LAS unsigned char* base, int row, int gk) { return *(const LAS bf16x8*)(base + row * 128 + ((gk ^ ((row >> 1) & 7)) << 4)); }

__device__ __forceinline__ void chain_unit(const DArgs& a, int unit, const float* lg2p, LAS unsigned char* lds, int tid, int wid, int lane) {
    const int eq = unit & 3, dir = (unit >> 2) & 1, h = (unit >> 3) & 3, bb = unit >> 5, fr = lane & 15, fq = lane >> 4;
    const char* VT = (const char*)(a.ws + WS_VT) + (size_t)(h * 256 + eq * 64) * TG * 2;
    const char* KT = (const char*)(a.ws + (dir ? WS_KTB : WS_KTF)) + (size_t)(h * 128) * TG * 2;
    bf16_t* ST = (bf16_t*)(a.ws + WS_STATES) + ((size_t)((bb * 4 + h) * 2 + dir) * NCH) * 256 * 128;
    const float dec = exp2f(128.0f * lg2p[dir * 4 + h]);
    f32x4 acc[4];
#pragma unroll
    for (int m = 0; m < 4; ++m) acc[m] = (f32x4){0.f, 0.f, 0.f, 0.f};
#define CH_ORDER(s) (dir == 0 ? (s) : ((s) < 2 ? 1 - (s) : 19 - (s)))
#define CH_LOAD(hs) do { const int _h = (hs) < 2 * NCH ? (hs) : 2 * NCH - 1; const int _c = CH_ORDER(_h >> 1); const size_t _tb = (size_t)(bb * TPB + _c * 128 + (_h & 1) * 64) * 2; \
        LAS unsigned char* _sl = lds + ((hs) % 5) * 24576; dma_tile128<64>(_sl, VT + _tb, (size_t)TG * 2, tid); dma_tile128<128>(_sl + 8192, KT + _tb, (size_t)TG * 2, tid); } while (0)
#define CH_MMA(hs) do { const LAS unsigned char* buf = lds + ((hs) % 5) * 24576; bf16x8 kf_[2], vf_[2][4];     \
        _Pragma("unroll") for (int ks = 0; ks < 2; ++ks) { kf_[ks] = lds_frag128(buf + 8192, wid * 16 + fr, 4 * ks + fq); \
            _Pragma("unroll") for (int m = 0; m < 4; ++m) vf_[ks][m] = lds_frag128(buf, 16 * m + fr, 4 * ks + fq); } \
        LDS_WAIT(); __builtin_amdgcn_sched_barrier(0); \
        _Pragma("unroll") for (int ks = 0; ks < 2; ++ks) \
            _Pragma("unroll") for (int m = 0; m < 4; ++m) acc[m] = __builtin_amdgcn_mfma_f32_16x16x32_bf16(kf_[ks], vf_[ks][m], acc[m], 0, 0, 0); } while (0)
#define CH_SYNC() do { asm volatile("s_waitcnt vmcnt(11)" ::: "memory"); LDS_WAIT(); __builtin_amdgcn_s_barrier(); asm volatile("" ::: "memory"); } while (0)
    CH_LOAD(0); CH_LOAD(1); CH_LOAD(2); CH_LOAD(3);
    asm volatile("s_waitcnt vmcnt(9)" ::: "memory"); LDS_WAIT(); __builtin_amdgcn_s_barrier(); asm volatile("" ::: "memory");
    for (int s = 0; s < NCH; ++s) {
        const int hs = 2 * s;
        if (s > 0) CH_SYNC();
        u32x2 pub[4];
#pragma unroll
        for (int m = 0; m < 4; ++m) { acc[m] = acc[m] * dec; pub[m].x = cvt_pk_bf16(acc[m][0], acc[m][1]); pub[m].y = cvt_pk_bf16(acc[m][2], acc[m][3]); }
        CH_LOAD(hs + 4);
        CH_MMA(hs);
        {
            const int _c = CH_ORDER(s); bf16_t* sp = ST + (size_t)_c * 256 * 128 + (size_t)(eq * 64 + 16 * (fq & 1) + fr) * 128 + wid * 16 + 8 * (fq >> 1);
#pragma unroll
            for (int mp = 0; mp < 2; ++mp) { unsigned ax = pub[2 * mp].x, ay = pub[2 * mp].y, bx = pub[2 * mp + 1].x, by = pub[2 * mp + 1].y;
                asm volatile("s_nop 1\n\tv_permlane16_swap_b32 %0, %1\n\tv_permlane16_swap_b32 %2, %3\n\ts_nop 1" : "+v"(ax), "+v"(bx), "+v"(ay), "+v"(by));
                const u32x4 w = {ax, ay, bx, by}; *(u32x4*)(sp + (size_t)mp * 32 * 128) = w; }
        }
        CH_SYNC();
        CH_MMA(hs + 1);
        CH_LOAD(hs + 5);
    }
    asm volatile("s_waitcnt vmcnt(0)" ::: "memory"); LDS_WAIT(); __builtin_amdgcn_s_barrier(); asm volatile("" ::: "memory");
#undef CH_ORDER
#undef CH_LOAD
#undef CH_MMA
#undef CH_SYNC
}
__device__ __forceinline__ void conv_pool(const DArgs& a, int l, int worker, int nworkers, int tid, const int skip, const int it0, const int it1) {
    const bf16_t* CU = (const bf16_t*)(a.ws + WS_CU); const bf16_t* CBp = (const bf16_t*)(a.ws + WS_CB); const bf16_t* PI = (const bf16_t*)(a.ws + WS_PI);
    bf16_t* YCONV = (bf16_t*)(a.ws + WS_YCONV); bf16_t* POOLED = (bf16_t*)(a.ws + WS_POOLED);
    const float* cw = a.in[I_CONVW] + (size_t)l * 3 * 512;
    const int nitem = TG * 16;
    for (int it = it0 + worker * 512 + tid; it < it1; it += nworkers * 512) {
        const int ispool = it >= nitem, q = ispool ? it - nitem : it;
        if (!ispool) {
            const int c0 = (q & 63) * 8, gr0 = (q >> 6) * 4;
            const int r = gr0 % TPB, lo = r < CL ? 0 : CL, hi = r < CL ? CL : TPB;
            if (skip && r < CL) continue;
            u32x4 u[6], bv[4];
            u[0] = (u32x4){0u, 0u, 0u, 0u}; u[5] = u[0];
            if (r > lo) u[0] = *(const u32x4*)(CU + (size_t)(gr0 - 1) * 512 + c0);
#pragma unroll
            for (int j = 0; j < 4; ++j) { u[1 + j] = *(const u32x4*)(CU + (size_t)(gr0 + j) * 512 + c0); bv[j] = *(const u32x4*)(CBp + (size_t)(gr0 + j) * 512 + c0); }
            if (r + 4 < hi) u[5] = *(const u32x4*)(CU + (size_t)(gr0 + 4) * 512 + c0);
            const f32x4 w00 = *(const f32x4*)(cw + c0), w01 = *(const f32x4*)(cw + c0 + 4), w10 = *(const f32x4*)(cw + 512 + c0), w11 = *(const f32x4*)(cw + 512 + c0 + 4),
                        w20 = *(const f32x4*)(cw + 1024 + c0), w21 = *(const f32x4*)(cw + 1024 + c0 + 4);
#pragma unroll
            for (int j = 0; j < 4; ++j) { const u32x4 u0 = u[j], u1 = u[j + 1], u2 = u[j + 2], b = bv[j]; f32x4 o0, o1;
                o0[0] = bf_lo(b.x) * (w00[0] * bf_lo(u0.x) + w10[0] * bf_lo(u1.x) + w20[0] * bf_lo(u2.x)); o0[1] = bf_hi(b.x) * (w00[1] * bf_hi(u0.x) + w10[1] * bf_hi(u1.x) + w20[1] * bf_hi(u2.x));
                o0[2] = bf_lo(b.y) * (w00[2] * bf_lo(u0.y) + w10[2] * bf_lo(u1.y) + w20[2] * bf_lo(u2.y)); o0[3] = bf_hi(b.y) * (w00[3] * bf_hi(u0.y) + w10[3] * bf_hi(u1.y) + w20[3] * bf_hi(u2.y));
                o1[0] = bf_lo(b.z) * (w01[0] * bf_lo(u0.z) + w11[0] * bf_lo(u1.z) + w21[0] * bf_lo(u2.z)); o1[1] = bf_hi(b.z) * (w01[1] * bf_hi(u0.z) + w11[1] * bf_hi(u1.z) + w21[1] * bf_hi(u2.z));
                o1[2] = bf_lo(b.w) * (w01[2] * bf_lo(u0.w) + w11[2] * bf_lo(u1.w) + w21[2] * bf_lo(u2.w)); o1[3] = bf_hi(b.w) * (w01[3] * bf_hi(u0.w) + w11[3] * bf_hi(u1.w) + w21[3] * bf_hi(u2.w));
                *(u32x4*)(YCONV + (size_t)(gr0 + j) * 1024 + c0) = pack8(o0, o1); }
        } else {
            const int cbl = q & 15; const int rest = q >> 4; const int g2 = rest / (TG / 4), gr0 = 4 * (rest - g2 * (TG / 4)), cc0 = g2 * 128 + cbl * 8;
            const int r0 = gr0 % TPB, lo2 = r0 < CL ? 0 : CL, hi2 = r0 < CL ? CL : TPB, base2 = gr0 - r0, tl0 = r0 - lo2, n = hi2 - lo2;
            if (skip && r0 < CL) continue;
            const int win = 2 << g2, hw = win >> 1;
            f32x4 s0[4], s1[4]; u32x4 pc[4];
#pragma unroll
            for (int j = 0; j < 4; ++j) { s0[j] = (f32x4){0.f, 0.f, 0.f, 0.f}; s1[j] = s0[j]; pc[j] = (u32x4){0u, 0u, 0u, 0u}; }
            const bf16_t* prow = PI + (size_t)(base2 + lo2) * 512 + cc0;
#pragma unroll
            for (int k = 0; k < 19; ++k) { const int sidx = tl0 - hw + k;
                if (k < win + 3 && sidx >= 0 && sidx < n) { const u32x4 p = *(const u32x4*)(prow + (size_t)sidx * 512);
                    const f32x4 f0 = {bf_lo(p.x), bf_hi(p.x), bf_lo(p.y), bf_hi(p.y)}, f1 = {bf_lo(p.z), bf_hi(p.z), bf_lo(p.w), bf_hi(p.w)};
#pragma unroll
                    for (int j = 0; j < 4; ++j) { if (k >= j && k - j < win) { s0[j] += f0; s1[j] += f1; } if (k - j == hw) pc[j] = p; } } }
#pragma unroll
            for (int j = 0; j < 4; ++j) { const int tl = tl0 + j; int sa = tl - hw; if (sa < 0) sa = 0; int sb = tl + win - hw; if (sb > n) sb = n;
                const float inv = 1.0f / (float)(sb - sa); const u32x4 p = pc[j]; f32x4 o0, o1;
                o0[0] = s0[j][0] * inv - bf_lo(p.x); o0[1] = s0[j][1] * inv - bf_hi(p.x); o0[2] = s0[j][2] * inv - bf_lo(p.y); o0[3] = s0[j][3] * inv - bf_hi(p.y);
                o1[0] = s1[j][0] * inv - bf_lo(p.z); o1[1] = s1[j][1] * inv - bf_hi(p.z); o1[2] = s1[j][2] * inv - bf_lo(p.w); o1[3] = s1[j][3] * inv - bf_hi(p.w);
                *(u32x4*)(YCONV + (size_t)(gr0 + j) * 1024 + 512 + cc0) = pack8(o0, o1); }
        }
    }
}

__device__ __forceinline__ void finalize_unit(const DArgs& a, int unit, const float* lg2p, LAS unsigned char* lds, int tid, int wid, int lane) {
    asm volatile("" : "+v"(tid)); lane = tid & 63;
    const int c = unit % NCH, h = (unit / NCH) & 3, bb = unit / (NCH * 4), fr = lane & 15, fq = lane >> 4;
    const int tok0 = bb * TPB + c * 128;
    const float lgf = lg2p[h], lgb = lg2p[4 + h];
    LAS unsigned char* R0 = lds; LAS unsigned char* R1 = lds + 65536;
    const char* QF = (const char*)(a.ws + WS_QF);
    dma_tile<128, false>(R0, (const char*)(a.ws + WS_KF) + ((size_t)tok0 * 512 + h * 128) * 2, 1024, tid);
    bf16x8 qf[4];
    { const size_t ro = ((size_t)(tok0 + wid * 16 + fr) * 512 + h * 128 + 8 * fq) * 2;
#pragma unroll
      for (int ks = 0; ks < 4; ++ks) qf[ks] = *(const bf16x8*)(QF + ro + ks * 64); }
    asm volatile("" ::: "memory");
    const char* ST = (const char*)(a.ws + WS_STATES) + ((size_t)((bb * 4 + h) * 2) * NCH + c) * 256 * 128 * 2;
    dma_tile<128, true>(R0 + 32768, ST, 256, tid);
    dma_tile<256, true>(R1, (const char*)(a.ws + WS_VT) + ((size_t)(h * 256) * TG + tok0) * 2, (size_t)TG * 2, tid);
    asm volatile("s_waitcnt vmcnt(12)" ::: "memory"); __builtin_amdgcn_s_barrier(); asm volatile("" ::: "memory");
    bf16x8 pf[4];
    const int i = wid * 16 + fr;
    {
        f32x4 sc[8];
#pragma unroll
        for (int n = 0; n < 8; ++n) sc[n] = (f32x4){0.f, 0.f, 0.f, 0.f};
#pragma unroll
        for (int k2 = 0; k2 < 2; ++k2) { bf16x8 kfr[2][8];
#pragma unroll
            for (int kk = 0; kk < 2; ++kk)
#pragma unroll
                for (int n = 0; n < 8; ++n) kfr[kk][n] = lds_frag(R0, 16 * n + fr, 4 * (2 * k2 + kk) + fq);
            LDS_WAIT(); __builtin_amdgcn_sched_barrier(0);
#pragma unroll
            for (int kk = 0; kk < 2; ++kk)
#pragma unroll
                for (int n = 0; n < 8; ++n) sc[n] = __builtin_amdgcn_mfma_f32_16x16x32_bf16(kfr[kk][n], qf[2 * k2 + kk], sc[n], 0, 0, 0); }
#pragma unroll
        for (int n = 0; n < 8; ++n)
#pragma unroll
            for (int jj = 0; jj < 4; ++jj) { const int d = i - (16 * n + 4 * fq + jj); const float w = d == 0 ? 2.0f : __builtin_amdgcn_exp2f(d > 0 ? lgf * (float)d : lgb * (float)(-d)); sc[n][jj] *= w; }
#pragma unroll
        for (int ks = 0; ks < 4; ++ks) { u32x4 w; w.x = cvt_pk_bf16(sc[2 * ks][0], sc[2 * ks][1]); w.y = cvt_pk_bf16(sc[2 * ks][2], sc[2 * ks][3]);
            w.z = cvt_pk_bf16(sc[2 * ks + 1][0], sc[2 * ks + 1][1]); w.w = cvt_pk_bf16(sc[2 * ks + 1][2], sc[2 * ks + 1][3]);
            asm volatile("s_nop 1\n\tv_permlane16_swap_b32 %0, %1\n\tv_permlane16_swap_b32 %2, %3\n\ts_nop 1" : "+v"(w.x), "+v"(w.z), "+v"(w.y), "+v"(w.w));
            pf[ks] = __builtin_bit_cast(bf16x8, w); }
    }
    asm volatile("s_waitcnt vmcnt(0)" ::: "memory"); LDS_WAIT(); __builtin_amdgcn_s_barrier(); asm volatile("" ::: "memory");
    dma_tile<128, true>(R0, ST + (size_t)128 * 256, 256, tid);
    f32x4 o[16];
#pragma unroll
    for (int n = 0; n < 16; ++n) o[n] = (f32x4){0.f, 0.f, 0.f, 0.f};
#pragma unroll
    for (int ks = 0; ks < 4; ++ks) { bf16x8 vw[16];
#pragma unroll
        for (int n = 0; n < 16; ++n) vw[n] = lds_frag(R1, 16 * n + fr, 4 * ks + (((fq & 1) << 1) | (fq >> 1)));
        LDS_WAIT(); __builtin_amdgcn_sched_barrier(0);
#pragma unroll
        for (int n = 0; n < 16; ++n) o[n] = __builtin_amdgcn_mfma_f32_16x16x32_bf16(vw[n], pf[ks], o[n], 0, 0, 0); }
    { const float r1 = __builtin_amdgcn_exp2f(-lgf * (float)i);
#pragma unroll
      for (int n = 0; n < 16; ++n) o[n] = o[n] * r1; }
#pragma unroll
    for (int k2 = 0; k2 < 2; ++k2) { bf16x8 sfr[2][8];
#pragma unroll
        for (int kk = 0; kk < 2; ++kk)
#pragma unroll
            for (int n = 0; n < 8; ++n) sfr[kk][n] = lds_frag(R0 + 32768, 16 * n + fr, 4 * (2 * k2 + kk) + fq);
        LDS_WAIT(); __builtin_amdgcn_sched_barrier(0);
#pragma unroll
        for (int kk = 0; kk < 2; ++kk)
#pragma unroll
            for (int n = 0; n < 8; ++n) o[n] = __builtin_amdgcn_mfma_f32_16x16x32_bf16(sfr[kk][n], qf[2 * k2 + kk], o[n], 0, 0, 0); }
    asm volatile("s_waitcnt vmcnt(0) lgkmcnt(0)" ::: "memory"); __builtin_amdgcn_s_barrier(); asm volatile("" ::: "memory");
    dma_tile<256, true>(R1, ST + (size_t)NCH * 256 * 128 * 2, 256, tid);
#pragma unroll
    for (int k2 = 0; k2 < 2; ++k2) { bf16x8 sfr[2][8];
#pragma unroll
        for (int kk = 0; kk < 2; ++kk)
#pragma unroll
            for (int n = 0; n < 8; ++n) sfr[kk][n] = lds_frag(R0, 16 * n + fr, 4 * (2 * k2 + kk) + fq);
        LDS_WAIT(); __builtin_amdgcn_sched_barrier(0);
#pragma unroll
        for (int kk = 0; kk < 2; ++kk)
#pragma unroll
            for (int n = 0; n < 8; ++n) o[8 + n] = __builtin_amdgcn_mfma_f32_16x16x32_bf16(sfr[kk][n], qf[2 * k2 + kk], o[8 + n], 0, 0, 0); }
    { const float r2 = __builtin_amdgcn_exp2f((lgf + lgb) * (float)i);
#pragma unroll
      for (int n = 0; n < 16; ++n) o[n] = o[n] * r2; }
    asm volatile("s_waitcnt vmcnt(0) lgkmcnt(0)" ::: "memory"); __builtin_amdgcn_s_barrier(); asm volatile("" ::: "memory");
    const size_t ro = (size_t)(tok0 + wid * 16 + fr) * 1024 + h * 256 + 8 * fq;
    const bf16_t* GS = (const bf16_t*)(a.ws + WS_GS) + ro; bf16_t* YR = (bf16_t*)(a.ws + WS_YRET) + ro;
    u32x4 gsv[8];
#pragma unroll
    for (int p = 0; p < 8; ++p) gsv[p] = *(const u32x4*)(GS + 32 * p);
    asm volatile("" ::: "memory");
#pragma unroll
    for (int ks = 0; ks < 4; ++ks) { bf16x8 sbr[16];
#pragma unroll
        for (int n = 0; n < 16; ++n) sbr[n] = lds_frag(R1, 16 * n + fr, 4 * ks + fq);
        LDS_WAIT(); __builtin_amdgcn_sched_barrier(0);
#pragma unroll
        for (int n = 0; n < 16; ++n) o[n] = __builtin_amdgcn_mfma_f32_16x16x32_bf16(sbr[n], qf[ks], o[n], 0, 0, 0); }
    { const float r3 = __builtin_amdgcn_exp2f(-lgb * (float)i);
#pragma unroll
      for (int n = 0; n < 16; ++n) o[n] = o[n] * r3; }
    float s = 0.f;
#pragma unroll
    for (int n = 0; n < 16; ++n) s += (o[n][0] + o[n][1]) + (o[n][2] + o[n][3]);
    s = rows4_sum(s);
    const float mu = s * (1.0f / 256.0f); float q = 0.f;
#pragma unroll
    for (int n = 0; n < 16; ++n) { o[n] = o[n] - mu; q += (o[n][0] * o[n][0] + o[n][1] * o[n][1]) + (o[n][2] * o[n][2] + o[n][3] * o[n][3]); }
    q = rows4_sum(q);
    const float rstd = rsqrtf(q * (1.0f / 256.0f) + EPS);
#pragma unroll
    for (int p = 0; p < 8; ++p) { const u32x4 g = gsv[p]; f32x4 v0 = o[2 * p] * rstd, v1 = o[2 * p + 1] * rstd;
        v0[0] *= bf_lo(g.x); v0[1] *= bf_hi(g.x); v0[2] *= bf_lo(g.y); v0[3] *= bf_hi(g.y); v1[0] *= bf_lo(g.z); v1[1] *= bf_hi(g.z); v1[2] *= bf_lo(g.w); v1[3] *= bf_hi(g.w);
        *(u32x4*)(YR + 32 * p) = pack8(v0, v1); }
    LDS_WAIT(); __builtin_amdgcn_s_barrier(); asm volatile("" ::: "memory");
}

__device__ __forceinline__ void finalize_ctx_unit(const DArgs& a, int unit, const float* lg2p, LAS unsigned char* lds, int tid, int wid, int lane) {
    asm volatile("" : "+v"(tid)); lane = tid & 63;
    const int c = unit & 1, h = (unit >> 1) & 3, bb = unit >> 3, fr = lane & 15, fq = lane >> 4;
    const int tok0 = bb * TPB + c * 128, tokx = bb * TPB + (1 - c) * 128;
    const float lgf = lg2p[h], lgb = lg2p[4 + h];
    LAS unsigned char* R0 = lds; LAS unsigned char* R1 = lds + 65536;
    const char* QF = (const char*)(a.ws + WS_QF);
    dma_tile<128, false>(R0, (const char*)(a.ws + WS_KF) + ((size_t)tok0 * 512 + h * 128) * 2, 1024, tid);
    dma_tile<128, false>(R0 + 32768, (const char*)(a.ws + WS_KF) + ((size_t)tokx * 512 + h * 128) * 2, 1024, tid);
    dma_tile<256, true>(R1, (const char*)(a.ws + WS_VT) + ((size_t)(h * 256) * TG + tok0) * 2, (size_t)TG * 2, tid);
    bf16x8 qf[4];
    { const size_t ro = ((size_t)(tok0 + wid * 16 + fr) * 512 + h * 128 + 8 * fq) * 2;
#pragma unroll
      for (int ks = 0; ks < 4; ++ks) qf[ks] = *(const bf16x8*)(QF + ro + ks * 64); }
    asm volatile("s_waitcnt vmcnt(0)" ::: "memory"); __builtin_amdgcn_s_barrier(); asm volatile("" ::: "memory");
    bf16x8 pf[2][4];
    const int i = wid * 16 + fr;
#pragma unroll
    for (int kc = 0; kc < 2; ++kc) {
        const LAS unsigned char* Kb = R0 + kc * 32768; const int off = kc == 0 ? 0 : (c ? 128 : -128);
        f32x4 sc[8];
#pragma unroll
        for (int n = 0; n < 8; ++n) sc[n] = (f32x4){0.f, 0.f, 0.f, 0.f};
#pragma unroll
        for (int k2 = 0; k2 < 2; ++k2) { bf16x8 kfr[2][8];
#pragma unroll
            for (int kk = 0; kk < 2; ++kk)
#pragma unroll
                for (int n = 0; n < 8; ++n) kfr[kk][n] = lds_frag(Kb, 16 * n + fr, 4 * (2 * k2 + kk) + fq);
            LDS_WAIT(); __builtin_amdgcn_sched_barrier(0);
#pragma unroll
            for (int kk = 0; kk < 2; ++kk)
#pragma unroll
                for (int n = 0; n < 8; ++n) sc[n] = __builtin_amdgcn_mfma_f32_16x16x32_bf16(kfr[kk][n], qf[2 * k2 + kk], sc[n], 0, 0, 0); }
#pragma unroll
        for (int n = 0; n < 8; ++n)
#pragma unroll
            for (int jj = 0; jj < 4; ++jj) { const int d = i + off - (16 * n + 4 * fq + jj); const float w = d == 0 ? 2.0f : __builtin_amdgcn_exp2f(d > 0 ? lgf * (float)d : lgb * (float)(-d)); sc[n][jj] *= w; }
#pragma unroll
        for (int ks = 0; ks < 4; ++ks) { u32x4 w; w.x = cvt_pk_bf16(sc[2 * ks][0], sc[2 * ks][1]); w.y = cvt_pk_bf16(sc[2 * ks][2], sc[2 * ks][3]);
            w.z = cvt_pk_bf16(sc[2 * ks + 1][0], sc[2 * ks + 1][1]); w.w = cvt_pk_bf16(sc[2 * ks + 1][2], sc[2 * ks + 1][3]);
            asm volatile("s_nop 1\n\tv_permlane16_swap_b32 %0, %1\n\tv_permlane16_swap_b32 %2, %3\n\ts_nop 1" : "+v"(w.x), "+v"(w.z), "+v"(w.y), "+v"(w.w));
            pf[kc][ks] = __builtin_bit_cast(bf16x8, w); }
    }
    LDS_WAIT(); __builtin_amdgcn_s_barrier(); asm volatile("" ::: "memory");
    dma_tile<256, true>(R0, (const char*)(a.ws + WS_VT) + ((size_t)(h * 256) * TG + tokx) * 2, (size_t)TG * 2, tid);
    f32x4 o[16];
#pragma unroll
    for (int n = 0; n < 16; ++n) o[n] = (f32x4){0.f, 0.f, 0.f, 0.f};
#pragma unroll
    for (int kc = 0; kc < 2; ++kc) {
        const LAS unsigned char* Vb = kc == 0 ? R1 : R0;
        if (kc == 1) { asm volatile("s_waitcnt vmcnt(0) lgkmcnt(0)" ::: "memory"); __builtin_amdgcn_s_barrier(); asm volatile("" ::: "memory"); }
#pragma unroll
        for (int ks = 0; ks < 4; ++ks) { bf16x8 vw[16];
#pragma unroll
            for (int n = 0; n < 16; ++n) vw[n] = lds_frag(Vb, 16 * n + fr, 4 * ks + (((fq & 1) << 1) | (fq >> 1)));
            LDS_WAIT(); __builtin_amdgcn_sched_barrier(0);
#pragma unroll
            for (int n = 0; n < 16; ++n) o[n] = __builtin_amdgcn_mfma_f32_16x16x32_bf16(vw[n], pf[kc][ks], o[n], 0, 0, 0); }
    }
    float s = 0.f;
#pragma unroll
    for (int n = 0; n < 16; ++n) s += (o[n][0] + o[n][1]) + (o[n][2] + o[n][3]);
    s = rows4_sum(s);
    const float mu = s * (1.0f / 256.0f); float q = 0.f;
#pragma unroll
    for (int n = 0; n < 16; ++n) { o[n] = o[n] - mu; q += (o[n][0] * o[n][0] + o[n][1] * o[n][1]) + (o[n][2] * o[n][2] + o[n][3] * o[n][3]); }
    q = rows4_sum(q);
    const float rstd = rsqrtf(q * (1.0f / 256.0f) + EPS);
    const size_t ro = (size_t)(tok0 + wid * 16 + fr) * 1024 + h * 256 + 8 * fq;
    const bf16_t* GS = (const bf16_t*)(a.ws + WS_GS) + ro; bf16_t* YR = (bf16_t*)(a.ws + WS_YRET) + ro;
#pragma unroll
    for (int p = 0; p < 8; ++p) { const u32x4 g = *(const u32x4*)(GS + 32 * p); f32x4 v0 = o[2 * p] * rstd, v1 = o[2 * p + 1] * rstd;
        v0[0] *= bf_lo(g.x); v0[1] *= bf_hi(g.x); v0[2] *= bf_lo(g.y); v0[3] *= bf_hi(g.y); v1[0] *= bf_lo(g.z); v1[1] *= bf_hi(g.z); v1[2] *= bf_lo(g.w); v1[3] *= bf_hi(g.w);
        *(u32x4*)(YR + 32 * p) = pack8(v0, v1); }
    LDS_WAIT(); __builtin_amdgcn_s_barrier(); asm volatile("" ::: "memory");
}

__global__ void __launch_bounds__(512, 2) fwd_kernel(Args kargs_unused) {
    DArgs a; a.out = KArgs().out(); a.ws = KArgs().wsp();
    extern __shared__ __attribute__((aligned(16))) unsigned char lds_raw[];
    LAS unsigned char* lds = (LAS unsigned char*)lds_raw;
    int tid = threadIdx.x, lane = tid & 63, wid = __builtin_amdgcn_readfirstlane(tid >> 6);
    int G = gridDim.x, bid = blockIdx.x;
#define PHASE_FENCE() do { asm volatile("" : "+v"(tid)); lane = tid & 63; wid = __builtin_amdgcn_readfirstlane(tid >> 6); \
        { unsigned _l = __builtin_amdgcn_readfirstlane((unsigned)(size_t)lds); asm volatile("" : "+s"(_l)); lds = (LAS unsigned char*)(size_t)_l; } \
        G = __builtin_amdgcn_readfirstlane(G); bid = __builtin_amdgcn_readfirstlane(bid); asm volatile("" : "+s"(G), "+s"(bid)); \
        a.out = KArgs().out(); a.ws = KArgs().wsp(); } while (0)
    for (int u = tid; u < (LDS_BYTES - LC_OFF) / 4; u += 512) ((LAS unsigned*)(lds + LC_OFF))[u] = 0u;
    __syncthreads();
    unsigned* ctl = (unsigned*)(a.ws + WS_CTL);
    const XcdBarrier bar = xcd_barrier_post(ctl + CW_BAR, (volatile LAS unsigned*)(lds + LC_BAR));
#define GRID_BAR() do { for (int _r = 0; _r < REP_BAR; ++_r) { XcdBarrier _b = bar; asm volatile("" : "+s"(_b.bar)); xcd_barrier(_b); } PHASE_FENCE(); } while (0)
#define TAB ((const float*)(a.ws + WS_TAB))

#ifndef DBG_POISON
#define DBG_POISON 0
#endif
    if (DBG_POISON) {
        u32x4* p4 = (u32x4*)(a.ws + 1 * MiB); const size_t n4 = (WS_END - 1 * MiB) / 16; const u32x4 pz = {0xffffffffu, 0xffffffffu, 0xffffffffu, 0xffffffffu};
        for (size_t i = (size_t)bid * 512 + tid; i < n4; i += (size_t)G * 512) p4[i] = pz;
        u32x4* o4 = (u32x4*)a.out; const size_t m4 = (size_t)NB * SEQ * D / 4;
        for (size_t i = (size_t)bid * 512 + tid; i < m4; i += (size_t)G * 512) o4[i] = pz;
        GRID_BAR();
    }
#ifndef X_NO_P0
    for (int rep = 0; rep < REP_P0; ++rep) { p0_mod(a, lds, tid, wid, lane); __syncthreads(); }
    for (int rep = 0; rep < REP_CVT; ++rep) { convert_weights(a, 0, lds, wid, lane); __syncthreads(); }
#endif
    GRID_BAR();

    for (int l = 0; l < DEPTH; ++l) {
#define lg2 (TAB + l * 8)
        const int skipctx = (l == DEPTH - 1) ? 1 : 0;
#ifndef X_NO_N1
        if (l > 0) for (int rep = 0; rep < REP_CVT; ++rep) { convert_weights(a, l, lds, wid, lane); __syncthreads(); }
        if (l == 0) { for (int rep = 0; rep < REP_N1; ++rep) phase_n1<0>(a, l, wid, lane); } else phase_n1<1>(a, l, wid, lane);
#endif
        GRID_BAR();
        for (int g = 0; g <= NG; ++g) {
#ifndef NO_OVERLAP
#define NO_OVERLAP 0
#endif
            const int nG4 = g == 0 ? 0 : (skipctx ? 128 : 144);
            if (bid < nG4) {
#ifndef X_NO_OUTPROJ
                for (int rep = 0; rep < REP_G4; ++rep) { PHASE_FENCE();
                    const int gp = g - 1;
                    const unsigned char* GATE = (const unsigned char*)(a.ws + ((gp & 1) ? WS_GATE1 : WS_GATE0)); bf16_t* MG = (bf16_t*)(a.ws + WS_MERGED) + (size_t)gp * TG * 1024;
                    SchedG4 S{(const char*)(a.ws + WS_YRET), (const char*)(a.ws + WS_YCONV), (const char*)(a.ws + WS_WRET), (const char*)(a.ws + WS_WCONV), skipctx ? TG / 256 / 9 * 8 : TG / 256, nG4, bid, skipctx};
                    EpiG4 E{GATE, MG};
                    pg8::gemm_phase<1024, 1024, 1024, EpiG4, SchedG4, true, true, true>(lds, tid, S, E);
                }
#endif
            }
            if (g == NG && bid >= nG4) {
                PHASE_FENCE();
                const int ntg = skipctx ? TG / 256 / 9 * 8 : TG / 256;
                SchedPlain S{(const char*)(a.ws + WS_MERGED), (const char*)(a.ws + WS_WO), (size_t)256 * 2048, (size_t)256 * 2048, (NG - 1) * ntg, 4, G - nG4, bid - nG4, skipctx};
                EpiPlainBf16 E{(bf16_t*)(a.ws + WS_YATT), 1024};
                pg8::gemm_phase<1024, 1024, 1024, EpiPlainBf16, SchedPlain, true, true>(lds, tid, S, E);
            }
            if (g < NG) {
#ifndef X_NO_INPROJ
                for (int rep = 0; rep < REP_G1; ++rep) { PHASE_FENCE();
                    SchedInproj S{(const char*)(a.ws + WS_H) + (size_t)g * TG * 2048, (const char*)(a.ws + WS_WIN), G, bid, nG4, skipctx};
                    EpiInproj E{a.ws, lg2, TAB + 32, TAB + 32 + 2048, (bf16_t*)(a.ws + ((g & 1) ? WS_GATE1 : WS_GATE0))};
                    pg8::gemm_phase<1024, 1024, 1024, EpiInproj, SchedInproj, true, true>(lds, tid, S, E);
                }
#endif
            }
            GRID_BAR();
            if (g == NG) break;
#ifndef X_NO_CHAIN
            for (int rep = 0; rep < REP_G2; ++rep) {
            if (bid < NCHAIN) {
                const int cu = (((bid & 7) + 8 * (bid >> 5)) << 2) | ((bid >> 3) & 3);
                for (int r2 = 0; r2 < REP_CH; ++r2) chain_unit(a, cu, lg2, lds, tid, wid, lane); }
            else if (skipctx) { for (int r2 = 0; r2 < REP_CP; ++r2) conv_pool(a, l, bid - NCHAIN, G - NCHAIN, tid, skipctx, 0, CP_TOTAL - CP_DEFER); }
            else {
                const int w = bid - NCHAIN, nv = 2 * (G - NCHAIN) - 32;
                if (w < 32) { finalize_ctx_unit(a, w, lg2, lds, tid, wid, lane); conv_pool(a, l, w, nv, tid, skipctx, 0, CP_TOTAL - CP_DEFER); }
                else { conv_pool(a, l, 32 + 2 * (w - 32), nv, tid, skipctx, 0, CP_TOTAL - CP_DEFER); conv_pool(a, l, 33 + 2 * (w - 32), nv, tid, skipctx, 0, CP_TOTAL - CP_DEFER); }
            }
            }
#endif
            GRID_BAR();
#ifndef X_NO_FIN
            for (int rep = 0; rep < REP_G3; ++rep)
            for (int u = bid; u < BG * 4 * 16; u += G) finalize_unit(a, (u >> 4) * NCH + 2 + (u & 15), lg2, lds, tid, wid, lane);
            conv_pool(a, l, bid, G, tid, skipctx, CP_TOTAL - CP_DEFER, CP_TOTAL);
#endif
            GRID_BAR();
        }
#ifndef X_NO_WO
        for (int rep = 0; rep < REP_WO; ++rep) { PHASE_FENCE();
            SchedPlain S{(const char*)(a.ws + WS_MERGED) + (size_t)(NG - 1) * TG * 2048, (const char*)(a.ws + WS_WO), (size_t)256 * 2048, (size_t)256 * 2048, skipctx ? TG / 256 / 9 * 8 : TG / 256, 4, G, bid, skipctx};
            EpiPlainBf16 E{(bf16_t*)(a.ws + WS_YATT) + (size_t)(NG - 1) * TG * 1024, 1024};
            pg8::gemm_phase<1024, 1024, 1024, EpiPlainBf16, SchedPlain, true, true>(lds, tid, S, E);
        }
#endif
        GRID_BAR();
#ifndef X_NO_N2
        for (int rep = 1; rep < REP_N2; ++rep) { phase_n2(a, l, lds, tid, wid, lane, skipctx, true); __syncthreads(); }
        phase_n2(a, l, lds, tid, wid, lane, skipctx);
#endif
        GRID_BAR();
        {
            LAS int* cnt = (LAS int*)(lds + LC_CNT); LAS int* poff = (LAS int*)(lds + LC_POFF); LAS int* tile_e = (LAS int*)(lds + LC_TILEE); LAS int* ntl = (LAS int*)(lds + LC_NT);
            if (tid == 0) { int off = 0;
_Pragma("unroll 1")
                for (int e = 0; e < 16; ++e) { const int n = (int)xb_ld(ctl + CW_CNT + 64 * l + e); cnt[e] = n; poff[e] = off; const int nt = (n + 255) >> 8;
                    for (int t = 0; t < nt; ++t) tile_e[(off >> 8) + t] = e; off += nt << 8; } poff[16] = off; ntl[0] = off >> 8; }
            __syncthreads();
            const int ntiles = ntl[0];
            {
                int* SLOTOF = (int*)(a.ws + WS_SLOTOF); const int* LISTp = (const int*)(a.ws + WS_LIST);
                for (int idx = bid * 512 + tid; idx < ntiles * 256; idx += G * 512) { const int e = tile_e[idx >> 8], p = idx - poff[e]; if (p < cnt[e]) SLOTOF[LISTp[(size_t)e * T + p]] = idx; }
            }
#ifndef X_NO_M1
            for (int rep = 0; rep < REP_M1; ++rep) { PHASE_FENCE(); SchedMoeG S{(const char*)(a.ws + WS_H), (const char*)(a.ws + WS_W13), tile_e, cnt, poff, (const int*)(a.ws + WS_LIST), (LAS int*)(lds + LC_GTBL), ntiles, G, bid};
              EpiMoeUp E{(bf16_t*)(a.ws + WS_ACT)};
              pg8::gemm_phase<1024, 1024, 1024, EpiMoeUp, SchedMoeG, true, true>(lds, tid, S, E); }
#endif
            GRID_BAR();
#ifndef X_NO_M2
            for (int rep = 0; rep < REP_M2; ++rep) { PHASE_FENCE(); SchedMoe S{(const char*)(a.ws + WS_ACT), (const char*)(a.ws + WS_W2), (size_t)256 * 1024, (size_t)1024, tile_e, ntiles, G, bid};
              EpiPlainBf16 E{(bf16_t*)(a.ws + WS_YS), 1024};
              pg8::gemm_phase<512, 512, 512, EpiPlainBf16, SchedMoe, true, true>(lds, tid, S, E); }
#endif
            GRID_BAR();
        }
    }
    {
        float poison = 0.f;
        const unsigned err = xb_ld(ctl + CW_ERR), tmo = xb_ld(ctl + CW_BAR + XB_TMO);
        if (err) poison = sqrtf((float)err); else if (tmo) poison = sqrtf(90.f);
        phase_final(a, wid, lane, poison);
    }
}

extern "C" void kernel_launch(void* const* d_in, const int* in_sizes, int n_in, void* d_out, int out_size, void* d_ws, size_t ws_size, hipStream_t stream) {
    static int grid = 0;
    if (grid == 0) {
        if (n_in != 25 || ws_size < WS_END) { fprintf(stderr, "kernel_launch: unexpected n_in %d / ws_size %zu\n", n_in, ws_size); grid = -1; return; }
        int dev = 0, cus = 0, per_cu = 0;
        if (hipGetDevice(&dev) != hipSuccess || hipDeviceGetAttribute(&cus, hipDeviceAttributeMultiprocessorCount, dev) != hipSuccess) { grid = -1; return; }
        if (hipFuncSetAttribute((const void*)fwd_kernel, hipFuncAttributeMaxDynamicSharedMemorySize, LDS_BYTES) != hipSuccess) { grid = -1; return; }
        if (hipOccupancyMaxActiveBlocksPerMultiprocessor(&per_cu, (const void*)fwd_kernel, 512, LDS_BYTES) != hipSuccess || per_cu < 1) fprintf(stderr, "kernel_launch: occupancy query says %d\n", per_cu);
        (void)hipGetLastError();
        grid = cus;
    }
    if (grid < 0) return;
    if (hipMemsetAsync((char*)d_ws + WS_CTL, 0, 1 * MiB, stream) != hipSuccess) return;
    Args a{};
    for (int i = 0; i < 25; ++i) a.in[i] = (const float*)d_in[i];
    a.out = (float*)d_out; a.ws = (unsigned char*)d_ws;
    hipLaunchKernelGGL(fwd_kernel, dim3(grid), dim3(512), LDS_BYTES, stream, a);
}
```

```cpp
#include <hip/hip_runtime.h>
#include <cstdio>
#include <cstdint>

#ifndef REP_G1
#define REP_G1 1
#endif
#ifndef REP_G2
#define REP_G2 1
#endif
#ifndef REP_G3
#define REP_G3 1
#endif
#ifndef REP_G4
#define REP_G4 1
#endif
#ifndef REP_WO
#define REP_WO 1
#endif
#ifndef REP_M0
#define REP_M0 1
#endif
#ifndef REP_M1
#define REP_M1 1
#endif
#ifndef REP_M2
#define REP_M2 1
#endif
#ifndef REP_CVT
#define REP_CVT 1
#endif
#ifndef REP_P0
#define REP_P0 1
#endif
#ifndef REP_N1
#define REP_N1 1
#endif
#ifndef REP_BAR
#define REP_BAR 1
#endif
#ifndef REP_N2
#define REP_N2 1
#endif
#ifndef REP_CH
#define REP_CH 1
#endif
#ifndef REP_EPI
#define REP_EPI 1
#endif
#ifndef REP_CP
#define REP_CP 1
#endif
#define LAS __attribute__((address_space(3)))
typedef unsigned short bf16_t;
typedef short bf16x8 __attribute__((ext_vector_type(8)));
typedef short bf16x4 __attribute__((ext_vector_type(4)));
typedef float f32x4 __attribute__((ext_vector_type(4)));
typedef float f32x2 __attribute__((ext_vector_type(2)));
typedef unsigned u32x4 __attribute__((ext_vector_type(4)));
typedef unsigned u32x2 __attribute__((ext_vector_type(2)));

constexpr int D = 1024, NB = 16, SEQ = 2048, CL = 256, TPB = SEQ + CL  , T = NB * TPB  , DEPTH = 4;
constexpr int NG = 4, BG = NB / NG, TG = BG * TPB;
constexpr int NCH = TPB / 128;
constexpr float EPS = 1e-6f;
constexpr int NMOD = 6 * D;

constexpr size_t MiB = 1u << 20;
constexpr size_t WS_CTL = 0;
constexpr size_t WS_MOD = 1 * MiB;
constexpr size_t WS_TAB = WS_MOD + (size_t)DEPTH * 17 * NMOD * 4;
constexpr size_t WS_WIN = 3 * MiB;
constexpr size_t WS_WRET = WS_WIN + 16 * MiB;
constexpr size_t WS_WCONV = WS_WRET + 2 * MiB;
constexpr size_t WS_WPOOL = WS_WCONV + 1 * MiB;
constexpr size_t WS_WO = WS_WPOOL + 1 * MiB;
constexpr size_t WS_W13 = WS_WO + 2 * MiB;
constexpr size_t WS_W2 = WS_W13 + 32 * MiB;
constexpr size_t WS_XC = WS_W2 + 16 * MiB;
constexpr size_t WS_H = WS_XC + 16 * MiB;
constexpr size_t WS_PROJ = WS_H + 72 * MiB;
constexpr size_t SEC = (size_t)TG * 512 * 2;
constexpr size_t WS_QF = WS_PROJ, WS_QB = WS_QF + SEC, WS_KF = WS_QB + SEC, WS_KB = WS_KF + SEC, WS_KTF = WS_KB + SEC, WS_KTB = WS_KTF + SEC;
constexpr size_t WS_VT = WS_KTB + SEC, WS_GS = WS_VT + 2 * SEC, WS_CB = WS_GS + 2 * SEC, WS_CU = WS_CB + SEC, WS_PI = WS_CU + SEC;
constexpr size_t WS_GATE0 = WS_PI + SEC, WS_GATE1 = WS_GATE0 + 6 * SEC;
constexpr size_t WS_PROJ_END = WS_GATE1 + 6 * SEC;
constexpr size_t WS_H2S = WS_PROJ;
constexpr size_t WS_ACT = WS_PROJ + 152 * MiB;
constexpr size_t WS_STATES = WS_PROJ_END;
constexpr size_t WS_YRET = WS_STATES + 36 * MiB;
constexpr size_t WS_YCONV = WS_YRET + 18 * MiB;
constexpr size_t WS_POOLED = WS_YCONV + 9 * MiB;
constexpr size_t WS_MERGEDF = WS_POOLED + 9 * MiB;
constexpr size_t WS_X = WS_MERGEDF + 36 * MiB;
constexpr size_t WS_YATT = WS_X + 72 * MiB;
constexpr size_t WS_YS = WS_YATT + 72 * MiB;
constexpr size_t WS_MERGED = WS_YS;
constexpr size_t WS_ROUTEC = WS_YS + 152 * MiB;
constexpr size_t WS_SLOTOF = WS_ROUTEC + 512 * 1024;
constexpr size_t WS_LIST = WS_ROUTEC + 1 * MiB;
constexpr size_t WS_END = WS_LIST + 3 * MiB;
static_assert(WS_PROJ_END - WS_PROJ == 25 * SEC, "proj");
static_assert(WS_ACT + (size_t)(2 * T + 4096) * 512 * 2 <= WS_X && WS_H2S + (size_t)(2 * T + 4096) * 1024 * 2 <= WS_ACT, "moe alias");
static_assert(WS_END <= 798 * MiB, "workspace");
constexpr int CW_ERR = 16;
constexpr int CW_BAR = 4096;
constexpr int CW_CNT = 16384;

constexpr int LDS_BYTES = 147456;
constexpr int LC_OFF = 131072;
constexpr int LC_BAR = LC_OFF + 32;
constexpr int LC_CNT = LC_OFF + 256;
constexpr int LC_POFF = LC_OFF + 384;
constexpr int LC_NT = LC_OFF + 480;
constexpr int LC_TILEE = LC_OFF + 512;
constexpr int LC_RE = LC_OFF + 2048;
constexpr int LC_LCNT = LC_OFF + 3584;
constexpr int LC_GTBL = LC_OFF + 4096;

__device__ __forceinline__ unsigned cvt_pk_bf16(float lo, float hi) { unsigned r; asm volatile("s_nop 0\n\tv_cvt_pk_bf16_f32 %0, %1, %2" : "=v"(r) : "v"(lo), "v"(hi)); return r; }
__device__ __forceinline__ float bf_lo(unsigned w) { return __uint_as_float(w << 16); }
__device__ __forceinline__ float bf_hi(unsigned w) { return __uint_as_float(w & 0xffff0000u); }
template <int CTRL> __device__ __forceinline__ float dpp_add(float v) { return v + __builtin_bit_cast(float, __builtin_amdgcn_update_dpp(0, __builtin_bit_cast(int, v), CTRL, 0xF, 0xF, true)); }
__device__ __forceinline__ float row16_sum(float v) { v = dpp_add<0xB1>(v); v = dpp_add<0x4E>(v); v = dpp_add<0x141>(v); v = dpp_add<0x140>(v); return v; }
__device__ __forceinline__ float swap32_sum(float a, float b) { const auto r = __builtin_amdgcn_permlane32_swap(__builtin_bit_cast(unsigned, a), __builtin_bit_cast(unsigned, b), false, false);
    return __builtin_bit_cast(float, (unsigned)r[0]) + __builtin_bit_cast(float, (unsigned)r[1]); }
__device__ __forceinline__ float swap16_sum(float a, float b) { const auto r = __builtin_amdgcn_permlane16_swap(__builtin_bit_cast(unsigned, a), __builtin_bit_cast(unsigned, b), false, false);
    return __builtin_bit_cast(float, (unsigned)r[0]) + __builtin_bit_cast(float, (unsigned)r[1]); }
__device__ __forceinline__ float wave_sum4(float v0, float v1, float v2, float v3) { return row16_sum(swap16_sum(swap32_sum(v0, v1), swap32_sum(v2, v3))); }
__device__ __forceinline__ float wave_sum(float v) { const float r = row16_sum(v); const float t = swap16_sum(r, r); return swap32_sum(t, t); }
__device__ __forceinline__ float rows4_sum(float v) { const float t = swap16_sum(v, v); return swap32_sum(t, t); }
__device__ __forceinline__ float lane_val(float v, int l) { return __builtin_bit_cast(float, __builtin_amdgcn_readlane(__builtin_bit_cast(int, v), l)); }
__device__ __forceinline__ float fast_exp(float x) { return __builtin_amdgcn_exp2f(x * 1.4426950408889634f); }
__device__ __forceinline__ float silu_f(float x) { return x * __builtin_amdgcn_rcpf(1.0f + fast_exp(-x)); }
__device__ __forceinline__ float sigmoid_f(float x) { return __builtin_amdgcn_rcpf(1.0f + fast_exp(-x)); }
__device__ __forceinline__ float silu_fast(float x) { return x * __builtin_amdgcn_rcpf(1.0f + fast_exp(-x)); }
__device__ __forceinline__ float sigmoid_fast(float x) { return __builtin_amdgcn_rcpf(1.0f + fast_exp(-x)); }
__device__ __forceinline__ u32x4 pack8(const f32x4 a, const f32x4 b) { u32x4 w; w.x = cvt_pk_bf16(a[0], a[1]); w.y = cvt_pk_bf16(a[2], a[3]); w.z = cvt_pk_bf16(b[0], b[1]); w.w = cvt_pk_bf16(b[2], b[3]); return w; }
#define LDS_WAIT() asm volatile("s_waitcnt lgkmcnt(0)" ::: "memory")
#define VM_WAIT() asm volatile("s_waitcnt vmcnt(0)" ::: "memory")

#define XB_TMO      128
#define XB_XCNT(j)  (256  + 64 * (j))
#define XB_XSUB(j)  (1280 + 64 * (j))
#define XB_XGEN(j)  (2304 + 64 * (j))
#define XB_TOP      3328
#define XB_TOPGEN   3392
#define XCD_BAR_WORDS 3456
#define XB_SPIN_CAP (1u << 18)
__device__ __forceinline__ unsigned xb_ld(unsigned* p)              { return __hip_atomic_load(p, __ATOMIC_RELAXED, __HIP_MEMORY_SCOPE_AGENT); }
__device__ __forceinline__ unsigned xb_add(unsigned* p, unsigned v) { return __hip_atomic_fetch_add(p, v, __ATOMIC_RELAXED, __HIP_MEMORY_SCOPE_AGENT); }
__device__ __forceinline__ unsigned xb_xcc_id() { return (unsigned)__builtin_amdgcn_s_getreg((3 << 11) | 20) & 0xFu; }
#define XB_SPIN(cond, bar) do { unsigned _sp = 0; while (cond) { __builtin_amdgcn_s_sleep(1); \
    if ((++_sp & 255u) == 0u) { if (xb_ld(&(bar)[XB_TMO])) break; if (_sp > XB_SPIN_CAP) { atomicAdd(&(bar)[XB_TMO], 1u); break; } } } } while (0)
struct XcdBarrier { unsigned* bar; unsigned x; volatile LAS unsigned* st; };
__device__ __forceinline__ XcdBarrier xcd_barrier_post(unsigned* bar, volatile LAS unsigned* st) {
    XcdBarrier b; b.bar = bar; b.x = xb_xcc_id(); b.st = st;
    if (threadIdx.x == 0) (void)xb_add(&bar[XB_XCNT(b.x)], 1u);
    return b;
}
__device__ __forceinline__ void xcd_barrier_complete(unsigned* bar, unsigned x, unsigned& nloc, unsigned& nx) {
    const unsigned G = gridDim.x * gridDim.y * gridDim.z;
    unsigned sum, cnt, mine, sp = 0u;
    for (;;) {
        sum = 0u; cnt = 0u; mine = 0u;
#pragma unroll 1
        for (unsigned j = 0; j < 16; ++j) { const unsigned c = xb_ld(&bar[XB_XCNT(j)]); sum += c; cnt += (c > 0u) ? 1u : 0u; mine = (j == x) ? c : mine; }
        if (sum == G) break;
        __builtin_amdgcn_s_sleep(1);
        if ((++sp & 255u) == 0u) { if (xb_ld(&bar[XB_TMO])) break; if (sp > XB_SPIN_CAP) { atomicAdd(&bar[XB_TMO], 1u); break; } }
    }
    nloc = mine > 0u ? mine : 1u; nx = cnt > 0u ? cnt : 1u;
}
__device__ __forceinline__ void xcd_barrier(const XcdBarrier& b) {
    asm volatile("s_waitcnt vmcnt(0)" ::: "memory");
    __syncthreads();
    if (threadIdx.x == 0) {
        unsigned* bar = b.bar;
        __builtin_amdgcn_s_waitcnt(0);
        unsigned nloc = b.st[0], nx = b.st[1];
        if (nloc == 0u) { xcd_barrier_complete(bar, b.x, nloc, nx); b.st[0] = nloc; b.st[1] = nx; }
        const unsigned old = xb_add(&bar[XB_XSUB(b.x)], 1u);
        const unsigned gen = old / nloc;
        if (old + 1u == (gen + 1u) * nloc) {
            __builtin_amdgcn_fence(__ATOMIC_RELEASE, "agent");
            asm volatile("s_waitcnt vmcnt(0)" ::: "memory");
            const unsigned og = xb_add(&bar[XB_TOP], 1u);
            const unsigned tg = og / nx;
            if (og + 1u == (tg + 1u) * nx) xb_add(&bar[XB_TOPGEN], 1u);
            else XB_SPIN(xb_ld(&bar[XB_TOPGEN]) == tg, bar);
            __builtin_amdgcn_fence(__ATOMIC_ACQUIRE, "agent");
            xb_add(&bar[XB_XGEN(b.x)], 1u);
            asm volatile("s_waitcnt vmcnt(0)" ::: "memory");
        } else {
            XB_SPIN(xb_ld(&bar[XB_XGEN(b.x)]) == gen, bar);
            __builtin_amdgcn_fence(__ATOMIC_ACQUIRE, "agent");
            asm volatile("s_waitcnt vmcnt(0)" ::: "memory");
        }
    }
    __syncthreads();
}

namespace pg8 {
constexpr int BM = 256, BK = 64, HALF = 128, HTB = HALF * BK * 2, STAGE_BYTES = 8 * HTB, NXCD = 8, WGM = 8;
__host__ __device__ __forceinline__ int lds_byte(int r, int c) { const int st = (r >> 4) * 2 + (c >> 5), rr = r & 15, cc = c & 31, ob = rr * 64 + cc * 2; return st * 1024 + (ob ^ (((ob >> 9) & 1) << 5)); }
__host__ __device__ __forceinline__ void stage_rc(int b, int& R, int& C) { const int st = b / 1024, sb = b % 1024, swz = sb ^ (((sb >> 9) & 1) << 5); R = (st >> 1) * 16 + swz / 64; C = (st & 1) * 32 + (swz % 64) / 2; }
__host__ __device__ __forceinline__ int perm32(int rho) { const int n = rho >> 4, i = rho & 15; return 8 * (i >> 2) + 4 * n + (i & 3); }

struct Unit { const char* a; const char* b; int pm, pn, kind, nt, cont; };

__device__ __forceinline__ void tile_map(int L, int nM, int nN, int& pm, int& pn) {
    const int nwg = nM * nN; int wgid = L;
    { const int q = nwg / NXCD, r = nwg % NXCD, xcd = wgid % NXCD, off = wgid / NXCD; wgid = (xcd < r ? xcd * (q + 1) : r * (q + 1) + (xcd - r) * q) + off; }
    const int nig = WGM * nN, gid = wgid / nig, fm = gid * WGM, gsz = (nM - fm) < WGM ? (nM - fm) : WGM;
    pm = fm + ((wgid % nig) % gsz); pn = (wgid % nig) / gsz;
}

template <class S_> struct sched_gather { static constexpr bool value = false; };
template <int K, int lda, int ldb, class Epi, class Sched, bool ALIGN_EPI, bool SP2, bool VARNT = false>
__device__ __forceinline__ void gemm_phase(LAS unsigned char* lds, const int tid, const Sched& S, const Epi& E) {
    const int wid = __builtin_amdgcn_readfirstlane(tid >> 6), lane = tid & 63, wr = wid >> 2, wc = wid & 3, fr = lane & 15, fq = lane >> 4;
    constexpr int nt_c = K / BK;
    unsigned voffA[2], voffB[2];
#pragma unroll
    for (int i = 0; i < 2; ++i) { int R, C; stage_rc(tid * 16 + i * 8192, R, C); const int Rb = Epi::PERM ? ((R & ~31) + perm32(R & 31)) : R;
        voffA[i] = (unsigned)(R * lda + C) * 2u; voffB[i] = (unsigned)(Rb * ldb + C) * 2u; }
    constexpr bool GATHER = sched_gather<Sched>::value;
    int gR[2], gC2[2];
#pragma unroll
    for (int i = 0; i < 2; ++i) { int R, C; stage_rc(tid * 16 + i * 8192, R, C); gR[i] = R; gC2[i] = C * 2; }
    unsigned voA0[2] = {voffA[0], voffA[1]}, voA1[2] = {voffA[0], voffA[1]};
    constexpr size_t kstep = (size_t)(BK * 2);
    constexpr size_t hstepA = (size_t)HALF * lda * 2, hstepB = (size_t)HALF * ldb * 2;
    const unsigned ldsw = (unsigned)wid * 1024u;
    const int aoff = lds_byte(wr * 64 + fr, fq * 8), boff = lds_byte(wc * 32 + fr, fq * 8);
#define PG8_SA(b, h) (((b) * 2 + (h)) * HTB)
#define PG8_SB(b, h) ((4 + (b) * 2 + (h)) * HTB)
#define PG8_STAGE(bufoff, gbase, voff) do { _Pragma("unroll") for (int _i = 0; _i < 2; ++_i) \
        __builtin_amdgcn_global_load_lds((const unsigned*)((const char*)(gbase) + (voff)[_i]), (LAS unsigned*)(lds + (bufoff) + ldsw + _i * 8192), 16, 0, 0); } while (0)
#define PG8_STAGE_A(bufoff, gbase, h) do { if constexpr (GATHER) { if ((h) == 0) PG8_STAGE(bufoff, gbase, voA0); else PG8_STAGE(bufoff, gbase, voA1); } \
        else { PG8_STAGE(bufoff, (gbase) + ((h) ? hstepA : 0), voffA); } } while (0)
#define PG8_LDA(dst, b, h) do { _Pragma("unroll") for (int m = 0; m < 4; ++m) _Pragma("unroll") for (int k = 0; k < 2; ++k) dst[m][k] = *(const LAS bf16x8*)(lds + PG8_SA(b, h) + aoff + m * 2048 + k * 1024); } while (0)
#define PG8_LDB(dst, b, h) do { _Pragma("unroll") for (int n = 0; n < 2; ++n) _Pragma("unroll") for (int k = 0; k < 2; ++k) dst[n][k] = *(const LAS bf16x8*)(lds + PG8_SB(b, h) + boff + n * 2048 + k * 1024); } while (0)
#define PG8_MMA(ai, bj, At, Bt) do { __builtin_amdgcn_s_setprio(1); _Pragma("unroll") for (int m = 0; m < 4; ++m) _Pragma("unroll") for (int n = 0; n < 2; ++n) _Pragma("unroll") for (int k = 0; k < 2; ++k) \
        acc[ai][bj][m][n] = __builtin_amdgcn_mfma_f32_16x16x32_bf16(Bt[n][k], At[m][k], acc[ai][bj][m][n], 0, 0, 0); __builtin_amdgcn_s_setprio(0); } while (0)
#define PG8_WAIT_V(n) asm volatile("s_waitcnt vmcnt(" #n ")" ::: "memory")
#define PG8_WAIT_L(n) asm volatile("s_waitcnt lgkmcnt(" #n ")" ::: "memory")
#define PG8_BAR __builtin_amdgcn_s_barrier()
#define PG8_SCHED __builtin_amdgcn_sched_barrier(0)
    Unit cur, nxt; int ui = 0;
    if (!S.next(0, cur)) return;
    f32x4 acc[2][2][4][2];
#pragma unroll
    for (int a = 0; a < 2; ++a)
#pragma unroll
        for (int b = 0; b < 2; ++b)
#pragma unroll
            for (int m = 0; m < 4; ++m)
#pragma unroll
                for (int n = 0; n < 2; ++n) acc[a][b][m][n] = (f32x4){0.f, 0.f, 0.f, 0.f};
    bf16x8 At[4][2], B0[2][2], B1[2][2];
    const char* cA = cur.a; const char* cB = cur.b;
    if constexpr (GATHER) {
        S.fill_table(cur, 0, tid); asm volatile("s_waitcnt vmcnt(0)" ::: "memory"); __builtin_amdgcn_s_barrier(); asm volatile("" ::: "memory");
        S.load_offsets(cur, 0, gR, gC2, voA0, voA1);
    }
    if constexpr (SP2) {
        PG8_STAGE(PG8_SB(0, 0), cB, voffB); PG8_STAGE(PG8_SB(0, 1), cB + hstepB, voffB); PG8_STAGE_A(PG8_SA(0, 0), cA, 0); PG8_STAGE_A(PG8_SA(0, 1), cA, 1);
        if (wr == 1) PG8_BAR;
        PG8_WAIT_V(2); PG8_BAR;
        PG8_STAGE(PG8_SB(1, 0), cB + kstep, voffB); PG8_STAGE_A(PG8_SA(1, 0), cA + kstep, 0); PG8_STAGE(PG8_SB(1, 1), cB + hstepB + kstep, voffB);
        PG8_WAIT_V(6); PG8_BAR;
    } else {
        PG8_STAGE(PG8_SB(0, 0), cB, voffB); PG8_STAGE_A(PG8_SA(0, 0), cA, 0); PG8_STAGE(PG8_SB(0, 1), cB + hstepB, voffB); PG8_STAGE_A(PG8_SA(0, 1), cA, 1);
        if (wr == 1) PG8_BAR;
        PG8_WAIT_V(4); PG8_BAR;
        PG8_STAGE(PG8_SB(1, 0), cB + kstep, voffB); PG8_STAGE_A(PG8_SA(1, 0), cA + kstep, 0); PG8_STAGE(PG8_SB(1, 1), cB + hstepB + kstep, voffB);
        PG8_WAIT_V(6); PG8_BAR;
    }
    for (;;) {
        const bool has_next = S.next(ui + 1, nxt);
        const char* nA = has_next ? nxt.a : cA; const char* nB = has_next ? nxt.b : cB;
        if constexpr (GATHER) { if (has_next) S.fill_table(nxt, (ui + 1) & 1, tid); }
        const int nt = VARNT ? cur.nt : nt_c;
        for (int t = 0; t < nt; t += 2) {
            const bool last = (t == nt - 2);
            const char* a1 = cA + (size_t)(t + 1) * kstep;
            const char* a2 = last ? nA : cA + (size_t)(t + 2) * kstep; const char* b2 = last ? nB : cB + (size_t)(t + 2) * kstep;
            const char* a3 = a2 + kstep; const char* b3 = b2 + kstep;
            if constexpr (SP2) {
            PG8_LDB(B0, 0, 0); PG8_LDB(B1, 0, 1); PG8_SCHED; PG8_LDA(At, 0, 0); PG8_STAGE_A(PG8_SA(1, 1), a1, 1);
            PG8_WAIT_V(8); PG8_WAIT_L(0); PG8_BAR; PG8_MMA(0, 0, At, B0); PG8_MMA(0, 1, At, B1); PG8_BAR; PG8_SCHED;
            PG8_LDA(At, 0, 1);
            if constexpr (GATHER) { if (last && has_next) S.load_offsets(nxt, (ui + 1) & 1, gR, gC2, voA0, voA1); }
            PG8_STAGE(PG8_SB(0, 0), b2, voffB); PG8_STAGE(PG8_SB(0, 1), b2 + hstepB, voffB); PG8_STAGE_A(PG8_SA(0, 0), a2, 0);
            PG8_WAIT_V(8); PG8_WAIT_L(0); PG8_BAR; PG8_MMA(1, 0, At, B0); PG8_MMA(1, 1, At, B1); PG8_BAR; PG8_SCHED;
            PG8_LDB(B0, 1, 0); PG8_LDB(B1, 1, 1); PG8_SCHED; PG8_LDA(At, 1, 0); PG8_STAGE_A(PG8_SA(0, 1), a2, 1);
            PG8_WAIT_V(8); PG8_WAIT_L(0); PG8_BAR; PG8_MMA(0, 0, At, B0); PG8_MMA(0, 1, At, B1); PG8_BAR; PG8_SCHED;
            PG8_LDA(At, 1, 1); PG8_STAGE(PG8_SB(1, 0), b3, voffB); PG8_STAGE(PG8_SB(1, 1), b3 + hstepB, voffB); PG8_STAGE_A(PG8_SA(1, 0), a3, 0);
            PG8_WAIT_V(8); PG8_WAIT_L(0); PG8_BAR; PG8_MMA(1, 0, At, B0); PG8_MMA(1, 1, At, B1); PG8_BAR; PG8_SCHED;
            } else {
            PG8_LDB(B0, 0, 0); PG8_SCHED; PG8_LDA(At, 0, 0); PG8_STAGE_A(PG8_SA(1, 1), a1, 1);
            PG8_WAIT_L(8); PG8_BAR; PG8_WAIT_L(0); PG8_MMA(0, 0, At, B0); PG8_BAR; PG8_SCHED;
            PG8_LDB(B1, 0, 1); PG8_STAGE(PG8_SB(0, 0), b2, voffB);
            PG8_BAR; PG8_WAIT_L(0); PG8_MMA(0, 1, At, B1); PG8_BAR;
            PG8_LDA(At, 0, 1); PG8_STAGE_A(PG8_SA(0, 0), a2, 0);
            PG8_BAR; PG8_WAIT_L(0); PG8_MMA(1, 0, At, B0); PG8_BAR; PG8_SCHED;
            PG8_STAGE(PG8_SB(0, 1), b2 + hstepB, voffB);
            PG8_WAIT_V(6); PG8_BAR; PG8_MMA(1, 1, At, B1); PG8_BAR;
            PG8_LDB(B0, 1, 0); PG8_SCHED; PG8_LDA(At, 1, 0); PG8_STAGE_A(PG8_SA(0, 1), a2, 1);
            PG8_WAIT_L(8); PG8_BAR; PG8_WAIT_L(0); PG8_MMA(0, 0, At, B0); PG8_BAR; PG8_SCHED;
            PG8_LDB(B1, 1, 1); PG8_STAGE(PG8_SB(1, 0), b3, voffB);
            PG8_BAR; PG8_WAIT_L(0); PG8_MMA(0, 1, At, B1); PG8_BAR;
            PG8_LDA(At, 1, 1); PG8_STAGE_A(PG8_SA(1, 0), a3, 0);
            PG8_BAR; PG8_WAIT_L(0); PG8_MMA(1, 0, At, B0); PG8_BAR; PG8_SCHED;
            PG8_STAGE(PG8_SB(1, 1), b3 + hstepB, voffB);
            PG8_WAIT_V(6); PG8_BAR; PG8_MMA(1, 1, At, B1); PG8_BAR;
            }
        }
        if constexpr (ALIGN_EPI) { if (wr == 0) PG8_BAR; }
        E(acc, cur, wr, wc, fr, fq);
        if (REP_EPI > 1 && !VARNT) { for (int _r = 1; _r < REP_EPI; ++_r) E(acc, cur, wr, wc, fr, fq); }
        if (!has_next) break;
        if (!(VARNT && cur.cont))
#pragma unroll
        for (int a = 0; a < 2; ++a)
#pragma unroll
            for (int b = 0; b < 2; ++b)
#pragma unroll
                for (int m = 0; m < 4; ++m)
#pragma unroll
                    for (int n = 0; n < 2; ++n) acc[a][b][m][n] = (f32x4){0.f, 0.f, 0.f, 0.f};
        cur = nxt; cA = nA; cB = nB; ++ui;
        if constexpr (ALIGN_EPI) { if (wr == 1) PG8_BAR; }
    }
    PG8_WAIT_V(0);
    if constexpr (!ALIGN_EPI) { if (wr == 0) PG8_BAR; }
    PG8_BAR;
#undef PG8_SA
#undef PG8_SB
#undef PG8_STAGE
#undef PG8_LDA
#undef PG8_LDB
#undef PG8_MMA
#undef PG8_WAIT_V
#undef PG8_WAIT_L
#undef PG8_BAR
#undef PG8_SCHED
}
}
using pg8::Unit;

struct Args { const float* in[25]; float* out; unsigned char* ws; };
enum { I_X = 0, I_C, I_CTX, I_CCTX, I_WADA, I_BADA, I_NORM1, I_NORM2, I_WIN, I_RETDECAY, I_CONVW, I_POOLW, I_POOLSCALE, I_WRETOUT, I_WCONVOUT, I_WPOOLOUT, I_WO,
       I_WRG, I_BRG, I_WRE, I_BRE, I_W1, I_W3, I_W2, I_FINALNORM };

struct KArgs {
    __device__ __forceinline__ const char __attribute__((address_space(4)))* base() const { const char __attribute__((address_space(4)))* kp = (const char __attribute__((address_space(4)))*)__builtin_amdgcn_kernarg_segment_ptr(); asm volatile("" : "+s"(kp)); return kp; }
    __device__ __forceinline__ const float* in(int i) const { return *(const float* const __attribute__((address_space(4)))*)(base() + 8 * i); }
    __device__ __forceinline__ float* out() const { return *(float* const __attribute__((address_space(4)))*)(base() + 200); }
    __device__ __forceinline__ unsigned char* wsp() const { return *(unsigned char* const __attribute__((address_space(4)))*)(base() + 208); }
};
struct InProxy { __device__ __forceinline__ const float* operator[](int i) const { return KArgs().in(i); } };
struct DArgs { InProxy in; float* out; unsigned char* ws; };
__device__ __forceinline__ bf16_t* xrow_ptr(const DArgs& a, int row) { return (bf16_t*)(a.ws + WS_X) + (size_t)row * D; }

__device__ __forceinline__ void p0_mod(const DArgs& a, LAS unsigned char* lds, int tid, int wid, int lane) {
    LAS float* s = (LAS float*)lds;
    LAS float* red = (LAS float*)(lds + 17 * 1024 * 4);
    const float* c = a.in[I_C]; const float* cc = a.in[I_CCTX];
    for (int i = tid; i < 17 * 1024; i += 512) { const int r = i >> 10, k = i & 1023; const float v = r < 16 ? c[r * 1024 + k] : cc[k]; s[i] = silu_f(v); }
    __syncthreads();
    float* MOD = (float*)(a.ws + WS_MOD);
    for (int it = blockIdx.x; it < DEPTH * 96; it += gridDim.x) {
        const int l = it / 96, nb = it % 96, n = nb * 64 + lane;
        const float* W = a.in[I_WADA] + (size_t)l * D * NMOD + n;
        float acc[17];
#pragma unroll
        for (int r = 0; r < 17; ++r) acc[r] = 0.f;
        for (int k4 = 0; k4 < 32; ++k4) {
            const int k = wid * 128 + k4 * 4;
            const float w0 = W[(size_t)k * NMOD], w1 = W[(size_t)(k + 1) * NMOD], w2 = W[(size_t)(k + 2) * NMOD], w3 = W[(size_t)(k + 3) * NMOD];
#pragma unroll
            for (int r = 0; r < 17; ++r) { const f32x4 sv = *(const LAS f32x4*)(s + r * 1024 + k); acc[r] += sv[0] * w0 + sv[1] * w1 + sv[2] * w2 + sv[3] * w3; }
        }
#pragma unroll
        for (int r = 0; r < 17; ++r) red[(wid * 17 + r) * 64 + lane] = acc[r];
        __syncthreads();
        for (int i = tid; i < 17 * 64; i += 512) { const int r = i >> 6, nn = i & 63; float v = 0.f;
#pragma unroll
            for (int w = 0; w < 8; ++w) v += red[(w * 17 + r) * 64 + nn];
            MOD[((size_t)l * 17 + r) * NMOD + nb * 64 + nn] = v + a.in[I_BADA][(size_t)l * NMOD + nb * 64 + nn]; }
        __syncthreads();
    }
    if (blockIdx.x == gridDim.x - 1) {
        float* TAB = (float*)(a.ws + WS_TAB);
        if (tid < 32) { const float x = a.in[I_RETDECAY][tid]; TAB[tid] = -log1pf(expf(-x)) * 1.4426950408889634f; }
        for (int i = tid; i < 2048; i += 512) { const int v = i >> 5, f = i & 31; const float inv = powf(10000.0f, -(float)f / 32.0f); float sn, cs; sincosf((float)v * inv, &sn, &cs);
            TAB[32 + i] = cs; TAB[32 + 2048 + i] = sn; }
    }
}

template <class F>
__device__ __forceinline__ void cvt_item(const float* W, int N, int k0, int n0, float scale, LAS float* scr, int lane, const F& dstrow) {
    const int kk0 = lane >> 3, nq = lane & 7;
    f32x4 v[8];
#pragma unroll
    for (int i = 0; i < 8; ++i) v[i] = *(const f32x4*)(W + (size_t)(k0 + kk0 + 8 * i) * N + n0 + 4 * nq);
#pragma unroll
    for (int i = 0; i < 8; ++i) { LAS float* d = scr + (kk0 + 8 * i) * 33 + 4 * nq; d[0] = v[i][0]; d[1] = v[i][1]; d[2] = v[i][2]; d[3] = v[i][3]; }
    LDS_WAIT(); asm volatile("" ::: "memory");
    const int c = lane & 7;
#pragma unroll
    for (int j = 0; j < 4; ++j) { const int n = (lane >> 3) + 8 * j; const LAS float* sp = scr + (8 * c) * 33 + n;
        u32x4 o; o.x = cvt_pk_bf16(sp[0 * 33] * scale, sp[1 * 33] * scale); o.y = cvt_pk_bf16(sp[2 * 33] * scale, sp[3 * 33] * scale);
        o.z = cvt_pk_bf16(sp[4 * 33] * scale, sp[5 * 33] * scale); o.w = cvt_pk_bf16(sp[6 * 33] * scale, sp[7 * 33] * scale);
        *(u32x4*)(dstrow(n0 + n) + k0 + 8 * c) = o; }
    LDS_WAIT(); asm volatile("" ::: "memory");
}
__device__ __forceinline__ int win_row(int n) {
    if (n < 1024) { const int sec = n >> 9, c = n & 511, head = c >> 7, d = c & 127, half = d >> 6, idx = d & 63;
        return sec * 512 + (head >> 1) * 256 + half * 128 + (head & 1) * 64 + idx; }
    if (n >= 3584 && n < 4608) { const int isx = n >= 4096, i = isx ? n - 4096 : n - 3584; return 3584 + (i >> 7) * 256 + isx * 128 + (i & 127); }
    return n;
}
__device__ __forceinline__ void convert_weights(const DArgs& a, int l, LAS unsigned char* lds, int wid, int lane) {
    LAS float* scr = (LAS float*)(lds + wid * 8448);
    const int gw = blockIdx.x * 8 + wid, NGW = gridDim.x * 8;
    bf16_t* WIN = (bf16_t*)(a.ws + WS_WIN); bf16_t* WRET = (bf16_t*)(a.ws + WS_WRET); bf16_t* WCONV = (bf16_t*)(a.ws + WS_WCONV); bf16_t* WO = (bf16_t*)(a.ws + WS_WO);
    bf16_t* W13 = (bf16_t*)(a.ws + WS_W13); bf16_t* W2 = (bf16_t*)(a.ws + WS_W2); bf16_t* WPOOL = (bf16_t*)(a.ws + WS_WPOOL);
    constexpr int I0 = 16 * 256, I1 = 16 * 32, I2 = 8 * 32, I3 = 16 * 32, I4 = 16 * 256, I5 = 16 * 256, I6 = 16 * 256, I7 = 512;
    constexpr int NIT = I0 + I1 + I2 + I3 + I4 + I5 + I6 + I7;
    for (int it0 = gw; it0 < NIT; it0 += NGW) {
        int r = __builtin_amdgcn_readfirstlane(it0);
        if (r < I0) { const int kb = r / 256, nb = r % 256, n0 = nb * 32; const float sc = (n0 >= 512 && n0 < 1024) ? 0.08838834764831845f : 1.0f;
            cvt_item(a.in[I_WIN] + (size_t)l * D * 8192, 8192, kb * 64, n0, sc, scr, lane, [&](int n) { return WIN + (size_t)win_row(n) * 1024; }); continue; } r -= I0;
        if (r < I1) { const int kb = r / 32, nb = r % 32; cvt_item(a.in[I_WRETOUT] + (size_t)l * 1024 * 1024, 1024, kb * 64, nb * 32, 1.f, scr, lane, [&](int n) { return WRET + (size_t)n * 1024; }); continue; } r -= I1;
        if (r < I2) { const int kb = r / 32, nb = r % 32; cvt_item(a.in[I_WCONVOUT] + (size_t)l * 512 * 1024, 1024, kb * 64, nb * 32, 1.f, scr, lane, [&](int n) { return WCONV + (size_t)n * 1024; }); continue; } r -= I2;
        if (r < I3) { const int kb = r / 32, nb = r % 32; cvt_item(a.in[I_WO] + (size_t)l * 1024 * 1024, 1024, kb * 64, nb * 32, 1.f, scr, lane, [&](int n) { return WO + (size_t)n * 1024; }); continue; } r -= I3;
        if (r < I4 + I5) { const int is3 = r >= I4; if (is3) r -= I4; const int e = r / 256, q = r % 256, kb = q / 16, nb = q % 16;
            const float* src = a.in[is3 ? I_W3 : I_W1] + ((size_t)l * 16 + e) * 1024 * 512;
            cvt_item(src, 512, kb * 64, nb * 32, 1.f, scr, lane, [&](int n) { return W13 + ((size_t)e * 1024 + (n >> 7) * 256 + is3 * 128 + (n & 127)) * 1024; }); continue; } r -= I4 + I5;
        if (r < I6) { const int e = r / 256, q = r % 256, kb = q / 32, nb = q % 32;
            cvt_item(a.in[I_W2] + ((size_t)l * 16 + e) * 512 * 1024, 1024, kb * 64, nb * 32, 1.f, scr, lane, [&](int n) { return W2 + ((size_t)e * 1024 + n) * 512; }); continue; } r -= I6;
        {
            const int g = r / 128, q = r % 128, cb = q / 16, nb = q % 16, n = nb * 64 + lane;
            const float* pw = a.in[I_POOLW] + ((size_t)l * 4 + g) * 128 * 128 + (size_t)cb * 16 * 128;
            const float* sc = a.in[I_POOLSCALE] + (size_t)l * 512 + g * 128;
            const float* wpo = a.in[I_WPOOLOUT] + ((size_t)l * 512 + g * 128) * 1024 + n;
            float acc[16];
#pragma unroll
            for (int cc = 0; cc < 16; ++cc) acc[cc] = 0.f;
            for (int d = 0; d < 128; ++d) { const float w = wpo[(size_t)d * 1024] * sc[d];
#pragma unroll
                for (int cc = 0; cc < 16; ++cc) acc[cc] += pw[cc * 128 + d] * w; }
            u32x4 o0, o1; o0.x = cvt_pk_bf16(acc[0], acc[1]); o0.y = cvt_pk_bf16(acc[2], acc[3]); o0.z = cvt_pk_bf16(acc[4], acc[5]); o0.w = cvt_pk_bf16(acc[6], acc[7]);
            o1.x = cvt_pk_bf16(acc[8], acc[9]); o1.y = cvt_pk_bf16(acc[10], acc[11]); o1.z = cvt_pk_bf16(acc[12], acc[13]); o1.w = cvt_pk_bf16(acc[14], acc[15]);
            bf16_t* dst = WCONV + (size_t)n * 1024 + 512 + g * 128 + cb * 16; *(u32x4*)dst = o0; *(u32x4*)(dst + 8) = o1;
        }
    }
}

template <int MODE>
__device__ __forceinline__ void phase_n1(const DArgs& a, int l, int wid, int lane) {
    const int gw = blockIdx.x * 8 + wid, NGW = gridDim.x * 8;
    const float* MOD = (const float*)(a.ws + WS_MOD);
    const float* nw = a.in[I_NORM1] + (size_t)l * D;
    bf16_t* H = (bf16_t*)(a.ws + WS_H);
    f32x4 px[4], pg[4], pg1[4]; u32x2 py0[4], py1[4], pya[4], pxb[4];
    const int* SLOTOF = (const int*)(a.ws + WS_SLOTOF); const float* ROUTEC = (const float*)(a.ws + WS_ROUTEC); const bf16_t* YS = (const bf16_t*)(a.ws + WS_YS);
    int sl0 = 0, sl1 = 0; float cw0 = 0.f, cw1 = 0.f, cc0 = 0.f, cc1 = 0.f;
#define N1_SLOTS(rw) do { if (MODE != 0) { sl0 = SLOTOF[2 * (size_t)(rw)]; sl1 = SLOTOF[2 * (size_t)(rw) + 1]; cw0 = ROUTEC[2 * (size_t)(rw)]; cw1 = ROUTEC[2 * (size_t)(rw) + 1]; } } while (0)
#define N1_PRELOAD(rw) do { const int _b = (rw) / TPB, _r = (rw) - _b * TPB, _m = _r < CL ? 16 : _b; \
        if (MODE == 0) { const float* _src = _r < CL ? a.in[I_CTX] + (size_t)(_b * CL + _r) * D : a.in[I_X] + (size_t)(_b * SEQ + (_r - CL)) * D; \
            _Pragma("unroll") for (int j = 0; j < 4; ++j) px[j] = *(const f32x4*)(_src + 4 * lane + 256 * j); } \
        else { const bf16_t* _xp = xrow_ptr(a, (rw)); const float* _g = MOD + ((size_t)(l - 1) * 17 + _m) * NMOD + 5 * D; \
            const bf16_t* _y0 = YS + (size_t)sl0 * D; const bf16_t* _y1 = YS + (size_t)sl1 * D; cc0 = cw0; cc1 = cw1; \
            _Pragma("unroll") for (int j = 0; j < 4; ++j) { const int c = 4 * lane + 256 * j; pxb[j] = *(const u32x2*)(_xp + c); pg[j] = *(const f32x4*)(_g + c); pg1[j] = *(const f32x4*)(_g - 3 * D + c); py0[j] = *(const u32x2*)(_y0 + c); py1[j] = *(const u32x2*)(_y1 + c); \
                pya[j] = *(const u32x2*)((const bf16_t*)(a.ws + WS_YATT) + (size_t)(rw) * D + c); } } } while (0)
    if (gw < T) { N1_SLOTS(gw); N1_PRELOAD(gw); if (gw + NGW < T) N1_SLOTS(gw + NGW); }
    for (int row = gw; row < T; row += NGW) {
        const int b = row / TPB, r = row - b * TPB, mrow = r < CL ? 16 : b;
        bf16_t* xp = xrow_ptr(a, row);
        f32x4 v[4];
        if (MODE == 0) {
#pragma unroll
            for (int j = 0; j < 4; ++j) v[j] = px[j];
        } else {
            const float c0 = cc0, c1 = cc1;
#pragma unroll
            for (int j = 0; j < 4; ++j) { const f32x4 g = pg[j], g1 = pg1[j]; const u32x2 p0 = py0[j], p1 = py1[j], pa = pya[j], xb = pxb[j]; f32x4 x = {bf_lo(xb.x), bf_hi(xb.x), bf_lo(xb.y), bf_hi(xb.y)};
                x[0] += g1[0] * bf_lo(pa.x); x[1] += g1[1] * bf_hi(pa.x); x[2] += g1[2] * bf_lo(pa.y); x[3] += g1[3] * bf_hi(pa.y);
                v[j][0] = x[0] + g[0] * (c0 * bf_lo(p0.x) + c1 * bf_lo(p1.x)); v[j][1] = x[1] + g[1] * (c0 * bf_hi(p0.x) + c1 * bf_hi(p1.x));
                v[j][2] = x[2] + g[2] * (c0 * bf_lo(p0.y) + c1 * bf_lo(p1.y)); v[j][3] = x[3] + g[3] * (c0 * bf_hi(p0.y) + c1 * bf_hi(p1.y)); }
        }
        if (row + NGW < T) { N1_PRELOAD(row + NGW); if (row + 2 * NGW < T) N1_SLOTS(row + 2 * NGW); }
        float ss = 0.f;
#pragma unroll
        for (int j = 0; j < 4; ++j) { u32x2 o; o.x = cvt_pk_bf16(v[j][0], v[j][1]); o.y = cvt_pk_bf16(v[j][2], v[j][3]); *(u32x2*)(xp + 4 * lane + 256 * j) = o; ss += (v[j][0] * v[j][0] + v[j][1] * v[j][1]) + (v[j][2] * v[j][2] + v[j][3] * v[j][3]); }
        const float rr = rsqrtf(wave_sum(ss) * (1.0f / D) + EPS);
        const float* sh = MOD + ((size_t)l * 17 + mrow) * NMOD; const float* sc = sh + D;
#pragma unroll
        for (int j = 0; j < 4; ++j) { const int c = 4 * lane + 256 * j; const f32x4 w = *(const f32x4*)(nw + c), s1 = *(const f32x4*)(sc + c), s0 = *(const f32x4*)(sh + c);
            f32x4 h; for (int q = 0; q < 4; ++q) h[q] = v[j][q] * rr * w[q] * (1.0f + s1[q]) + s0[q];
            u32x2 o; o.x = cvt_pk_bf16(h[0], h[1]); o.y = cvt_pk_bf16(h[2], h[3]); *(u32x2*)(H + (size_t)row * D + c) = o; }
    }
}

__device__ __forceinline__ void phase_n2(const DArgs& a, int l, LAS unsigned char* ldsb, int tid, int wid, int lane, const int skip, const bool dry = false) {
    const float* MOD = (const float*)(a.ws + WS_MOD);
    const float* nw = a.in[I_NORM2] + (size_t)l * D;
    bf16_t* H = (bf16_t*)(a.ws + WS_H);
    const bf16_t* YATT = (const bf16_t*)(a.ws + WS_YATT);
    const float* wrg = a.in[I_WRG] + (size_t)l * D * 4; const float* wre = a.in[I_WRE] + (size_t)l * D * 16;
    const float* brg = a.in[I_BRG] + l * 4; const float* bre = a.in[I_BRE] + l * 16;
    float* ROUTEC = (float*)(a.ws + WS_ROUTEC); int* LIST = (int*)(a.ws + WS_LIST);
    unsigned* gcnt = (unsigned*)(a.ws + WS_CTL) + CW_CNT + 64 * l;
    LAS int* re = (LAS int*)(ldsb + LC_RE); LAS int* lcnt = (LAS int*)(ldsb + LC_LCNT);
    const int rpw = (T + (int)gridDim.x - 1) / (int)gridDim.x, row0 = blockIdx.x * rpw, row1 = (row0 + rpw < T) ? row0 + rpw : T;
    LAS float* wl = (LAS float*)ldsb;
    for (int i = tid; i < 1024 * 4; i += 512) { const int c = i >> 2, z = i & 3; wl[z * 1024 + c] = wrg[i]; }
    for (int i = tid; i < 1024 * 16; i += 512) { const int c = i >> 4, z = i & 15; wl[(4 + z) * 1024 + c] = wre[i]; }
    if (tid < 48) lcnt[tid] = 0;
    __syncthreads();
    f32x4 pg[2][4]; u32x2 pp[2][4], px[2][4];
    int ln = lane;
#define N2_PRELOAD(s_, rw) do { const int _b = (rw) / TPB, _r = (rw) - _b * TPB, _m = _r < CL ? 16 : _b; const bf16_t* _xp = xrow_ptr(a, (rw)); const float* _g = MOD + ((size_t)l * 17 + _m) * NMOD + 2 * D; \
        _Pragma("unroll") for (int j = 0; j < 4; ++j) { const int c = 4 * ln + 256 * j; px[s_][j] = *(const u32x2*)(_xp + c); pg[s_][j] = *(const f32x4*)(_g + c); pp[s_][j] = *(const u32x2*)(YATT + (size_t)(rw) * D + c); } } while (0)
    for (int row = row0 + wid; row < row1; row += 16) {
        asm volatile("" : "+v"(ln));
        const int rws[2] = {row, row + 8 < row1 ? row + 8 : row};
        N2_PRELOAD(0, rws[0]); N2_PRELOAD(1, rws[1]);
        f32x4 v[2][4];
        const float gs = dry ? 0.f : 1.f;
#pragma unroll
        for (int s2 = 0; s2 < 2; ++s2)
#pragma unroll
            for (int j = 0; j < 4; ++j) { const u32x2 xb = px[s2][j]; const f32x4 x = {bf_lo(xb.x), bf_hi(xb.x), bf_lo(xb.y), bf_hi(xb.y)}, g = pg[s2][j]; const u32x2 p = pp[s2][j];
                v[s2][j][0] = x[0] + gs * g[0] * bf_lo(p.x); v[s2][j][1] = x[1] + gs * g[1] * bf_hi(p.x); v[s2][j][2] = x[2] + gs * g[2] * bf_lo(p.y); v[s2][j][3] = x[3] + gs * g[3] * bf_hi(p.y); }
        bool act[2]; int mrow[2];
#pragma unroll
        for (int s2 = 0; s2 < 2; ++s2) { const int rw = rws[s2], b = rw / TPB, r = rw - b * TPB; mrow[s2] = r < CL ? 16 : b; const bool present = (s2 == 0) || (row + 8 < row1);
            act[s2] = present && !(skip && r < CL);
            if (present && skip && r < CL && lane == 0) { re[rw - row0] = -1; re[160 + rw - row0] = -1; } }
        if (!act[0] && !act[1]) continue;
        float rr[2];
#pragma unroll
        for (int s2 = 0; s2 < 2; ++s2) { float ss = 0.f;
#pragma unroll
            for (int j = 0; j < 4; ++j) ss += (v[s2][j][0] * v[s2][j][0] + v[s2][j][1] * v[s2][j][1]) + (v[s2][j][2] * v[s2][j][2] + v[s2][j][3] * v[s2][j][3]);
            rr[s2] = rsqrtf(wave_sum(ss) * (1.0f / D) + EPS); }
        f32x2 lg[2][20];
#pragma unroll
        for (int s2 = 0; s2 < 2; ++s2)
#pragma unroll
            for (int q = 0; q < 20; ++q) lg[s2][q] = (f32x2){0.f, 0.f};
#pragma unroll
        for (int j = 0; j < 4; ++j) { const int c = 4 * ln + 256 * j; const f32x4 w = *(const f32x4*)(nw + c);
            f32x4 h[2];
#pragma unroll
            for (int s2 = 0; s2 < 2; ++s2) { const float* sh = MOD + ((size_t)l * 17 + mrow[s2]) * NMOD + 3 * D; const f32x4 s1 = *(const f32x4*)(sh + D + c), s0 = *(const f32x4*)(sh + c);
#pragma unroll
                for (int q = 0; q < 4; ++q) h[s2][q] = v[s2][j][q] * rr[s2] * w[q] * (1.0f + s1[q]) + s0[q];
                { u32x2 o; o.x = cvt_pk_bf16(h[s2][0], h[s2][1]); o.y = cvt_pk_bf16(h[s2][2], h[s2][3]); *(u32x2*)(H + (size_t)rws[s2] * D + c) = o; } }
#pragma unroll
            for (int z = 0; z < 20; ++z) { const f32x4 w4 = *(const LAS f32x4*)(wl + z * 1024 + c); const f32x2 wa2 = {w4[0], w4[1]}, wb2 = {w4[2], w4[3]};
                lg[0][z] += (f32x2){h[0][0], h[0][1]} * wa2; lg[0][z] += (f32x2){h[0][2], h[0][3]} * wb2; lg[1][z] += (f32x2){h[1][0], h[1][1]} * wa2; lg[1][z] += (f32x2){h[1][2], h[1][3]} * wb2;
                if ((z & 3) == 3) asm volatile("" : "+v"(lg[0][z - 3]), "+v"(lg[0][z - 2]), "+v"(lg[0][z - 1]), "+v"(lg[0][z]), "+v"(lg[1][z - 3]), "+v"(lg[1][z - 2]), "+v"(lg[1][z - 1]), "+v"(lg[1][z])); }
            asm volatile("" ::: "memory"); }
#define N2_ROUTE(s2) if (act[s2]) { \
            const int rw = rws[s2]; \
            float lgs[20]; \
            _Pragma("unroll") for (int k4 = 0; k4 < 5; ++k4) { const float u4 = wave_sum4(lg[s2][4 * k4][0] + lg[s2][4 * k4][1], lg[s2][4 * k4 + 1][0] + lg[s2][4 * k4 + 1][1], lg[s2][4 * k4 + 2][0] + lg[s2][4 * k4 + 2][1], lg[s2][4 * k4 + 3][0] + lg[s2][4 * k4 + 3][1]); \
                lgs[4 * k4] = lane_val(u4, 0); lgs[4 * k4 + 2] = lane_val(u4, 16); lgs[4 * k4 + 1] = lane_val(u4, 32); lgs[4 * k4 + 3] = lane_val(u4, 48); } \
            float g0 = lgs[0] + brg[0], g1 = lgs[1] + brg[1], g2 = lgs[2] + brg[2], g3 = lgs[3] + brg[3]; \
            int gi = 0; float gm = g0; if (g1 > gm) { gm = g1; gi = 1; } if (g2 > gm) { gm = g2; gi = 2; } if (g3 > gm) { gm = g3; gi = 3; } \
            const float gtop = 1.0f / (expf(g0 - gm) + expf(g1 - gm) + expf(g2 - gm) + expf(g3 - gm)); \
            float e[4]; \
            _Pragma("unroll") \
            for (int i = 0; i < 4; ++i) { const float v0 = lgs[4 + i] + bre[i], v1 = lgs[8 + i] + bre[4 + i], v2 = lgs[12 + i] + bre[8 + i], v3 = lgs[16 + i] + bre[12 + i]; \
                e[i] = gi == 0 ? v0 : gi == 1 ? v1 : gi == 2 ? v2 : v3; } \
            int ia = 0; float va = e[0]; if (e[1] > va) { va = e[1]; ia = 1; } if (e[2] > va) { va = e[2]; ia = 2; } if (e[3] > va) { va = e[3]; ia = 3; } \
            int ib = -1; float vb = -3.0e38f; \
            _Pragma("unroll") \
            for (int i = 0; i < 4; ++i) if (i != ia && e[i] > vb) { vb = e[i]; ib = i; } \
            const float wa = 1.0f / (1.0f + expf(vb - va)), wb = 1.0f - wa; \
            if (lane == 0 && !dry) { const int e0 = gi * 4 + ia, e1 = gi * 4 + ib; const int li = rw - row0; re[li] = e0; re[160 + li] = e1; \
                ROUTEC[(size_t)rw * 2] = wa * gtop; ROUTEC[(size_t)rw * 2 + 1] = wb * gtop; \
                __hip_atomic_fetch_add(lcnt + e0, 1, __ATOMIC_RELAXED, __HIP_MEMORY_SCOPE_WORKGROUP); __hip_atomic_fetch_add(lcnt + e1, 1, __ATOMIC_RELAXED, __HIP_MEMORY_SCOPE_WORKGROUP); } \
        }
        N2_ROUTE(0) N2_ROUTE(1)
#undef N2_ROUTE
    }
#undef N2_PRELOAD
    __syncthreads();
    if (dry) return;
    if (tid < 16) { lcnt[16 + tid] = (int)__hip_atomic_fetch_add(gcnt + tid, (unsigned)lcnt[tid], __ATOMIC_RELAXED, __HIP_MEMORY_SCOPE_AGENT); }
    __syncthreads();
    const int nr = row1 - row0;
    if (tid < 2 * nr && re[(tid & 1) * 160 + (tid >> 1)] >= 0) { const int li = tid >> 1, rk = tid & 1; const int e = re[rk * 160 + li];
        const int p = lcnt[16 + e] + __hip_atomic_fetch_add(lcnt + 32 + e, 1, __ATOMIC_RELAXED, __HIP_MEMORY_SCOPE_WORKGROUP);
        LIST[(size_t)e * T + p] = ((row0 + li) << 1) | rk; }
    __syncthreads();
}

__device__ __forceinline__ void phase_final(const DArgs& a, int wid, int lane, float poison) {
    const int gw = blockIdx.x * 8 + wid, NGW = gridDim.x * 8;
    const float* MOD = (const float*)(a.ws + WS_MOD);
    const float* nw = a.in[I_FINALNORM];
    const int* SLOTOF = (const int*)(a.ws + WS_SLOTOF); const float* ROUTEC = (const float*)(a.ws + WS_ROUTEC); const bf16_t* YS = (const bf16_t*)(a.ws + WS_YS);
    int sl0 = 0, sl1 = 0; float cw0 = 0.f, cw1 = 0.f;
#define FN_ROW(q_) (((q_) / SEQ) * TPB + CL + ((q_) % SEQ))
    if (gw < NB * SEQ) { const int r0 = FN_ROW(gw); sl0 = SLOTOF[2 * (size_t)r0]; sl1 = SLOTOF[2 * (size_t)r0 + 1]; cw0 = ROUTEC[2 * (size_t)r0]; cw1 = ROUTEC[2 * (size_t)r0 + 1]; }
    for (int lr = gw; lr < NB * SEQ; lr += NGW) {
        const int b = lr / SEQ, row = b * TPB + CL + (lr - b * SEQ);
        const bf16_t* xp = xrow_ptr(a, row); float* op = a.out + (size_t)lr * D;
        const float* gt2 = MOD + ((size_t)(DEPTH - 1) * 17 + b) * NMOD + 5 * D; const float* gt1 = gt2 - 3 * D;
        const bf16_t* y0 = YS + (size_t)sl0 * D; const bf16_t* y1 = YS + (size_t)sl1 * D; const bf16_t* ya = (const bf16_t*)(a.ws + WS_YATT) + (size_t)row * D;
        const float c0 = cw0, c1 = cw1;
        if (lr + NGW < NB * SEQ) { const int rn = FN_ROW(lr + NGW); sl0 = SLOTOF[2 * (size_t)rn]; sl1 = SLOTOF[2 * (size_t)rn + 1]; cw0 = ROUTEC[2 * (size_t)rn]; cw1 = ROUTEC[2 * (size_t)rn + 1]; }
        f32x4 v[4]; float ss = 0.f;
#pragma unroll
        for (int j = 0; j < 4; ++j) { const int c = 4 * lane + 256 * j; const u32x2 xb = *(const u32x2*)(xp + c); f32x4 x = {bf_lo(xb.x), bf_hi(xb.x), bf_lo(xb.y), bf_hi(xb.y)}; const f32x4 g = *(const f32x4*)(gt2 + c), g1 = *(const f32x4*)(gt1 + c);
            const u32x2 p0 = *(const u32x2*)(y0 + c), p1 = *(const u32x2*)(y1 + c), pa = *(const u32x2*)(ya + c);
            x[0] += g1[0] * bf_lo(pa.x); x[1] += g1[1] * bf_hi(pa.x); x[2] += g1[2] * bf_lo(pa.y); x[3] += g1[3] * bf_hi(pa.y);
            v[j][0] = x[0] + g[0] * (c0 * bf_lo(p0.x) + c1 * bf_lo(p1.x)); v[j][1] = x[1] + g[1] * (c0 * bf_hi(p0.x) + c1 * bf_hi(p1.x));
            v[j][2] = x[2] + g[2] * (c0 * bf_lo(p0.y) + c1 * bf_lo(p1.y)); v[j][3] = x[3] + g[3] * (c0 * bf_hi(p0.y) + c1 * bf_hi(p1.y));
            ss += (v[j][0] * v[j][0] + v[j][1] * v[j][1]) + (v[j][2] * v[j][2] + v[j][3] * v[j][3]); }
        const float rr = rsqrtf(wave_sum(ss) * (1.0f / D) + EPS);
#pragma unroll
        for (int j = 0; j < 4; ++j) { const int c = 4 * lane + 256 * j; const f32x4 w = *(const f32x4*)(nw + c);
            f32x4 o; for (int q = 0; q < 4; ++q) o[q] = poison != 0.f ? poison : v[j][q] * rr * w[q];
            *(f32x4*)(op + c) = o; }
    }
}

struct SchedInproj {
    const char* H; const char* W; int G, w, nA, skip;
    __device__ __forceinline__ bool next(int i, Unit& u) const {
        int L; if (i < 4) L = i * G + w; else { if (w < nA) return false; L = 4 * G + (i - 4) * (G - nA) + (w - nA); }
        const int nMn = skip ? 32 : 36;
        if (L < nMn * 28) { int pm, pi; pg8::tile_map(L, nMn, 28, pm, pi); if (skip) pm = (pm >> 3) * 9 + 1 + (pm & 7); const int wt = pi < 4 ? pi : pi + 4;
            u.a = H + (size_t)pm * 256 * 2048; u.b = W + (size_t)wt * 256 * 2048; u.pm = pm; u.pn = wt; u.kind = 0; u.nt = 16; u.cont = 0; return true; }
        L -= nMn * 28;
        if (L < 6 * 36) { int pi, pn; pg8::tile_map(L, 6, 36, pi, pn); const int wt = pi + 2;
            u.a = W + (size_t)wt * 256 * 2048; u.b = H + (size_t)pn * 256 * 2048; u.pm = wt; u.pn = pn; u.kind = 1; u.nt = 16; u.cont = 0; return true; }
        return false;
    }
};
struct EpiInproj {
    static constexpr bool PERM = true;
    unsigned char* ws; const float* lg2;
    const float* ropec; const float* ropes; bf16_t* gate;
    template <int ACT> __device__ __forceinline__ void plain(const f32x4 (&acc)[2][2][4][2], bf16_t* dst, int ld, int row0, int col0) const {
#pragma unroll
        for (int ai = 0; ai < 2; ++ai)
#pragma unroll
            for (int m = 0; m < 4; ++m) { bf16_t* rowp = dst + (size_t)(row0 + ai * 128 + m * 16) * ld + col0;
#pragma unroll
                for (int bj = 0; bj < 2; ++bj) { f32x4 v0 = acc[ai][bj][m][0], v1 = acc[ai][bj][m][1];
                    if (ACT == 1) { for (int q = 0; q < 4; ++q) { v0[q] = silu_f(v0[q]); v1[q] = silu_f(v1[q]); } }
                    if (ACT == 2) { for (int q = 0; q < 4; ++q) { v0[q] = sigmoid_f(v0[q]); v1[q] = sigmoid_f(v1[q]); } }
                    *(u32x4*)(rowp + bj * 128) = pack8(v0, v1); } }
    }
    __device__ __forceinline__ void operator()(const f32x4 (&acc)[2][2][4][2], const Unit& u, int wr, int wc, int fr, int fq) const {
        if (u.kind == 0) {
            const int wt = u.pn, row0 = u.pm * 256 + wr * 64 + fr, cl = wc * 32 + 8 * fq;
            if (wt < 4) {
                const int isk = wt >> 1, t = wt & 1, head = 2 * t + (wc >> 1), idx0 = 32 * (wc & 1) + 8 * fq;
                bf16_t* dA = (bf16_t*)(ws + (isk ? WS_KF : WS_QF));
#pragma unroll
                for (int ai = 0; ai < 2; ++ai)
#pragma unroll
                    for (int m = 0; m < 4; ++m) {
                        const int gr = row0 + ai * 128 + m * 16, r = gr % TPB;
                        f32x4 c0 = {1.f, 1.f, 1.f, 1.f}, c1 = c0, s0 = {0.f, 0.f, 0.f, 0.f}, s1 = s0;
                        if (r >= CL) { const int pos = r - CL, v = (wc & 1) ? (pos & 63) : (pos >> 6); const float* cp = ropec + v * 32 + 8 * fq; const float* sp = ropes + v * 32 + 8 * fq;
                            c0 = *(const f32x4*)cp; c1 = *(const f32x4*)(cp + 4); s0 = *(const f32x4*)sp; s1 = *(const f32x4*)(sp + 4); }
                        const f32x4 x10 = acc[ai][0][m][0], x11 = acc[ai][0][m][1], x20 = acc[ai][1][m][0], x21 = acc[ai][1][m][1];
                        const f32x4 o10 = x10 * c0 - x20 * s0, o11 = x11 * c1 - x21 * s1, o20 = x10 * s0 + x20 * c0, o21 = x11 * s1 + x21 * c1;
                        bf16_t* pa = dA + (size_t)gr * 512 + head * 128 + idx0;
                        *(u32x4*)pa = pack8(o10, o11); *(u32x4*)(pa + 64) = pack8(o20, o21);
                    }
            } else if (wt < 12) plain<1>(acc, (bf16_t*)(ws + WS_GS), 1024, row0, (wt - 8) * 256 + cl);
            else if (wt < 14) plain<0>(acc, (bf16_t*)(ws + WS_CB), 512, row0, (wt - 12) * 256 + cl);
            else if (wt < 18) { bf16_t* dst = (bf16_t*)(ws + WS_CU);
#pragma unroll
                for (int ai = 0; ai < 2; ++ai)
#pragma unroll
                    for (int m = 0; m < 4; ++m)
                        *(u32x4*)(dst + (size_t)(row0 + ai * 128 + m * 16) * 512 + (wt - 14) * 128 + cl) = pack8(acc[ai][0][m][0] * acc[ai][1][m][0], acc[ai][0][m][1] * acc[ai][1][m][1]);
            } else if (wt < 20) plain<0>(acc, (bf16_t*)(ws + WS_PI), 512, row0, (wt - 18) * 256 + cl);
            else {
                unsigned char* gp = (unsigned char*)gate + (size_t)((wt - 20) >> 2) * TG * 1024 + ((wt - 20) & 3) * 256 + (wc * 4 + fq) * 16;
#pragma unroll
                for (int ai = 0; ai < 2; ++ai)
#pragma unroll
                    for (int m = 0; m < 4; ++m) { u32x4 w;
#pragma unroll
                        for (int bj = 0; bj < 2; ++bj) { unsigned lo = 0u, hi = 0u;
#pragma unroll
                            for (int q = 0; q < 4; ++q) { lo |= (unsigned)(sigmoid_f(acc[ai][bj][m][0][q]) * 255.0f + 0.5f) << (8 * q); hi |= (unsigned)(sigmoid_f(acc[ai][bj][m][1][q]) * 255.0f + 0.5f) << (8 * q); }
                            if (bj == 0) { w.x = lo; w.y = hi; } else { w.z = lo; w.w = hi; } }
                        *(u32x4*)(gp + (size_t)(row0 + ai * 128 + m * 16) * 1024) = w; }
            }
        } else {
            const int wt = u.pm, tok0 = u.pn * 256 + wc * 32 + 8 * fq;
            if (wt < 4) {
                const int t = wt - 2, head = 2 * t + wr; const float lgf = lg2[head], lgb = lg2[4 + head];
                bf16_t* dF = (bf16_t*)(ws + WS_KTF); bf16_t* dB = (bf16_t*)(ws + WS_KTB);
#pragma unroll
                for (int m = 0; m < 4; ++m) { const int idx = 16 * m + fr;
#pragma unroll
                    for (int bj = 0; bj < 2; ++bj) { f32x4 o1[2], o2[2], sF[2], sB[2];
#pragma unroll
                        for (int n = 0; n < 2; ++n) { const int g0 = tok0 + bj * 128 + 4 * n, r0 = g0 % TPB; const f32x4 x1 = acc[0][bj][m][n], x2 = acc[1][bj][m][n];
                            f32x4 cs = {1.f, 1.f, 1.f, 1.f}, sn = {0.f, 0.f, 0.f, 0.f};
                            if (r0 >= CL) { const int pos = r0 - CL;
                                if (m < 2) { const float c = ropec[(pos >> 6) * 32 + idx], s = ropes[(pos >> 6) * 32 + idx]; cs = (f32x4){c, c, c, c}; sn = (f32x4){s, s, s, s}; }
                                else { const int v = pos & 63;
#pragma unroll
                                    for (int j = 0; j < 4; ++j) { cs[j] = ropec[(v + j) * 32 + idx - 32]; sn[j] = ropes[(v + j) * 32 + idx - 32]; } } }
                            o1[n] = x1 * cs - x2 * sn; o2[n] = x1 * sn + x2 * cs;
#pragma unroll
                            for (int j = 0; j < 4; ++j) { const float fi = (float)((g0 + j) & 127); sF[n][j] = __builtin_amdgcn_exp2f(-fi * lgf); sB[n][j] = __builtin_amdgcn_exp2f(fi * lgb); } }
                        const size_t r1 = (size_t)(head * 128 + idx) * TG + tok0 + bj * 128, r2 = r1 + (size_t)64 * TG;
                        *(u32x4*)(dF + r1) = pack8(o1[0] * sF[0], o1[1] * sF[1]); *(u32x4*)(dF + r2) = pack8(o2[0] * sF[0], o2[1] * sF[1]);
                        *(u32x4*)(dB + r1) = pack8(o1[0] * sB[0], o1[1] * sB[1]); *(u32x4*)(dB + r2) = pack8(o2[0] * sB[0], o2[1] * sB[1]);
                    } }
            } else {
                bf16_t* dst = (bf16_t*)(ws + WS_VT); const int e0 = (wt - 4) * 256 + wr * 64 + fr;
#pragma unroll
                for (int ai = 0; ai < 2; ++ai)
#pragma unroll
                    for (int m = 0; m < 4; ++m)
#pragma unroll
                        for (int bj = 0; bj < 2; ++bj) *(u32x4*)(dst + (size_t)(e0 + ai * 128 + m * 16) * TG + tok0 + bj * 128) = pack8(acc[ai][bj][m][0], acc[ai][bj][m][1]);
            }
        }
    }
};

struct SchedPlain {
    const char* A; const char* B; size_t astep, bstep; int nM, nN, G, c, skip;
    __device__ __forceinline__ bool next(int i, Unit& u) const {
        const int L = i * G + c; if (L >= nM * nN) return false;
        int pm, pn; pg8::tile_map(L, nM, nN, pm, pn); if (skip) pm = (pm >> 3) * 9 + 1 + (pm & 7);
        u.a = A + (size_t)pm * astep; u.b = B + (size_t)pn * bstep; u.pm = pm; u.pn = pn; u.kind = 0; u.nt = 0; u.cont = 0; return true;
    }
};
struct SchedG4 {
    const char* YRET; const char* YCP; const char* WRET; const char* WCP; int nM, G, c, skip;
    __device__ __forceinline__ bool next(int i, Unit& u) const {
        const int mac = i / 3, sub = i - mac * 3, L = mac * G + c; if (L >= nM * 4) return false;
        int pm, pn; pg8::tile_map(L, nM, 4, pm, pn); if (skip) pm = (pm >> 3) * 9 + 1 + (pm & 7);
        const size_t ao = (size_t)pm * 256 * 2048, bo = (size_t)pn * 256 * 2048;
        u.a = sub == 0 ? YRET + ao : YCP + ao + (sub == 2 ? 1024 : 0); u.b = sub == 0 ? WRET + bo : WCP + bo + (sub == 2 ? 1024 : 0);
        u.pm = pm; u.pn = pn; u.kind = sub; u.nt = sub == 0 ? 16 : 8; u.cont = sub != 2; return true;
    }
};
struct EpiG4 {
    static constexpr bool PERM = true;
    const unsigned char* gate;    bf16_t* merged;
    __device__ __forceinline__ void operator()(f32x4 (&acc)[2][2][4][2], const Unit& u, int wr, int wc, int fr, int fq) const {
        const int row0 = u.pm * 256 + wr * 64 + fr, col0 = u.pn * 256 + wc * 32 + 8 * fq, k = u.kind;
        const unsigned char* gk = gate + (size_t)k * TG * 1024 + u.pn * 256 + (wc * 4 + fq) * 16;
#pragma unroll
        for (int ai = 0; ai < 2; ++ai)
#pragma unroll
            for (int m = 0; m < 4; ++m) { const int row = row0 + ai * 128 + m * 16;
                const u32x4 g = *(const u32x4*)(gk + (size_t)row * 1024); u32x4 h = g; if (k < 2) h = *(const u32x4*)(gk + (size_t)TG * 1024 + (size_t)row * 1024);
#pragma unroll
                for (int bj = 0; bj < 2; ++bj) { const int col = col0 + bj * 128;
                    const unsigned g0 = bj ? g.z : g.x, g1 = bj ? g.w : g.y, h0 = bj ? h.z : h.x, h1 = bj ? h.w : h.y;
                    f32x4 v0 = acc[ai][bj][m][0], v1 = acc[ai][bj][m][1];
#pragma unroll
                    for (int q = 0; q < 4; ++q) {
                        const float n0 = fmaxf((float)((g0 >> (8 * q)) & 255u), 2.55e-16f), n1 = fmaxf((float)((g1 >> (8 * q)) & 255u), 2.55e-16f);
                        const float d0 = fmaxf((float)((h0 >> (8 * q)) & 255u), 2.55e-16f), d1 = fmaxf((float)((h1 >> (8 * q)) & 255u), 2.55e-16f);
                        v0[q] *= k < 2 ? n0 * __builtin_amdgcn_rcpf(d0) : n0 * (1.0f / 255.0f); v1[q] *= k < 2 ? n1 * __builtin_amdgcn_rcpf(d1) : n1 * (1.0f / 255.0f); }
                    if (k < 2) { acc[ai][bj][m][0] = v0; acc[ai][bj][m][1] = v1; }
                    else *(u32x4*)(merged + (size_t)row * 1024 + col) = pack8(v0, v1); } }
    }
};
struct EpiPlainBf16 {
    static constexpr bool PERM = true;
    bf16_t* O; int ld;
    __device__ __forceinline__ void operator()(const f32x4 (&acc)[2][2][4][2], const Unit& u, int wr, int wc, int fr, int fq) const {
        const int row0 = u.pm * 256 + wr * 64 + fr, col0 = u.pn * 256 + wc * 32 + 8 * fq;
#pragma unroll
        for (int ai = 0; ai < 2; ++ai)
#pragma unroll
            for (int m = 0; m < 4; ++m)
#pragma unroll
                for (int bj = 0; bj < 2; ++bj) *(u32x4*)(O + (size_t)(row0 + ai * 128 + m * 16) * ld + col0 + bj * 128) = pack8(acc[ai][bj][m][0], acc[ai][bj][m][1]);
    }
};

struct SchedMoe {
    const char* A; const char* W; size_t astep, wrow; const LAS int* tile_e; int ntiles, G, c;
    __device__ __forceinline__ bool next(int i, Unit& u) const {
        const int L = i * G + c; if (L >= ntiles * 4) return false;
        int tile, pn; pg8::tile_map(L, ntiles, 4, tile, pn); const int e = tile_e[tile];
        u.a = A + (size_t)tile * astep; u.b = W + ((size_t)e * 1024 + pn * 256) * wrow; u.pm = tile; u.pn = pn; u.kind = e; u.nt = 0; u.cont = 0; return true;
    }
};
struct SchedMoeG {
    const char* A; const char* W; const LAS int* tile_e; const LAS int* cnt; const LAS int* poff; const int* LIST; LAS int* tbl; int ntiles, G, c;
    __device__ __forceinline__ bool next(int i, Unit& u) const {
        const int L = i * G + c; if (L >= ntiles * 4) return false;
        int tile, pn; pg8::tile_map(L, ntiles, 4, tile, pn); const int e = tile_e[tile];
        u.a = A; u.b = W + ((size_t)e * 1024 + pn * 256) * 2048; u.pm = tile; u.pn = pn; u.kind = e; u.nt = 0; u.cont = 0; return true;
    }
    __device__ __forceinline__ void fill_table(const Unit& u, int buf, int tid) const {
        if (tid < 256) { const int e = u.kind; const int* src = LIST + (size_t)e * T + (u.pm * 256 - poff[e]) + tid;
            __builtin_amdgcn_global_load_lds((const unsigned*)src, (LAS unsigned*)(tbl + buf * 256 + (tid & ~63)), 4, 0, 0); }
    }
    __device__ __forceinline__ void load_offsets(const Unit& u, int buf, const int (&gR)[2], const int (&gC2)[2], unsigned (&vo0)[2], unsigned (&vo1)[2]) const {
        const int e = u.kind, pb = u.pm * 256 - poff[e], n = cnt[e];
#pragma unroll
        for (int i = 0; i < 2; ++i) { const int r0 = gR[i], r1 = 128 + gR[i]; const int e0 = tbl[buf * 256 + r0], e1 = tbl[buf * 256 + r1];
            vo0[i] = (unsigned)((pb + r0 < n) ? (e0 >> 1) : 0) * 2048u + (unsigned)gC2[i]; vo1[i] = (unsigned)((pb + r1 < n) ? (e1 >> 1) : 0) * 2048u + (unsigned)gC2[i]; }
    }
};
namespace pg8 { template <> struct sched_gather<SchedMoeG> { static constexpr bool value = true; }; }
struct EpiMoeUp {
    static constexpr bool PERM = true;
    bf16_t* ACT;
    __device__ __forceinline__ void operator()(const f32x4 (&acc)[2][2][4][2], const Unit& u, int wr, int wc, int fr, int fq) const {
        const int row0 = u.pm * 256 + wr * 64 + fr, col0 = u.pn * 128 + wc * 32 + 8 * fq;
#pragma unroll
        for (int ai = 0; ai < 2; ++ai)
#pragma unroll
            for (int m = 0; m < 4; ++m) { f32x4 v0, v1;
#pragma unroll
                for (int q = 0; q < 4; ++q) { v0[q] = silu_fast(acc[ai][0][m][0][q]) * acc[ai][1][m][0][q]; v1[q] = silu_fast(acc[ai][0][m][1][q]) * acc[ai][1][m][1][q]; }
                *(u32x4*)(ACT + (size_t)(row0 + ai * 128 + m * 16) * 512 + col0) = pack8(v0, v1); }
    }
};

template <int NROWS, bool PERMROWS>
__device__ __forceinline__ void dma_tile(LAS unsigned char* ldst, const char* gsrc, size_t row_stride, int tid) {
#pragma unroll
    for (int i = 0; i < NROWS * 16 / 512; ++i) {
        const int q = tid + 512 * i, row = q >> 4, cg = q & 15;
        const int srow = PERMROWS ? ((row & ~31) + pg8::perm32(row & 31)) : row;
        const char* src = gsrc + (size_t)srow * row_stride + ((cg ^ (row & 15)) << 4);
        __builtin_amdgcn_global_load_lds((const unsigned*)src, (LAS unsigned*)(ldst + ((tid & ~63) + 512 * i) * 16), 16, 0, 0);
    }
}
__device__ __forceinline__ bf16x8 lds_frag(const LAS unsigned char* base, int row, int gk) { return *(const LAS bf16x8*)(base + row * 256 + ((gk ^ (row & 15)) << 4)); }

#ifndef CP_DEFER_PCT
#define CP_DEFER_PCT 38
#endif
#ifndef CP_DEFER_PCT_LAST
#define CP_DEFER_PCT_LAST 10
#endif
constexpr int CP_TOTAL = TG * 16 + TG * 16;
constexpr int CP_DEFER_A = (CP_TOTAL / 100 * CP_DEFER_PCT) / 512 * 512, CP_DEFER_B = (CP_TOTAL / 100 * CP_DEFER_PCT_LAST) / 512 * 512;
#define CP_DEFER (skipctx ? CP_DEFER_B : CP_DEFER_A)
constexpr int NCHAIN = BG * 4 * 2 * 4;
template <int NROWS>
__device__ __forceinline__ void dma_tile128(LAS unsigned char* ldst, const char* gsrc, size_t row_stride, int tid) {
#pragma unroll
    for (int i = 0; i < NROWS * 8 / 512; ++i) {
        const int q = tid + 512 * i, row = q >> 3, cg = q & 7;
        const char* src = gsrc + (size_t)row * row_stride + ((cg ^ ((row >> 1) & 7)) << 4);
        __builtin_amdgcn_global_load_lds((const unsigned*)src, (LAS unsigned*)(ldst + ((tid & ~63) + 512 * i) * 16), 16, 0, 0);
    }
}
__device__ __forceinline__ bf16x8 lds_frag128(const LAS unsigned char* base, int row, int gk) { return *(const LAS bf16x8*)(base + row * 128 + ((gk ^ ((row >> 1) & 7)) << 4)); }

__device__ __forceinline__ void chain_unit(const DArgs& a, int unit, const float* lg2p, LAS unsigned char* lds, int tid, int wid, int lane) {
    const int eq = unit & 3, dir = (unit >> 2) & 1, h = (unit >> 3) & 3, bb = unit >> 5, fr = lane & 15, fq = lane >> 4;
    const char* VT = (const char*)(a.ws + WS_VT) + (size_t)(h * 256 + eq * 64) * TG * 2;
    const char* KT = (const char*)(a.ws + (dir ? WS_KTB : WS_KTF)) + (size_t)(h * 128) * TG * 2;
    bf16_t* ST = (bf16_t*)(a.ws + WS_STATES) + ((size_t)((bb * 4 + h) * 2 + dir) * NCH) * 256 * 128;
    const float dec = exp2f(128.0f * lg2p[dir * 4 + h]);
    f32x4 acc[4];
#pragma unroll
    for (int m = 0; m < 4; ++m) acc[m] = (f32x4){0.f, 0.f, 0.f, 0.f};
#define CH_ORDER(s) (dir == 0 ? (s) : ((s) < 2 ? 1 - (s) : 19 - (s)))
#define CH_LOAD(hs) do { const int _h = (hs) < 2 * NCH ? (hs) : 2 * NCH - 1; const int _c = CH_ORDER(_h >> 1); const size_t _tb = (size_t)(bb * TPB + _c * 128 + (_h & 1) * 64) * 2; \
        LAS unsigned char* _sl = lds + ((hs) % 5) * 24576; dma_tile128<64>(_sl, VT + _tb, (size_t)TG * 2, tid); dma_tile128<128>(_sl + 8192, KT + _tb, (size_t)TG * 2, tid); } while (0)
#define CH_MMA(hs) do { const LAS unsigned char* buf = lds + ((hs) % 5) * 24576; bf16x8 kf_[2], vf_[2][4];     \
        _Pragma("unroll") for (int ks = 0; ks < 2; ++ks) { kf_[ks] = lds_frag128(buf + 8192, wid * 16 + fr, 4 * ks + fq); \
            _Pragma("unroll") for (int m = 0; m < 4; ++m) vf_[ks][m] = lds_frag128(buf, 16 * m + fr, 4 * ks + fq); } \
        LDS_WAIT(); __builtin_amdgcn_sched_barrier(0); \
        _Pragma("unroll") for (int ks = 0; ks < 2; ++ks) \
            _Pragma("unroll") for (int m = 0; m < 4; ++m) acc[m] = __builtin_amdgcn_mfma_f32_16x16x32_bf16(kf_[ks], vf_[ks][m], acc[m], 0, 0, 0); } while (0)
#define CH_SYNC() do { asm volatile("s_waitcnt vmcnt(11)" ::: "memory"); LDS_WAIT(); __builtin_amdgcn_s_barrier(); asm volatile("" ::: "memory"); } while (0)
    CH_LOAD(0); CH_LOAD(1); CH_LOAD(2); CH_LOAD(3);
    asm volatile("s_waitcnt vmcnt(9)" ::: "memory"); LDS_WAIT(); __builtin_amdgcn_s_barrier(); asm volatile("" ::: "memory");
    for (int s = 0; s < NCH; ++s) {
        const int hs = 2 * s;
        if (s > 0) CH_SYNC();
        u32x2 pub[4];
#pragma unroll
        for (int m = 0; m < 4; ++m) { acc[m] = acc[m] * dec; pub[m].x = cvt_pk_bf16(acc[m][0], acc[m][1]); pub[m].y = cvt_pk_bf16(acc[m][2], acc[m][3]); }
        CH_LOAD(hs + 4);
        CH_MMA(hs);
        {
            const int _c = CH_ORDER(s); bf16_t* sp = ST + (size_t)_c * 256 * 128 + (size_t)(eq * 64 + 16 * (fq & 1) + fr) * 128 + wid * 16 + 8 * (fq >> 1);
#pragma unroll
            for (int mp = 0; mp < 2; ++mp) { unsigned ax = pub[2 * mp].x, ay = pub[2 * mp].y, bx = pub[2 * mp + 1].x, by = pub[2 * mp + 1].y;
                asm volatile("s_nop 1\n\tv_permlane16_swap_b32 %0, %1\n\tv_permlane16_swap_b32 %2, %3\n\ts_nop 1" : "+v"(ax), "+v"(bx), "+v"(ay), "+v"(by));
                const u32x4 w = {ax, ay, bx, by}; *(u32x4*)(sp + (size_t)mp * 32 * 128) = w; }
        }
        CH_SYNC();
        CH_MMA(hs + 1);
        CH_LOAD(hs + 5);
    }
    asm volatile("s_waitcnt vmcnt(0)" ::: "memory"); LDS_WAIT(); __builtin_amdgcn_s_barrier(); asm volatile("" ::: "memory");
#undef CH_ORDER
#undef CH_LOAD
#undef CH_MMA
#undef CH_SYNC
}
__device__ __forceinline__ void conv_pool(const DArgs& a, int l, int worker, int nworkers, int tid, const int skip, const int it0, const int it1) {
    const bf16_t* CU = (const bf16_t*)(a.ws + WS_CU); const bf16_t* CBp = (const bf16_t*)(a.ws + WS_CB); const bf16_t* PI = (const bf16_t*)(a.ws + WS_PI);
    bf16_t* YCONV = (bf16_t*)(a.ws + WS_YCONV); bf16_t* POOLED = (bf16_t*)(a.ws + WS_POOLED);
    const float* cw = a.in[I_CONVW] + (size_t)l * 3 * 512;
    const int nitem = TG * 16;
    for (int it = it0 + worker * 512 + tid; it < it1; it += nworkers * 512) {
        const int ispool = it >= nitem, q = ispool ? it - nitem : it;
        if (!ispool) {
            const int c0 = (q & 63) * 8, gr0 = (q >> 6) * 4;
            const int r = gr0 % TPB, lo = r < CL ? 0 : CL, hi = r < CL ? CL : TPB;
            if (skip && r < CL) continue;
            u32x4 u[6], bv[4];
            u[0] = (u32x4){0u, 0u, 0u, 0u}; u[5] = u[0];
            if (r > lo) u[0] = *(const u32x4*)(CU + (size_t)(gr0 - 1) * 512 + c0);
#pragma unroll
            for (int j = 0; j < 4; ++j) { u[1 + j] = *(const u32x4*)(CU + (size_t)(gr0 + j) * 512 + c0); bv[j] = *(const u32x4*)(CBp + (size_t)(gr0 + j) * 512 + c0); }
            if (r + 4 < hi) u[5] = *(const u32x4*)(CU + (size_t)(gr0 + 4) * 512 + c0);
            const f32x4 w00 = *(const f32x4*)(cw + c0), w01 = *(const f32x4*)(cw + c0 + 4), w10 = *(const f32x4*)(cw + 512 + c0), w11 = *(const f32x4*)(cw + 512 + c0 + 4),
                        w20 = *(const f32x4*)(cw + 1024 + c0), w21 = *(const f32x4*)(cw + 1024 + c0 + 4);
#pragma unroll
            for (int j = 0; j < 4; ++j) { const u32x4 u0 = u[j], u1 = u[j + 1], u2 = u[j + 2], b = bv[j]; f32x4 o0, o1;
                o0[0] = bf_lo(b.x) * (w00[0] * bf_lo(u0.x) + w10[0] * bf_lo(u1.x) + w20[0] * bf_lo(u2.x)); o0[1] = bf_hi(b.x) * (w00[1] * bf_hi(u0.x) + w10[1] * bf_hi(u1.x) + w20[1] * bf_hi(u2.x));
                o0[2] = bf_lo(b.y) * (w00[2] * bf_lo(u0.y) + w10[2] * bf_lo(u1.y) + w20[2] * bf_lo(u2.y)); o0[3] = bf_hi(b.y) * (w00[3] * bf_hi(u0.y) + w10[3] * bf_hi(u1.y) + w20[3] * bf_hi(u2.y));
                o1[0] = bf_lo(b.z) * (w01[0] * bf_lo(u0.z) + w11[0] * bf_lo(u1.z) + w21[0] * bf_lo(u2.z)); o1[1] = bf_hi(b.z) * (w01[1] * bf_hi(u0.z) + w11[1] * bf_hi(u1.z) + w21[1] * bf_hi(u2.z));
                o1[2] = bf_lo(b.w) * (w01[2] * bf_lo(u0.w) + w11[2] * bf_lo(u1.w) + w21[2] * bf_lo(u2.w)); o1[3] = bf_hi(b.w) * (w01[3] * bf_hi(u0.w) + w11[3] * bf_hi(u1.w) + w21[3] * bf_hi(u2.w));
                *(u32x4*)(YCONV + (size_t)(gr0 + j) * 1024 + c0) = pack8(o0, o1); }
        } else {
            const int cbl = q & 15; const int rest = q >> 4; const int g2 = rest / (TG / 4), gr0 = 4 * (rest - g2 * (TG / 4)), cc0 = g2 * 128 + cbl * 8;
            const int r0 = gr0 % TPB, lo2 = r0 < CL ? 0 : CL, hi2 = r0 < CL ? CL : TPB, base2 = gr0 - r0, tl0 = r0 - lo2, n = hi2 - lo2;
            if (skip && r0 < CL) continue;
            const int win = 2 << g2, hw = win >> 1;
            f32x4 s0[4], s1[4]; u32x4 pc[4];
#pragma unroll
            for (int j = 0; j < 4; ++j) { s0[j] = (f32x4){0.f, 0.f, 0.f, 0.f}; s1[j] = s0[j]; pc[j] = (u32x4){0u, 0u, 0u, 0u}; }
            const bf16_t* prow = PI + (size_t)(base2 + lo2) * 512 + cc0;
#pragma unroll
            for (int k = 0; k < 19; ++k) { const int sidx = tl0 - hw + k;
                if (k < win + 3 && sidx >= 0 && sidx < n) { const u32x4 p = *(const u32x4*)(prow + (size_t)sidx * 512);
                    const f32x4 f0 = {bf_lo(p.x), bf_hi(p.x), bf_lo(p.y), bf_hi(p.y)}, f1 = {bf_lo(p.z), bf_hi(p.z), bf_lo(p.w), bf_hi(p.w)};
#pragma unroll
                    for (int j = 0; j < 4; ++j) { if (k >= j && k - j < win) { s0[j] += f0; s1[j] += f1; } if (k - j == hw) pc[j] = p; } } }
#pragma unroll
            for (int j = 0; j < 4; ++j) { const int tl = tl0 + j; int sa = tl - hw; if (sa < 0) sa = 0; int sb = tl + win - hw; if (sb > n) sb = n;
                const float inv = 1.0f / (float)(sb - sa); const u32x4 p = pc[j]; f32x4 o0, o1;
                o0[0] = s0[j][0] * inv - bf_lo(p.x); o0[1] = s0[j][1] * inv - bf_hi(p.x); o0[2] = s0[j][2] * inv - bf_lo(p.y); o0[3] = s0[j][3] * inv - bf_hi(p.y);
                o1[0] = s1[j][0] * inv - bf_lo(p.z); o1[1] = s1[j][1] * inv - bf_hi(p.z); o1[2] = s1[j][2] * inv - bf_lo(p.w); o1[3] = s1[j][3] * inv - bf_hi(p.w);
                *(u32x4*)(YCONV + (size_t)(gr0 + j) * 1024 + 512 + cc0) = pack8(o0, o1); }
        }
    }
}

__device__ __forceinline__ void finalize_unit(const DArgs& a, int unit, const float* lg2p, LAS unsigned char* lds, int tid, int wid, int lane) {
    asm volatile("" : "+v"(tid)); lane = tid & 63;
    const int c = unit % NCH, h = (unit / NCH) & 3, bb = unit / (NCH * 4), fr = lane & 15, fq = lane >> 4;
    const int tok0 = bb * TPB + c * 128;
    const float lgf = lg2p[h], lgb = lg2p[4 + h];
    LAS unsigned char* R0 = lds; LAS unsigned char* R1 = lds + 65536;
    const char* QF = (const char*)(a.ws + WS_QF);
    dma_tile<128, false>(R0, (const char*)(a.ws + WS_KF) + ((size_t)tok0 * 512 + h * 128) * 2, 1024, tid);
    bf16x8 qf[4];
    { const size_t ro = ((size_t)(tok0 + wid * 16 + fr) * 512 + h * 128 + 8 * fq) * 2;
#pragma unroll
      for (int ks = 0; ks < 4; ++ks) qf[ks] = *(const bf16x8*)(QF + ro + ks * 64); }
    asm volatile("" ::: "memory");
    const char* ST = (const char*)(a.ws + WS_STATES) + ((size_t)((bb * 4 + h) * 2) * NCH + c) * 256 * 128 * 2;
    dma_tile<128, true>(R0 + 32768, ST, 256, tid);
    dma_tile<256, true>(R1, (const char*)(a.ws + WS_VT) + ((size_t)(h * 256) * TG + tok0) * 2, (size_t)TG * 2, tid);
    asm volatile("s_waitcnt vmcnt(12)" ::: "memory"); __builtin_amdgcn_s_barrier(); asm volatile("" ::: "memory");
    bf16x8 pf[4];
    const int i = wid * 16 + fr;
    {
        f32x4 sc[8];
#pragma unroll
        for (int n = 0; n < 8; ++n) sc[n] = (f32x4){0.f, 0.f, 0.f, 0.f};
#pragma unroll
        for (int k2 = 0; k2 < 2; ++k2) { bf16x8 kfr[2][8];
#pragma unroll
            for (int kk = 0; kk < 2; ++kk)
#pragma unroll
                for (int n = 0; n < 8; ++n) kfr[kk][n] = lds_frag(R0, 16 * n + fr, 4 * (2 * k2 + kk) + fq);
            LDS_WAIT(); __builtin_amdgcn_sched_barrier(0);
#pragma unroll
            for (int kk = 0; kk < 2; ++kk)
#pragma unroll
                for (int n = 0; n < 8; ++n) sc[n] = __builtin_amdgcn_mfma_f32_16x16x32_bf16(kfr[kk][n], qf[2 * k2 + kk], sc[n], 0, 0, 0); }
#pragma unroll
        for (int n = 0; n < 8; ++n)
#pragma unroll
            for (int jj = 0; jj < 4; ++jj) { const int d = i - (16 * n + 4 * fq + jj); const float w = d == 0 ? 2.0f : __builtin_amdgcn_exp2f(d > 0 ? lgf * (float)d : lgb * (float)(-d)); sc[n][jj] *= w; }
#pragma unroll
        for (int ks = 0; ks < 4; ++ks) { u32x4 w; w.x = cvt_pk_bf16(sc[2 * ks][0], sc[2 * ks][1]); w.y = cvt_pk_bf16(sc[2 * ks][2], sc[2 * ks][3]);
            w.z = cvt_pk_bf16(sc[2 * ks + 1][0], sc[2 * ks + 1][1]); w.w = cvt_pk_bf16(sc[2 * ks + 1][2], sc[2 * ks + 1][3]);
            asm volatile("s_nop 1\n\tv_permlane16_swap_b32 %0, %1\n\tv_permlane16_swap_b32 %2, %3\n\ts_nop 1" : "+v"(w.x), "+v"(w.z), "+v"(w.y), "+v"(w.w));
            pf[ks] = __builtin_bit_cast(bf16x8, w); }
    }
    asm volatile("s_waitcnt vmcnt(0)" ::: "memory"); LDS_WAIT(); __builtin_amdgcn_s_barrier(); asm volatile("" ::: "memory");
    dma_tile<128, true>(R0, ST + (size_t)128 * 256, 256, tid);
    f32x4 o[16];
#pragma unroll
    for (int n = 0; n < 16; ++n) o[n] = (f32x4){0.f, 0.f, 0.f, 0.f};
#pragma unroll
    for (int ks = 0; ks < 4; ++ks) { bf16x8 vw[16];
#pragma unroll
        for (int n = 0; n < 16; ++n) vw[n] = lds_frag(R1, 16 * n + fr, 4 * ks + (((fq & 1) << 1) | (fq >> 1)));
        LDS_WAIT(); __builtin_amdgcn_sched_barrier(0);
#pragma unroll
        for (int n = 0; n < 16; ++n) o[n] = __builtin_amdgcn_mfma_f32_16x16x32_bf16(vw[n], pf[ks], o[n], 0, 0, 0); }
    { const float r1 = __builtin_amdgcn_exp2f(-lgf * (float)i);
#pragma unroll
      for (int n = 0; n < 16; ++n) o[n] = o[n] * r1; }
#pragma unroll
    for (int k2 = 0; k2 < 2; ++k2) { bf16x8 sfr[2][8];
#pragma unroll
        for (int kk = 0; kk < 2; ++kk)
#pragma unroll
            for (int n = 0; n < 8; ++n) sfr[kk][n] = lds_frag(R0 + 32768, 16 * n + fr, 4 * (2 * k2 + kk) + fq);
        LDS_WAIT(); __builtin_amdgcn_sched_barrier(0);
#pragma unroll
        for (int kk = 0; kk < 2; ++kk)
#pragma unroll
            for (int n = 0; n < 8; ++n) o[n] = __builtin_amdgcn_mfma_f32_16x16x32_bf16(sfr[kk][n], qf[2 * k2 + kk], o[n], 0, 0, 0); }
    asm volatile("s_waitcnt vmcnt(0) lgkmcnt(0)" ::: "memory"); __builtin_amdgcn_s_barrier(); asm volatile("" ::: "memory");
    dma_tile<256, true>(R1, ST + (size_t)NCH * 256 * 128 * 2, 256, tid);
#pragma unroll
    for (int k2 = 0; k2 < 2; ++k2) { bf16x8 sfr[2][8];
#pragma unroll
        for (int kk = 0; kk < 2; ++kk)
#pragma unroll
            for (int n = 0; n < 8; ++n) sfr[kk][n] = lds_frag(R0, 16 * n + fr, 4 * (2 * k2 + kk) + fq);
        LDS_WAIT(); __builtin_amdgcn_sched_barrier(0);
#pragma unroll
        for (int kk = 0; kk < 2; ++kk)
#pragma unroll
            for (int n = 0; n < 8; ++n) o[8 + n] = __builtin_amdgcn_mfma_f32_16x16x32_bf16(sfr[kk][n], qf[2 * k2 + kk], o[8 + n], 0, 0, 0); }
    { const float r2 = __builtin_amdgcn_exp2f((lgf + lgb) * (float)i);
#pragma unroll
      for (int n = 0; n < 16; ++n) o[n] = o[n] * r2; }
    asm volatile("s_waitcnt vmcnt(0) lgkmcnt(0)" ::: "memory"); __builtin_amdgcn_s_barrier(); asm volatile("" ::: "memory");
    const size_t ro = (size_t)(tok0 + wid * 16 + fr) * 1024 + h * 256 + 8 * fq;
    const bf16_t* GS = (const bf16_t*)(a.ws + WS_GS) + ro; bf16_t* YR = (bf16_t*)(a.ws + WS_YRET) + ro;
    u32x4 gsv[8];
#pragma unroll
    for (int p = 0; p < 8; ++p) gsv[p] = *(const u32x4*)(GS + 32 * p);
    asm volatile("" ::: "memory");
#pragma unroll
    for (int ks = 0; ks < 4; ++ks) { bf16x8 sbr[16];
#pragma unroll
        for (int n = 0; n < 16; ++n) sbr[n] = lds_frag(R1, 16 * n + fr, 4 * ks + fq);
        LDS_WAIT(); __builtin_amdgcn_sched_barrier(0);
#pragma unroll
        for (int n = 0; n < 16; ++n) o[n] = __builtin_amdgcn_mfma_f32_16x16x32_bf16(sbr[n], qf[ks], o[n], 0, 0, 0); }
    { const float r3 = __builtin_amdgcn_exp2f(-lgb * (float)i);
#pragma unroll
      for (int n = 0; n < 16; ++n) o[n] = o[n] * r3; }
    float s = 0.f;
#pragma unroll
    for (int n = 0; n < 16; ++n) s += (o[n][0] + o[n][1]) + (o[n][2] + o[n][3]);
    s = rows4_sum(s);
    const float mu = s * (1.0f / 256.0f); float q = 0.f;
#pragma unroll
    for (int n = 0; n < 16; ++n) { o[n] = o[n] - mu; q += (o[n][0] * o[n][0] + o[n][1] * o[n][1]) + (o[n][2] * o[n][2] + o[n][3] * o[n][3]); }
    q = rows4_sum(q);
    const float rstd = rsqrtf(q * (1.0f / 256.0f) + EPS);
#pragma unroll
    for (int p = 0; p < 8; ++p) { const u32x4 g = gsv[p]; f32x4 v0 = o[2 * p] * rstd, v1 = o[2 * p + 1] * rstd;
        v0[0] *= bf_lo(g.x); v0[1] *= bf_hi(g.x); v0[2] *= bf_lo(g.y); v0[3] *= bf_hi(g.y); v1[0] *= bf_lo(g.z); v1[1] *= bf_hi(g.z); v1[2] *= bf_lo(g.w); v1[3] *= bf_hi(g.w);
        *(u32x4*)(YR + 32 * p) = pack8(v0, v1); }
    LDS_WAIT(); __builtin_amdgcn_s_barrier(); asm volatile("" ::: "memory");
}

__device__ __forceinline__ void finalize_ctx_unit(const DArgs& a, int unit, const float* lg2p, LAS unsigned char* lds, int tid, int wid, int lane) {
    asm volatile("" : "+v"(tid)); lane = tid & 63;
    const int c = unit & 1, h = (unit >> 1) & 3, bb = unit >> 3, fr = lane & 15, fq = lane >> 4;
    const int tok0 = bb * TPB + c * 128, tokx = bb * TPB + (1 - c) * 128;
    const float lgf = lg2p[h], lgb = lg2p[4 + h];
    LAS unsigned char* R0 = lds; LAS unsigned char* R1 = lds + 65536;
    const char* QF = (const char*)(a.ws + WS_QF);
    dma_tile<128, false>(R0, (const char*)(a.ws + WS_KF) + ((size_t)tok0 * 512 + h * 128) * 2, 1024, tid);
    dma_tile<128, false>(R0 + 32768, (const char*)(a.ws + WS_KF) + ((size_t)tokx * 512 + h * 128) * 2, 1024, tid);
    dma_tile<256, true>(R1, (const char*)(a.ws + WS_VT) + ((size_t)(h * 256) * TG + tok0) * 2, (size_t)TG * 2, tid);
    bf16x8 qf[4];
    { const size_t ro = ((size_t)(tok0 + wid * 16 + fr) * 512 + h * 128 + 8 * fq) * 2;
#pragma unroll
      for (int ks = 0; ks < 4; ++ks) qf[ks] = *(const bf16x8*)(QF + ro + ks * 64); }
    asm volatile("s_waitcnt vmcnt(0)" ::: "memory"); __builtin_amdgcn_s_barrier(); asm volatile("" ::: "memory");
    bf16x8 pf[2][4];
    const int i = wid * 16 + fr;
#pragma unroll
    for (int kc = 0; kc < 2; ++kc) {
        const LAS unsigned char* Kb = R0 + kc * 32768; const int off = kc == 0 ? 0 : (c ? 128 : -128);
        f32x4 sc[8];
#pragma unroll
        for (int n = 0; n < 8; ++n) sc[n] = (f32x4){0.f, 0.f, 0.f, 0.f};
#pragma unroll
        for (int k2 = 0; k2 < 2; ++k2) { bf16x8 kfr[2][8];
#pragma unroll
            for (int kk = 0; kk < 2; ++kk)
#pragma unroll
                for (int n = 0; n < 8; ++n) kfr[kk][n] = lds_frag(Kb, 16 * n + fr, 4 * (2 * k2 + kk) + fq);
            LDS_WAIT(); __builtin_amdgcn_sched_barrier(0);
#pragma unroll
            for (int kk = 0; kk < 2; ++kk)
#pragma unroll
                for (int n = 0; n < 8; ++n) sc[n] = __builtin_amdgcn_mfma_f32_16x16x32_bf16(kfr[kk][n], qf[2 * k2 + kk], sc[n], 0, 0, 0); }
#pragma unroll
        for (int n = 0; n < 8; ++n)
#pragma unroll
            for (int jj = 0; jj < 4; ++jj) { const int d = i + off - (16 * n + 4 * fq + jj); const float w = d == 0 ? 2.0f : __builtin_amdgcn_exp2f(d > 0 ? lgf * (float)d : lgb * (float)(-d)); sc[n][jj] *= w; }
#pragma unroll
        for (int ks = 0; ks < 4; ++ks) { u32x4 w; w.x = cvt_pk_bf16(sc[2 * ks][0], sc[2 * ks][1]); w.y = cvt_pk_bf16(sc[2 * ks][2], sc[2 * ks][3]);
            w.z = cvt_pk_bf16(sc[2 * ks + 1][0], sc[2 * ks + 1][1]); w.w = cvt_pk_bf16(sc[2 * ks + 1][2], sc[2 * ks + 1][3]);
            asm volatile("s_nop 1\n\tv_permlane16_swap_b32 %0, %1\n\tv_permlane16_swap_b32 %2, %3\n\ts_nop 1" : "+v"(w.x), "+v"(w.z), "+v"(w.y), "+v"(w.w));
            pf[kc][ks] = __builtin_bit_cast(bf16x8, w); }
    }
    LDS_WAIT(); __builtin_amdgcn_s_barrier(); asm volatile("" ::: "memory");
    dma_tile<256, true>(R0, (const char*)(a.ws + WS_VT) + ((size_t)(h * 256) * TG + tokx) * 2, (size_t)TG * 2, tid);
    f32x4 o[16];
#pragma unroll
    for (int n = 0; n < 16; ++n) o[n] = (f32x4){0.f, 0.f, 0.f, 0.f};
#pragma unroll
    for (int kc = 0; kc < 2; ++kc) {
        const LAS unsigned char* Vb = kc == 0 ? R1 : R0;
        if (kc == 1) { asm volatile("s_waitcnt vmcnt(0) lgkmcnt(0)" ::: "memory"); __builtin_amdgcn_s_barrier(); asm volatile("" ::: "memory"); }
#pragma unroll
        for (int ks = 0; ks < 4; ++ks) { bf16x8 vw[16];
#pragma unroll
            for (int n = 0; n < 16; ++n) vw[n] = lds_frag(Vb, 16 * n + fr, 4 * ks + (((fq & 1) << 1) | (fq >> 1)));
            LDS_WAIT(); __builtin_amdgcn_sched_barrier(0);
#pragma unroll
            for (int n = 0; n < 16; ++n) o[n] = __builtin_amdgcn_mfma_f32_16x16x32_bf16(vw[n], pf[kc][ks], o[n], 0, 0, 0); }
    }
    float s = 0.f;
#pragma unroll
    for (int n = 0; n < 16; ++n) s += (o[n][0] + o[n][1]) + (o[n][2] + o[n][3]);
    s = rows4_sum(s);
    const float mu = s * (1.0f / 256.0f); float q = 0.f;
#pragma unroll
    for (int n = 0; n < 16; ++n) { o[n] = o[n] - mu; q += (o[n][0] * o[n][0] + o[n][1] * o[n][1]) + (o[n][2] * o[n][2] + o[n][3] * o[n][3]); }
    q = rows4_sum(q);
    const float rstd = rsqrtf(q * (1.0f / 256.0f) + EPS);
    const size_t ro = (size_t)(tok0 + wid * 16 + fr) * 1024 + h * 256 + 8 * fq;
    const bf16_t* GS = (const bf16_t*)(a.ws + WS_GS) + ro; bf16_t* YR = (bf16_t*)(a.ws + WS_YRET) + ro;
#pragma unroll
    for (int p = 0; p < 8; ++p) { const u32x4 g = *(const u32x4*)(GS + 32 * p); f32x4 v0 = o[2 * p] * rstd, v1 = o[2 * p + 1] * rstd;
        v0[0] *= bf_lo(g.x); v0[1] *= bf_hi(g.x); v0[2] *= bf_lo(g.y); v0[3] *= bf_hi(g.y); v1[0] *= bf_lo(g.z); v1[1] *= bf_hi(g.z); v1[2] *= bf_lo(g.w); v1[3] *= bf_hi(g.w);
        *(u32x4*)(YR + 32 * p) = pack8(v0, v1); }
    LDS_WAIT(); __builtin_amdgcn_s_barrier(); asm volatile("" ::: "memory");
}

__global__ void __launch_bounds__(512, 2) fwd_kernel(Args kargs_unused) {
    DArgs a; a.out = KArgs().out(); a.ws = KArgs().wsp();
    extern __shared__ __attribute__((aligned(16))) unsigned char lds_raw[];
    LAS unsigned char* lds = (LAS unsigned char*)lds_raw;
    int tid = threadIdx.x, lane = tid & 63, wid = __builtin_amdgcn_readfirstlane(tid >> 6);
    int G = gridDim.x, bid = blockIdx.x;
#define PHASE_FENCE() do { asm volatile("" : "+v"(tid)); lane = tid & 63; wid = __builtin_amdgcn_readfirstlane(tid >> 6); \
        { unsigned _l = __builtin_amdgcn_readfirstlane((unsigned)(size_t)lds); asm volatile("" : "+s"(_l)); lds = (LAS unsigned char*)(size_t)_l; } \
        G = __builtin_amdgcn_readfirstlane(G); bid = __builtin_amdgcn_readfirstlane(bid); asm volatile("" : "+s"(G), "+s"(bid)); \
        a.out = KArgs().out(); a.ws = KArgs().wsp(); } while (0)
    for (int u = tid; u < (LDS_BYTES - LC_OFF) / 4; u += 512) ((LAS unsigned*)(lds + LC_OFF))[u] = 0u;
    __syncthreads();
    unsigned* ctl = (unsigned*)(a.ws + WS_CTL);
    const XcdBarrier bar = xcd_barrier_post(ctl + CW_BAR, (volatile LAS unsigned*)(lds + LC_BAR));
#define GRID_BAR() do { for (int _r = 0; _r < REP_BAR; ++_r) { XcdBarrier _b = bar; asm volatile("" : "+s"(_b.bar)); xcd_barrier(_b); } PHASE_FENCE(); } while (0)
#define TAB ((const float*)(a.ws + WS_TAB))

#ifndef DBG_POISON
#define DBG_POISON 0
#endif
    if (DBG_POISON) {
        u32x4* p4 = (u32x4*)(a.ws + 1 * MiB); const size_t n4 = (WS_END - 1 * MiB) / 16; const u32x4 pz = {0xffffffffu, 0xffffffffu, 0xffffffffu, 0xffffffffu};
        for (size_t i = (size_t)bid * 512 + tid; i < n4; i += (size_t)G * 512) p4[i] = pz;
        u32x4* o4 = (u32x4*)a.out; const size_t m4 = (size_t)NB * SEQ * D / 4;
        for (size_t i = (size_t)bid * 512 + tid; i < m4; i += (size_t)G * 512) o4[i] = pz;
        GRID_BAR();
    }
#ifndef X_NO_P0
    for (int rep = 0; rep < REP_P0; ++rep) { p0_mod(a, lds, tid, wid, lane); __syncthreads(); }
    for (int rep = 0; rep < REP_CVT; ++rep) { convert_weights(a, 0, lds, wid, lane); __syncthreads(); }
#endif
    GRID_BAR();

    for (int l = 0; l < DEPTH; ++l) {
#define lg2 (TAB + l * 8)
        const int skipctx = (l == DEPTH - 1) ? 1 : 0;
#ifndef X_NO_N1
        if (l > 0) for (int rep = 0; rep < REP_CVT; ++rep) { convert_weights(a, l, lds, wid, lane); __syncthreads(); }
        if (l == 0) { for (int rep = 0; rep < REP_N1; ++rep) phase_n1<0>(a, l, wid, lane); } else phase_n1<1>(a, l, wid, lane);
#endif
        GRID_BAR();
        for (int g = 0; g <= NG; ++g) {
#ifndef NO_OVERLAP
#define NO_OVERLAP 0
#endif
            const int nG4 = g == 0 ? 0 : (skipctx ? 128 : 144);
            if (bid < nG4) {
#ifndef X_NO_OUTPROJ
                for (int rep = 0; rep < REP_G4; ++rep) { PHASE_FENCE();
                    const int gp = g - 1;
                    const unsigned char* GATE = (const unsigned char*)(a.ws + ((gp & 1) ? WS_GATE1 : WS_GATE0)); bf16_t* MG = (bf16_t*)(a.ws + WS_MERGED) + (size_t)gp * TG * 1024;
                    SchedG4 S{(const char*)(a.ws + WS_YRET), (const char*)(a.ws + WS_YCONV), (const char*)(a.ws + WS_WRET), (const char*)(a.ws + WS_WCONV), skipctx ? TG / 256 / 9 * 8 : TG / 256, nG4, bid, skipctx};
                    EpiG4 E{GATE, MG};
                    pg8::gemm_phase<1024, 1024, 1024, EpiG4, SchedG4, true, true, true>(lds, tid, S, E);
                }
#endif
            }
            if (g == NG && bid >= nG4) {
                PHASE_FENCE();
                const int ntg = skipctx ? TG / 256 / 9 * 8 : TG / 256;
                SchedPlain S{(const char*)(a.ws + WS_MERGED), (const char*)(a.ws + WS_WO), (size_t)256 * 2048, (size_t)256 * 2048, (NG - 1) * ntg, 4, G - nG4, bid - nG4, skipctx};
                EpiPlainBf16 E{(bf16_t*)(a.ws + WS_YATT), 1024};
                pg8::gemm_phase<1024, 1024, 1024, EpiPlainBf16, SchedPlain, true, true>(lds, tid, S, E);
            }
            if (g < NG) {
#ifndef X_NO_INPROJ
                for (int rep = 0; rep < REP_G1; ++rep) { PHASE_FENCE();
                    SchedInproj S{(const char*)(a.ws + WS_H) + (size_t)g * TG * 2048, (const char*)(a.ws + WS_WIN), G, bid, nG4, skipctx};
                    EpiInproj E{a.ws, lg2, TAB + 32, TAB + 32 + 2048, (bf16_t*)(a.ws + ((g & 1) ? WS_GATE1 : WS_GATE0))};
                    pg8::gemm_phase<1024, 1024, 1024, EpiInproj, SchedInproj, true, true>(lds, tid, S, E);
                }
#endif
            }
            GRID_BAR();
            if (g == NG) break;
#ifndef X_NO_CHAIN
            for (int rep = 0; rep < REP_G2; ++rep) {
            if (bid < NCHAIN) {
                const int cu = (((bid & 7) + 8 * (bid >> 5)) << 2) | ((bid >> 3) & 3);
                for (int r2 = 0; r2 < REP_CH; ++r2) chain_unit(a, cu, lg2, lds, tid, wid, lane); }
            else if (skipctx) { for (int r2 = 0; r2 < REP_CP; ++r2) conv_pool(a, l, bid - NCHAIN, G - NCHAIN, tid, skipctx, 0, CP_TOTAL - CP_DEFER); }
            else {
                const int w = bid - NCHAIN, nv = 2 * (G - NCHAIN) - 32;
                if (w < 32) { finalize_ctx_unit(a, w, lg2, lds, tid, wid, lane); conv_pool(a, l, w, nv, tid, skipctx, 0, CP_TOTAL - CP_DEFER); }
                else { conv_pool(a, l, 32 + 2 * (w - 32), nv, tid, skipctx, 0, CP_TOTAL - CP_DEFER); conv_pool(a, l, 33 + 2 * (w - 32), nv, tid, skipctx, 0, CP_TOTAL - CP_DEFER); }
            }
            }
#endif
            GRID_BAR();
#ifndef X_NO_FIN
            for (int rep = 0; rep < REP_G3; ++rep)
            for (int u = bid; u < BG * 4 * 16; u += G) finalize_unit(a, (u >> 4) * NCH + 2 + (u & 15), lg2, lds, tid, wid, lane);
            conv_pool(a, l, bid, G, tid, skipctx, CP_TOTAL - CP_DEFER, CP_TOTAL);
#endif
            GRID_BAR();
        }
#ifndef X_NO_WO
        for (int rep = 0; rep < REP_WO; ++rep) { PHASE_FENCE();
            SchedPlain S{(const char*)(a.ws + WS_MERGED) + (size_t)(NG - 1) * TG * 2048, (const char*)(a.ws + WS_WO), (size_t)256 * 2048, (size_t)256 * 2048, skipctx ? TG / 256 / 9 * 8 : TG / 256, 4, G, bid, skipctx};
            EpiPlainBf16 E{(bf16_t*)(a.ws + WS_YATT) + (size_t)(NG - 1) * TG * 1024, 1024};
            pg8::gemm_phase<1024, 1024, 1024, EpiPlainBf16, SchedPlain, true, true>(lds, tid, S, E);
        }
#endif
        GRID_BAR();
#ifndef X_NO_N2
        for (int rep = 1; rep < REP_N2; ++rep) { phase_n2(a, l, lds, tid, wid, lane, skipctx, true); __syncthreads(); }
        phase_n2(a, l, lds, tid, wid, lane, skipctx);
#endif
        GRID_BAR();
        {
            LAS int* cnt = (LAS int*)(lds + LC_CNT); LAS int* poff = (LAS int*)(lds + LC_POFF); LAS int* tile_e = (LAS int*)(lds + LC_TILEE); LAS int* ntl = (LAS int*)(lds + LC_NT);
            if (tid == 0) { int off = 0;
_Pragma("unroll 1")
                for (int e = 0; e < 16; ++e) { const int n = (int)xb_ld(ctl + CW_CNT + 64 * l + e); cnt[e] = n; poff[e] = off; const int nt = (n + 255) >> 8;
                    for (int t = 0; t < nt; ++t) tile_e[(off >> 8) + t] = e; off += nt << 8; } poff[16] = off; ntl[0] = off >> 8; }
            __syncthreads();
            const int ntiles = ntl[0];
            {
                int* SLOTOF = (int*)(a.ws + WS_SLOTOF); const int* LISTp = (const int*)(a.ws + WS_LIST);
                for (int idx = bid * 512 + tid; idx < ntiles * 256; idx += G * 512) { const int e = tile_e[idx >> 8], p = idx - poff[e]; if (p < cnt[e]) SLOTOF[LISTp[(size_t)e * T + p]] = idx; }
            }
#ifndef X_NO_M1
            for (int rep = 0; rep < REP_M1; ++rep) { PHASE_FENCE(); SchedMoeG S{(const char*)(a.ws + WS_H), (const char*)(a.ws + WS_W13), tile_e, cnt, poff, (const int*)(a.ws + WS_LIST), (LAS int*)(lds + LC_GTBL), ntiles, G, bid};
              EpiMoeUp E{(bf16_t*)(a.ws + WS_ACT)};
              pg8::gemm_phase<1024, 1024, 1024, EpiMoeUp, SchedMoeG, true, true>(lds, tid, S, E); }
#endif
            GRID_BAR();
#ifndef X_NO_M2
            for (int rep = 0; rep < REP_M2; ++rep) { PHASE_FENCE(); SchedMoe S{(const char*)(a.ws + WS_ACT), (const char*)(a.ws + WS_W2), (size_t)256 * 1024, (size_t)1024, tile_e, ntiles, G, bid};
              EpiPlainBf16 E{(bf16_t*)(a.ws + WS_YS), 1024};
              pg8::gemm_phase<512, 512, 512, EpiPlainBf16, SchedMoe, true, true>(lds, tid, S, E); }
#endif
            GRID_BAR();
        }
    }
    {
        float poison = 0.f;
        const unsigned err = xb_ld(ctl + CW_ERR), tmo = xb_ld(ctl + CW_BAR + XB_TMO);
        if (err) poison = sqrtf((float)err); else if (tmo) poison = sqrtf(90.f);
        phase_final(a, wid, lane, poison);
    }
}

extern "C" void kernel_launch(void* const* d_in, const int* in_sizes, int n_in, void* d_out, int out_size, void* d_ws, size_t ws_size, hipStream_t stream) {
    static int grid = 0;
    if (grid == 0) {
        if (n_in != 25 || ws_size < WS_END) { fprintf(stderr, "kernel_launch: unexpected n_in %d / ws_size %zu\n", n_in, ws_size); grid = -1; return; }
        int dev = 0, cus = 0, per_cu = 0;
        if (hipGetDevice(&dev) != hipSuccess || hipDeviceGetAttribute(&cus, hipDeviceAttributeMultiprocessorCount, dev) != hipSuccess) { grid = -1; return; }
        if (hipFuncSetAttribute((const void*)fwd_kernel, hipFuncAttributeMaxDynamicSharedMemorySize, LDS_BYTES) != hipSuccess) { grid = -1; return; }
        if (hipOccupancyMaxActiveBlocksPerMultiprocessor(&per_cu, (const void*)fwd_kernel, 512, LDS_BYTES) != hipSuccess || per_cu < 1) fprintf(stderr, "kernel_launch: occupancy query says %d\n", per_cu);
        (void)hipGetLastError();
        grid = cus;
    }
    if (grid < 0) return;
    if (hipMemsetAsync((char*)d_ws + WS_CTL, 0, 1 * MiB, stream) != hipSuccess) return;
    Args a{};
    for (int i = 0; i < 25; ++i) a.in[i] = (const float*)d_in[i];
    a.out = (float*)d_out; a.ws = (unsigned char*)d_ws;
    hipLaunchKernelGGL(fwd_kernel, dim3(grid), dim3(512), LDS_BYTES, stream, a);
}
```

```cpp
#include <hip/hip_runtime.h>
#include <cstdio>
#include <cstdint>

#ifndef REP_G1
#define REP_G1 1
#endif
#ifndef REP_G2
#define REP_G2 1
#endif
#ifndef REP_G3
#define REP_G3 1
#endif
#ifndef REP_G4
#define REP_G4 1
#endif
#ifndef REP_WO
#define REP_WO 1
#endif
#ifndef REP_M0
#define REP_M0 1
#endif
#ifndef REP_M1
#define REP_M1 1
#endif
#ifndef REP_M2
#define REP_M2 1
#endif
#ifndef REP_CVT
#define REP_CVT 1
#endif
#ifndef REP_P0
#define REP_P0 1
#endif
#ifndef REP_N1
#define REP_N1 1
#endif
#ifndef REP_BAR
#define REP_BAR 1
#endif
#ifndef REP_N2
#define REP_N2 1
#endif
#ifndef REP_CH
#define REP_CH 1
#endif
#ifndef REP_EPI
#define REP_EPI 1
#endif
#ifndef REP_CP
#define REP_CP 1
#endif
#define LAS __attribute__((address_space(3)))
typedef unsigned short bf16_t;
typedef short bf16x8 __attribute__((ext_vector_type(8)));
typedef short bf16x4 __attribute__((ext_vector_type(4)));
typedef float f32x4 __attribute__((ext_vector_type(4)));
typedef float f32x2 __attribute__((ext_vector_type(2)));
typedef unsigned u32x4 __attribute__((ext_vector_type(4)));
typedef unsigned u32x2 __attribute__((ext_vector_type(2)));

constexpr int D = 1024, NB = 16, SEQ = 2048, CL = 256, TPB = SEQ + CL  , T = NB * TPB  , DEPTH = 4;
constexpr int NG = 4, BG = NB / NG, TG = BG * TPB;
constexpr int NCH = TPB / 128;
constexpr float EPS = 1e-6f;
constexpr int NMOD = 6 * D;

constexpr size_t MiB = 1u << 20;
constexpr size_t WS_CTL = 0;
constexpr size_t WS_MOD = 1 * MiB;
constexpr size_t WS_TAB = WS_MOD + (size_t)DEPTH * 17 * NMOD * 4;
constexpr size_t WS_WIN = 3 * MiB;
constexpr size_t WS_WRET = WS_WIN + 16 * MiB;
constexpr size_t WS_WCONV = WS_WRET + 2 * MiB;
constexpr size_t WS_WPOOL = WS_WCONV + 1 * MiB;
constexpr size_t WS_WO = WS_WPOOL + 1 * MiB;
constexpr size_t WS_W13 = WS_WO + 2 * MiB;
constexpr size_t WS_W2 = WS_W13 + 32 * MiB;
constexpr size_t WS_XC = WS_W2 + 16 * MiB;
constexpr size_t WS_H = WS_XC + 16 * MiB;
constexpr size_t WS_PROJ = WS_H + 72 * MiB;
constexpr size_t SEC = (size_t)TG * 512 * 2;
constexpr size_t WS_QF = WS_PROJ, WS_QB = WS_QF + SEC, WS_KF = WS_QB + SEC, WS_KB = WS_KF + SEC, WS_KTF = WS_KB + SEC, WS_KTB = WS_KTF + SEC;
constexpr size_t WS_VT = WS_KTB + SEC, WS_GS = WS_VT + 2 * SEC, WS_CB = WS_GS + 2 * SEC, WS_CU = WS_CB + SEC, WS_PI = WS_CU + SEC;
constexpr size_t WS_GATE0 = WS_PI + SEC, WS_GATE1 = WS_GATE0 + 6 * SEC;
constexpr size_t WS_PROJ_END = WS_GATE1 + 6 * SEC;
constexpr size_t WS_H2S = WS_PROJ;
constexpr size_t WS_ACT = WS_PROJ + 152 * MiB;
constexpr size_t WS_STATES = WS_PROJ_END;
constexpr size_t WS_YRET = WS_STATES + 36 * MiB;
constexpr size_t WS_YCONV = WS_YRET + 18 * MiB;
constexpr size_t WS_POOLED = WS_YCONV + 9 * MiB;
constexpr size_t WS_MERGEDF = WS_POOLED + 9 * MiB;
constexpr size_t WS_X = WS_MERGEDF + 36 * MiB;
constexpr size_t WS_YATT = WS_X + 72 * MiB;
constexpr size_t WS_YS = WS_YATT + 72 * MiB;
constexpr size_t WS_MERGED = WS_YS;
constexpr size_t WS_ROUTEC = WS_YS + 152 * MiB;
constexpr size_t WS_SLOTOF = WS_ROUTEC + 512 * 1024;
constexpr size_t WS_LIST = WS_ROUTEC + 1 * MiB;
constexpr size_t WS_END = WS_LIST + 3 * MiB;
static_assert(WS_PROJ_END - WS_PROJ == 25 * SEC, "proj");
static_assert(WS_ACT + (size_t)(2 * T + 4096) * 512 * 2 <= WS_X && WS_H2S + (size_t)(2 * T + 4096) * 1024 * 2 <= WS_ACT, "moe alias");
static_assert(WS_END <= 798 * MiB, "workspace");
constexpr int CW_ERR = 16;
constexpr int CW_BAR = 4096;
constexpr int CW_CNT = 16384;

constexpr int LDS_BYTES = 147456;
constexpr int LC_OFF = 131072;
constexpr int LC_BAR = LC_OFF + 32;
constexpr int LC_CNT = LC_OFF + 256;
constexpr int LC_POFF = LC_OFF + 384;
constexpr int LC_NT = LC_OFF + 480;
constexpr int LC_TILEE = LC_OFF + 512;
constexpr int LC_RE = LC_OFF + 2048;
constexpr int LC_LCNT = LC_OFF + 3584;
constexpr int LC_GTBL = LC_OFF + 4096;

__device__ __forceinline__ unsigned cvt_pk_bf16(float lo, float hi) { unsigned r; asm volatile("s_nop 0\n\tv_cvt_pk_bf16_f32 %0, %1, %2" : "=v"(r) : "v"(lo), "v"(hi)); return r; }
__device__ __forceinline__ float bf_lo(unsigned w) { return __uint_as_float(w << 16); }
__device__ __forceinline__ float bf_hi(unsigned w) { return __uint_as_float(w & 0xffff0000u); }
template <int CTRL> __device__ __forceinline__ float dpp_add(float v) { return v + __builtin_bit_cast(float, __builtin_amdgcn_update_dpp(0, __builtin_bit_cast(int, v), CTRL, 0xF, 0xF, true)); }
__device__ __forceinline__ float row16_sum(float v) { v = dpp_add<0xB1>(v); v = dpp_add<0x4E>(v); v = dpp_add<0x141>(v); v = dpp_add<0x140>(v); return v; }
__device__ __forceinline__ float swap32_sum(float a, float b) { const auto r = __builtin_amdgcn_permlane32_swap(__builtin_bit_cast(unsigned, a), __builtin_bit_cast(unsigned, b), false, false);
    return __builtin_bit_cast(float, (unsigned)r[0]) + __builtin_bit_cast(float, (unsigned)r[1]); }
__device__ __forceinline__ float swap16_sum(float a, float b) { const auto r = __builtin_amdgcn_permlane16_swap(__builtin_bit_cast(unsigned, a), __builtin_bit_cast(unsigned, b), false, false);
    return __builtin_bit_cast(float, (unsigned)r[0]) + __builtin_bit_cast(float, (unsigned)r[1]); }
__device__ __forceinline__ float wave_sum4(float v0, float v1, float v2, float v3) { return row16_sum(swap16_sum(swap32_sum(v0, v1), swap32_sum(v2, v3))); }
__device__ __forceinline__ float wave_sum(float v) { const float r = row16_sum(v); const float t = swap16_sum(r, r); return swap32_sum(t, t); }
__device__ __forceinline__ float rows4_sum(float v) { const float t = swap16_sum(v, v); return swap32_sum(t, t); }
__device__ __forceinline__ float lane_val(float v, int l) { return __builtin_bit_cast(float, __builtin_amdgcn_readlane(__builtin_bit_cast(int, v), l)); }
__device__ __forceinline__ float fast_exp(float x) { return __builtin_amdgcn_exp2f(x * 1.4426950408889634f); }
__device__ __forceinline__ float silu_f(float x) { return x * __builtin_amdgcn_rcpf(1.0f + fast_exp(-x)); }
__device__ __forceinline__ float sigmoid_f(float x) { return __builtin_amdgcn_rcpf(1.0f + fast_exp(-x)); }
__device__ __forceinline__ float silu_fast(float x) { return x * __builtin_amdgcn_rcpf(1.0f + fast_exp(-x)); }
__device__ __forceinline__ float sigmoid_fast(float x) { return __builtin_amdgcn_rcpf(1.0f + fast_exp(-x)); }
__device__ __forceinline__ u32x4 pack8(const f32x4 a, const f32x4 b) { u32x4 w; w.x = cvt_pk_bf16(a[0], a[1]); w.y = cvt_pk_bf16(a[2], a[3]); w.z = cvt_pk_bf16(b[0], b[1]); w.w = cvt_pk_bf16(b[2], b[3]); return w; }
#define LDS_WAIT() asm volatile("s_waitcnt lgkmcnt(0)" ::: "memory")
#define VM_WAIT() asm volatile("s_waitcnt vmcnt(0)" ::: "memory")

#define XB_TMO      128
#define XB_XCNT(j)  (256  + 64 * (j))
#define XB_XSUB(j)  (1280 + 64 * (j))
#define XB_XGEN(j)  (2304 + 64 * (j))
#define XB_TOP      3328
#define XB_TOPGEN   3392
#define XCD_BAR_WORDS 3456
#define XB_SPIN_CAP (1u << 18)
__device__ __forceinline__ unsigned xb_ld(unsigned* p)              { return __hip_atomic_load(p, __ATOMIC_RELAXED, __HIP_MEMORY_SCOPE_AGENT); }
__device__ __forceinline__ unsigned xb_add(unsigned* p, unsigned v) { return __hip_atomic_fetch_add(p, v, __ATOMIC_RELAXED, __HIP_MEMORY_SCOPE_AGENT); }
__device__ __forceinline__ unsigned xb_xcc_id() { return (unsigned)__builtin_amdgcn_s_getreg((3 << 11) | 20) & 0xFu; }
#define XB_SPIN(cond, bar) do { unsigned _sp = 0; while (cond) { __builtin_amdgcn_s_sleep(1); \
    if ((++_sp & 255u) == 0u) { if (xb_ld(&(bar)[XB_TMO])) break; if (_sp > XB_SPIN_CAP) { atomicAdd(&(bar)[XB_TMO], 1u); break; } } } } while (0)
struct XcdBarrier { unsigned* bar; unsigned x; volatile LAS unsigned* st; };
__device__ __forceinline__ XcdBarrier xcd_barrier_post(unsigned* bar, volatile LAS unsigned* st) {
    XcdBarrier b; b.bar = bar; b.x = xb_xcc_id(); b.st = st;
    if (threadIdx.x == 0) (void)xb_add(&bar[XB_XCNT(b.x)], 1u);
    return b;
}
__device__ __forceinline__ void xcd_barrier_complete(unsigned* bar, unsigned x, unsigned& nloc, unsigned& nx) {
    const unsigned G = gridDim.x * gridDim.y * gridDim.z;
    unsigned sum, cnt, mine, sp = 0u;
    for (;;) {
        sum = 0u; cnt = 0u; mine = 0u;
#pragma unroll 1
        for (unsigned j = 0; j < 16; ++j) { const unsigned c = xb_ld(&bar[XB_XCNT(j)]); sum += c; cnt += (c > 0u) ? 1u : 0u; mine = (j == x) ? c : mine; }
        if (sum == G) break;
        __builtin_amdgcn_s_sleep(1);
        if ((++sp & 255u) == 0u) { if (xb_ld(&bar[XB_TMO])) break; if (sp > XB_SPIN_CAP) { atomicAdd(&bar[XB_TMO], 1u); break; } }
    }
    nloc = mine > 0u ? mine : 1u; nx = cnt > 0u ? cnt : 1u;
}
__device__ __forceinline__ void xcd_barrier(const XcdBarrier& b) {
    asm volatile("s_waitcnt vmcnt(0)" ::: "memory");
    __syncthreads();
    if (threadIdx.x == 0) {
        unsigned* bar = b.bar;
        __builtin_amdgcn_s_waitcnt(0);
        unsigned nloc = b.st[0], nx = b.st[1];
        if (nloc == 0u) { xcd_barrier_complete(bar, b.x, nloc, nx); b.st[0] = nloc; b.st[1] = nx; }
        const unsigned old = xb_add(&bar[XB_XSUB(b.x)], 1u);
        const unsigned gen = old / nloc;
        if (old + 1u == (gen + 1u) * nloc) {
            __builtin_amdgcn_fence(__ATOMIC_RELEASE, "agent");
            asm volatile("s_waitcnt vmcnt(0)" ::: "memory");
            const unsigned og = xb_add(&bar[XB_TOP], 1u);
            const unsigned tg = og / nx;
            if (og + 1u == (tg + 1u) * nx) xb_add(&bar[XB_TOPGEN], 1u);
            else XB_SPIN(xb_ld(&bar[XB_TOPGEN]) == tg, bar);
            __builtin_amdgcn_fence(__ATOMIC_ACQUIRE, "agent");
            xb_add(&bar[XB_XGEN(b.x)], 1u);
            asm volatile("s_waitcnt vmcnt(0)" ::: "memory");
        } else {
            XB_SPIN(xb_ld(&bar[XB_XGEN(b.x)]) == gen, bar);
            __builtin_amdgcn_fence(__ATOMIC_ACQUIRE, "agent");
            asm volatile("s_waitcnt vmcnt(0)" ::: "memory");
        }
    }
    __syncthreads();
}

namespace pg8 {
constexpr int BM = 256, BK = 64, HALF = 128, HTB = HALF * BK * 2, STAGE_BYTES = 8 * HTB, NXCD = 8, WGM = 8;
__host__ __device__ __forceinline__ int lds_byte(int r, int c) { const int st = (r >> 4) * 2 + (c >> 5), rr = r & 15, cc = c & 31, ob = rr * 64 + cc * 2; return st * 1024 + (ob ^ (((ob >> 9) & 1) << 5)); }
__host__ __device__ __forceinline__ void stage_rc(int b, int& R, int& C) { const int st = b / 1024, sb = b % 1024, swz = sb ^ (((sb >> 9) & 1) << 5); R = (st >> 1) * 16 + swz / 64; C = (st & 1) * 32 + (swz % 64) / 2; }
__host__ __device__ __forceinline__ int perm32(int rho) { const int n = rho >> 4, i = rho & 15; return 8 * (i >> 2) + 4 * n + (i & 3); }

struct Unit { const char* a; const char* b; int pm, pn, kind, nt, cont; };

__device__ __forceinline__ void tile_map(int L, int nM, int nN, int& pm, int& pn) {
    const int nwg = nM * nN; int wgid = L;
    { const int q = nwg / NXCD, r = nwg % NXCD, xcd = wgid % NXCD, off = wgid / NXCD; wgid = (xcd < r ? xcd * (q + 1) : r * (q + 1) + (xcd - r) * q) + off; }
    const int nig = WGM * nN, gid = wgid / nig, fm = gid * WGM, gsz = (nM - fm) < WGM ? (nM - fm) : WGM;
    pm = fm + ((wgid % nig) % gsz); pn = (wgid % nig) / gsz;
}

template <class S_> struct sched_gather { static constexpr bool value = false; };
template <int K, int lda, int ldb, class Epi, class Sched, bool ALIGN_EPI, bool SP2, bool VARNT = false>
__device__ __forceinline__ void gemm_phase(LAS unsigned char* lds, const int tid, const Sched& S, const Epi& E) {
    const int wid = __builtin_amdgcn_readfirstlane(tid >> 6), lane = tid & 63, wr = wid >> 2, wc = wid & 3, fr = lane & 15, fq = lane >> 4;
    constexpr int nt_c = K / BK;
    unsigned voffA[2], voffB[2];
#pragma unroll
    for (int i = 0; i < 2; ++i) { int R, C; stage_rc(tid * 16 + i * 8192, R, C); const int Rb = Epi::PERM ? ((R & ~31) + perm32(R & 31)) : R;
        voffA[i] = (unsigned)(R * lda + C) * 2u; voffB[i] = (unsigned)(Rb * ldb + C) * 2u; }
    constexpr bool GATHER = sched_gather<Sched>::value;
    int gR[2], gC2[2];
#pragma unroll
    for (int i = 0; i < 2; ++i) { int R, C; stage_rc(tid * 16 + i * 8192, R, C); gR[i] = R; gC2[i] = C * 2; }
    unsigned voA0[2] = {voffA[0], voffA[1]}, voA1[2] = {voffA[0], voffA[1]};
    constexpr size_t kstep = (size_t)(BK * 2);
    constexpr size_t hstepA = (size_t)HALF * lda * 2, hstepB = (size_t)HALF * ldb * 2;
    const unsigned ldsw = (unsigned)wid * 1024u;
    const int aoff = lds_byte(wr * 64 + fr, fq * 8), boff = lds_byte(wc * 32 + fr, fq * 8);
#define PG8_SA(b, h) (((b) * 2 + (h)) * HTB)
#define PG8_SB(b, h) ((4 + (b) * 2 + (h)) * HTB)
#define PG8_STAGE(bufoff, gbase, voff) do { _Pragma("unroll") for (int _i = 0; _i < 2; ++_i) \
        __builtin_amdgcn_global_load_lds((const unsigned*)((const char*)(gbase) + (voff)[_i]), (LAS unsigned*)(lds + (bufoff) + ldsw + _i * 8192), 16, 0, 0); } while (0)
#define PG8_STAGE_A(bufoff, gbase, h) do { if constexpr (GATHER) { if ((h) == 0) PG8_STAGE(bufoff, gbase, voA0); else PG8_STAGE(bufoff, gbase, voA1); } \
        else { PG8_STAGE(bufoff, (gbase) + ((h) ? hstepA : 0), voffA); } } while (0)
#define PG8_LDA(dst, b, h) do { _Pragma("unroll") for (int m = 0; m < 4; ++m) _Pragma("unroll") for (int k = 0; k < 2; ++k) dst[m][k] = *(const LAS bf16x8*)(lds + PG8_SA(b, h) + aoff + m * 2048 + k * 1024); } while (0)
#define PG8_LDB(dst, b, h) do { _Pragma("unroll") for (int n = 0; n < 2; ++n) _Pragma("unroll") for (int k = 0; k < 2; ++k) dst[n][k] = *(const LAS bf16x8*)(lds + PG8_SB(b, h) + boff + n * 2048 + k * 1024); } while (0)
#define PG8_MMA(ai, bj, At, Bt) do { __builtin_amdgcn_s_setprio(1); _Pragma("unroll") for (int m = 0; m < 4; ++m) _Pragma("unroll") for (int n = 0; n < 2; ++n) _Pragma("unroll") for (int k = 0; k < 2; ++k) \
        acc[ai][bj][m][n] = __builtin_amdgcn_mfma_f32_16x16x32_bf16(Bt[n][k], At[m][k], acc[ai][bj][m][n], 0, 0, 0); __builtin_amdgcn_s_setprio(0); } while (0)
#define PG8_WAIT_V(n) asm volatile("s_waitcnt vmcnt(" #n ")" ::: "memory")
#define PG8_WAIT_L(n) asm volatile("s_waitcnt lgkmcnt(" #n ")" ::: "memory")
#define PG8_BAR __builtin_amdgcn_s_barrier()
#define PG8_SCHED __builtin_amdgcn_sched_barrier(0)
    Unit cur, nxt; int ui = 0;
    if (!S.next(0, cur)) return;
    f32x4 acc[2][2][4][2];
#pragma unroll
    for (int a = 0; a < 2; ++a)
#pragma unroll
        for (int b = 0; b < 2; ++b)
#pragma unroll
            for (int m = 0; m < 4; ++m)
#pragma unroll
                for (int n = 0; n < 2; ++n) acc[a][b][m][n] = (f32x4){0.f, 0.f, 0.f, 0.f};
    bf16x8 At[4][2], B0[2][2], B1[2][2];
    const char* cA = cur.a; const char* cB = cur.b;
    if constexpr (GATHER) {
        S.fill_table(cur, 0, tid); asm volatile("s_waitcnt vmcnt(0)" ::: "memory"); __builtin_amdgcn_s_barrier(); asm volatile("" ::: "memory");
        S.load_offsets(cur, 0, gR, gC2, voA0, voA1);
    }
    if constexpr (SP2) {
        PG8_STAGE(PG8_SB(0, 0), cB, voffB); PG8_STAGE(PG8_SB(0, 1), cB + hstepB, voffB); PG8_STAGE_A(PG8_SA(0, 0), cA, 0); PG8_STAGE_A(PG8_SA(0, 1), cA, 1);
        if (wr == 1) PG8_BAR;
        PG8_WAIT_V(2); PG8_BAR;
        PG8_STAGE(PG8_SB(1, 0), cB + kstep, voffB); PG8_STAGE_A(PG8_SA(1, 0), cA + kstep, 0); PG8_STAGE(PG8_SB(1, 1), cB + hstepB + kstep, voffB);
        PG8_WAIT_V(6); PG8_BAR;
    } else {
        PG8_STAGE(PG8_SB(0, 0), cB, voffB); PG8_STAGE_A(PG8_SA(0, 0), cA, 0); PG8_STAGE(PG8_SB(0, 1), cB + hstepB, voffB); PG8_STAGE_A(PG8_SA(0, 1), cA, 1);
        if (wr == 1) PG8_BAR;
        PG8_WAIT_V(4); PG8_BAR;
        PG8_STAGE(PG8_SB(1, 0), cB + kstep, voffB); PG8_STAGE_A(PG8_SA(1, 0), cA + kstep, 0); PG8_STAGE(PG8_SB(1, 1), cB + hstepB + kstep, voffB);
        PG8_WAIT_V(6); PG8_BAR;
    }
    for (;;) {
        const bool has_next = S.next(ui + 1, nxt);
        const char* nA = has_next ? nxt.a : cA; const char* nB = has_next ? nxt.b : cB;
        if constexpr (GATHER) { if (has_next) S.fill_table(nxt, (ui + 1) & 1, tid); }
        const int nt = VARNT ? cur.nt : nt_c;
        for (int t = 0; t < nt; t += 2) {
            const bool last = (t == nt - 2);
            const char* a1 = cA + (size_t)(t + 1) * kstep;
            const char* a2 = last ? nA : cA + (size_t)(t + 2) * kstep; const char* b2 = last ? nB : cB + (size_t)(t + 2) * kstep;
            const char* a3 = a2 + kstep; const char* b3 = b2 + kstep;
            if constexpr (SP2) {
            PG8_LDB(B0, 0, 0); PG8_LDB(B1, 0, 1); PG8_SCHED; PG8_LDA(At, 0, 0); PG8_STAGE_A(PG8_SA(1, 1), a1, 1);
            PG8_WAIT_V(8); PG8_WAIT_L(0); PG8_BAR; PG8_MMA(0, 0, At, B0); PG8_MMA(0, 1, At, B1); PG8_BAR; PG8_SCHED;
            PG8_LDA(At, 0, 1);
            if constexpr (GATHER) { if (last && has_next) S.load_offsets(nxt, (ui + 1) & 1, gR, gC2, voA0, voA1); }
            PG8_STAGE(PG8_SB(0, 0), b2, voffB); PG8_STAGE(PG8_SB(0, 1), b2 + hstepB, voffB); PG8_STAGE_A(PG8_SA(0, 0), a2, 0);
            PG8_WAIT_V(8); PG8_WAIT_L(0); PG8_BAR; PG8_MMA(1, 0, At, B0); PG8_MMA(1, 1, At, B1); PG8_BAR; PG8_SCHED;
            PG8_LDB(B0, 1, 0); PG8_LDB(B1, 1, 1); PG8_SCHED; PG8_LDA(At, 1, 0); PG8_STAGE_A(PG8_SA(0, 1), a2, 1);
            PG8_WAIT_V(8); PG8_WAIT_L(0); PG8_BAR; PG8_MMA(0, 0, At, B0); PG8_MMA(0, 1, At, B1); PG8_BAR; PG8_SCHED;
            PG8_LDA(At, 1, 1); PG8_STAGE(PG8_SB(1, 0), b3, voffB); PG8_STAGE(PG8_SB(1, 1), b3 + hstepB, voffB); PG8_STAGE_A(PG8_SA(1, 0), a3, 0);
            PG8_WAIT_V(8); PG8_WAIT_L(0); PG8_BAR; PG8_MMA(1, 0, At, B0); PG8_MMA(1, 1, At, B1); PG8_BAR; PG8_SCHED;
            } else {
            PG8_LDB(B0, 0, 0); PG8_SCHED; PG8_LDA(At, 0, 0); PG8_STAGE_A(PG8_SA(1, 1), a1, 1);
            PG8_WAIT_L(8); PG8_BAR; PG8_WAIT_L(0); PG8_MMA(0, 0, At, B0); PG8_BAR; PG8_SCHED;
            PG8_LDB(B1, 0, 1); PG8_STAGE(PG8_SB(0, 0), b2, voffB);
            PG8_BAR; PG8_WAIT_L(0); PG8_MMA(0, 1, At, B1); PG8_BAR;
            PG8_LDA(At, 0, 1); PG8_STAGE_A(PG8_SA(0, 0), a2, 0);
            PG8_BAR; PG8_WAIT_L(0); PG8_MMA(1, 0, At, B0); PG8_BAR; PG8_SCHED;
            PG8_STAGE(PG8_SB(0, 1), b2 + hstepB, voffB);
            PG8_WAIT_V(6); PG8_BAR; PG8_MMA(1, 1, At, B1); PG8_BAR;
            PG8_LDB(B0, 1, 0); PG8_SCHED; PG8_LDA(At, 1, 0); PG8_STAGE_A(PG8_SA(0, 1), a2, 1);
            PG8_WAIT_L(8); PG8_BAR; PG8_WAIT_L(0); PG8_MMA(0, 0, At, B0); PG8_BAR; PG8_SCHED;
            PG8_LDB(B1, 1, 1); PG8_STAGE(PG8_SB(1, 0), b3, voffB);
            PG8_BAR; PG8_WAIT_L(0); PG8_MMA(0, 1, At, B1); PG8_BAR;
            PG8_LDA(At, 1, 1); PG8_STAGE_A(PG8_SA(1, 0), a3, 0);
            PG8_BAR; PG8_WAIT_L(0); PG8_MMA(1, 0, At, B0); PG8_BAR; PG8_SCHED;
            PG8_STAGE(PG8_SB(1, 1), b3 + hstepB, voffB);
            PG8_WAIT_V(6); PG8_BAR; PG8_MMA(1, 1, At, B1); PG8_BAR;
            }
        }
        if constexpr (ALIGN_EPI) { if (wr == 0) PG8_BAR; }
        E(acc, cur, wr, wc, fr, fq);
        if (REP_EPI > 1 && !VARNT) { for (int _r = 1; _r < REP_EPI; ++_r) E(acc, cur, wr, wc, fr, fq); }
        if (!has_next) break;
        if (!(VARNT && cur.cont))
#pragma unroll
        for (int a = 0; a < 2; ++a)
#pragma unroll
            for (int b = 0; b < 2; ++b)
#pragma unroll
                for (int m = 0; m < 4; ++m)
#pragma unroll
                    for (int n = 0; n < 2; ++n) acc[a][b][m][n] = (f32x4){0.f, 0.f, 0.f, 0.f};
        cur = nxt; cA = nA; cB = nB; ++ui;
        if constexpr (ALIGN_EPI) { if (wr == 1) PG8_BAR; }
    }
    PG8_WAIT_V(0);
    if constexpr (!ALIGN_EPI) { if (wr == 0) PG8_BAR; }
    PG8_BAR;
#undef PG8_SA
#undef PG8_SB
#undef PG8_STAGE
#undef PG8_LDA
#undef PG8_LDB
#undef PG8_MMA
#undef PG8_WAIT_V
#undef PG8_WAIT_L
#undef PG8_BAR
#undef PG8_SCHED
}
}
using pg8::Unit;

struct Args { const float* in[25]; float* out; unsigned char* ws; };
enum { I_X = 0, I_C, I_CTX, I_CCTX, I_WADA, I_BADA, I_NORM1, I_NORM2, I_WIN, I_RETDECAY, I_CONVW, I_POOLW, I_POOLSCALE, I_WRETOUT, I_WCONVOUT, I_WPOOLOUT, I_WO,
       I_WRG, I_BRG, I_WRE, I_BRE, I_W1, I_W3, I_W2, I_FINALNORM };

struct KArgs {
    __device__ __forceinline__ const char __attribute__((address_space(4)))* base() const { const char __attribute__((address_space(4)))* kp = (const char __attribute__((address_space(4)))*)__builtin_amdgcn_kernarg_segment_ptr(); asm volatile("" : "+s"(kp)); return kp; }
    __device__ __forceinline__ const float* in(int i) const { return *(const float* const __attribute__((address_space(4)))*)(base() + 8 * i); }
    __device__ __forceinline__ float* out() const { return *(float* const __attribute__((address_space(4)))*)(base() + 200); }
    __device__ __forceinline__ unsigned char* wsp() const { return *(unsigned char* const __attribute__((address_space(4)))*)(base() + 208); }
};
struct InProxy { __device__ __forceinline__ const float* operator[](int i) const { return KArgs().in(i); } };
struct DArgs { InProxy in; float* out; unsigned char* ws; };
__device__ __forceinline__ bf16_t* xrow_ptr(const DArgs& a, int row) { return (bf16_t*)(a.ws + WS_X) + (size_t)row * D; }

__device__ __forceinline__ void p0_mod(const DArgs& a, LAS unsigned char* lds, int tid, int wid, int lane) {
    LAS float* s = (LAS float*)lds;
    LAS float* red = (LAS float*)(lds + 17 * 1024 * 4);
    const float* c = a.in[I_C]; const float* cc = a.in[I_CCTX];
    for (int i = tid; i < 17 * 1024; i += 512) { const int r = i >> 10, k = i & 1023; const float v = r < 16 ? c[r * 1024 + k] : cc[k]; s[i] = silu_f(v); }
    __syncthreads();
    float* MOD = (float*)(a.ws + WS_MOD);
    for (int it = blockIdx.x; it < DEPTH * 96; it += gridDim.x) {
        const int l = it / 96, nb = it % 96, n = nb * 64 + lane;
        const float* W = a.in[I_WADA] + (size_t)l * D * NMOD + n;
        float acc[17];
#pragma unroll
        for (int r = 0; r < 17; ++r) acc[r] = 0.f;
        for (int k4 = 0; k4 < 32; ++k4) {
            const int k = wid * 128 + k4 * 4;
            const float w0 = W[(size_t)k * NMOD], w1 = W[(size_t)(k + 1) * NMOD], w2 = W[(size_t)(k + 2) * NMOD], w3 = W[(size_t)(k + 3) * NMOD];
#pragma unroll
            for (int r = 0; r < 17; ++r) { const f32x4 sv = *(const LAS f32x4*)(s + r * 1024 + k); acc[r] += sv[0] * w0 + sv[1] * w1 + sv[2] * w2 + sv[3] * w3; }
        }
#pragma unroll
        for (int r = 0; r < 17; ++r) red[(wid * 17 + r) * 64 + lane] = acc[r];
        __syncthreads();
        for (int i = tid; i < 17 * 64; i += 512) { const int r = i >> 6, nn = i & 63; float v = 0.f;
#pragma unroll
            for (int w = 0; w < 8; ++w) v += red[(w * 17 + r) * 64 + nn];
            MOD[((size_t)l * 17 + r) * NMOD + nb * 64 + nn] = v + a.in[I_BADA][(size_t)l * NMOD + nb * 64 + nn]; }
        __syncthreads();
    }
    if (blockIdx.x == gridDim.x - 1) {
        float* TAB = (float*)(a.ws + WS_TAB);
        if (tid < 32) { const float x = a.in[I_RETDECAY][tid]; TAB[tid] = -log1pf(expf(-x)) * 1.4426950408889634f; }
        for (int i = tid; i < 2048; i += 512) { const int v = i >> 5, f = i & 31; const float inv = powf(10000.0f, -(float)f / 32.0f); float sn, cs; sincosf((float)v * inv, &sn, &cs);
            TAB[32 + i] = cs; TAB[32 + 2048 + i] = sn; }
    }
}

template <class F>
__device__ __forceinline__ void cvt_item(const float* W, int N, int k0, int n0, float scale, LAS float* scr, int lane, const F& dstrow) {
    const int kk0 = lane >> 3, nq = lane & 7;
    f32x4 v[8];
#pragma unroll
    for (int i = 0; i < 8; ++i) v[i] = *(const f32x4*)(W + (size_t)(k0 + kk0 + 8 * i) * N + n0 + 4 * nq);
#pragma unroll
    for (int i = 0; i < 8; ++i) { LAS float* d = scr + (kk0 + 8 * i) * 33 + 4 * nq; d[0] = v[i][0]; d[1] = v[i][1]; d[2] = v[i][2]; d[3] = v[i][3]; }
    LDS_WAIT(); asm volatile("" ::: "memory");
    const int c = lane & 7;
#pragma unroll
    for (int j = 0; j < 4; ++j) { const int n = (lane >> 3) + 8 * j; const LAS float* sp = scr + (8 * c) * 33 + n;
        u32x4 o; o.x = cvt_pk_bf16(sp[0 * 33] * scale, sp[1 * 33] * scale); o.y = cvt_pk_bf16(sp[2 * 33] * scale, sp[3 * 33] * scale);
        o.z = cvt_pk_bf16(sp[4 * 33] * scale, sp[5 * 33] * scale); o.w = cvt_pk_bf16(sp[6 * 33] * scale, sp[7 * 33] * scale);
        *(u32x4*)(dstrow(n0 + n) + k0 + 8 * c) = o; }
    LDS_WAIT(); asm volatile("" ::: "memory");
}
__device__ __forceinline__ int win_row(int n) {
    if (n < 1024) { const int sec = n >> 9, c = n & 511, head = c >> 7, d = c & 127, half = d >> 6, idx = d & 63;
        return sec * 512 + (head >> 1) * 256 + half * 128 + (head & 1) * 64 + idx; }
    if (n >= 3584 && n < 4608) { const int isx = n >= 4096, i = isx ? n - 4096 : n - 3584; return 3584 + (i >> 7) * 256 + isx * 128 + (i & 127); }
    return n;
}
__device__ __forceinline__ void convert_weights(const DArgs& a, int l, LAS unsigned char* lds, int wid, int lane) {
    LAS float* scr = (LAS float*)(lds + wid * 8448);
    const int gw = blockIdx.x * 8 + wid, NGW = gridDim.x * 8;
    bf16_t* WIN = (bf16_t*)(a.ws + WS_WIN); bf16_t* WRET = (bf16_t*)(a.ws + WS_WRET); bf16_t* WCONV = (bf16_t*)(a.ws + WS_WCONV); bf16_t* WO = (bf16_t*)(a.ws + WS_WO);
    bf16_t* W13 = (bf16_t*)(a.ws + WS_W13); bf16_t* W2 = (bf16_t*)(a.ws + WS_W2); bf16_t* WPOOL = (bf16_t*)(a.ws + WS_WPOOL);
    constexpr int I0 = 16 * 256, I1 = 16 * 32, I2 = 8 * 32, I3 = 16 * 32, I4 = 16 * 256, I5 = 16 * 256, I6 = 16 * 256, I7 = 512;
    constexpr int NIT = I0 + I1 + I2 + I3 + I4 + I5 + I6 + I7;
    for (int it0 = gw; it0 < NIT; it0 += NGW) {
        int r = __builtin_amdgcn_readfirstlane(it0);
        if (r < I0) { const int kb = r / 256, nb = r % 256, n0 = nb * 32; const float sc = (n0 >= 512 && n0 < 1024) ? 0.08838834764831845f : 1.0f;
            cvt_item(a.in[I_WIN] + (size_t)l * D * 8192, 8192, kb * 64, n0, sc, scr, lane, [&](int n) { return WIN + (size_t)win_row(n) * 1024; }); continue; } r -= I0;
        if (r < I1) { const int kb = r / 32, nb = r % 32; cvt_item(a.in[I_WRETOUT] + (size_t)l * 1024 * 1024, 1024, kb * 64, nb * 32, 1.f, scr, lane, [&](int n) { return WRET + (size_t)n * 1024; }); continue; } r -= I1;
        if (r < I2) { const int kb = r / 32, nb = r % 32; cvt_item(a.in[I_WCONVOUT] + (size_t)l * 512 * 1024, 1024, kb * 64, nb * 32, 1.f, scr, lane, [&](int n) { return WCONV + (size_t)n * 1024; }); continue; } r -= I2;
        if (r < I3) { const int kb = r / 32, nb = r % 32; cvt_item(a.in[I_WO] + (size_t)l * 1024 * 1024, 1024, kb * 64, nb * 32, 1.f, scr, lane, [&](int n) { return WO + (size_t)n * 1024; }); continue; } r -= I3;
        if (r < I4 + I5) { const int is3 = r >= I4; if (is3) r -= I4; const int e = r / 256, q = r % 256, kb = q / 16, nb = q % 16;
            const float* src = a.in[is3 ? I_W3 : I_W1] + ((size_t)l * 16 + e) * 1024 * 512;
            cvt_item(src, 512, kb * 64, nb * 32, 1.f, scr, lane, [&](int n) { return W13 + ((size_t)e * 1024 + (n >> 7) * 256 + is3 * 128 + (n & 127)) * 1024; }); continue; } r -= I4 + I5;
        if (r < I6) { const int e = r / 256, q = r % 256, kb = q / 32, nb = q % 32;
            cvt_item(a.in[I_W2] + ((size_t)l * 16 + e) * 512 * 1024, 1024, kb * 64, nb * 32, 1.f, scr, lane, [&](int n) { return W2 + ((size_t)e * 1024 + n) * 512; }); continue; } r -= I6;
        {
            const int g = r / 128, q = r % 128, cb = q / 16, nb = q % 16, n = nb * 64 + lane;
            const float* pw = a.in[I_POOLW] + ((size_t)l * 4 + g) * 128 * 128 + (size_t)cb * 16 * 128;
            const float* sc = a.in[I_POOLSCALE] + (size_t)l * 512 + g * 128;
            const float* wpo = a.in[I_WPOOLOUT] + ((size_t)l * 512 + g * 128) * 1024 + n;
            float acc[16];
#pragma unroll
            for (int cc = 0; cc < 16; ++cc) acc[cc] = 0.f;
            for (int d = 0; d < 128; ++d) { const float w = wpo[(size_t)d * 1024] * sc[d];
#pragma unroll
                for (int cc = 0; cc < 16; ++cc) acc[cc] += pw[cc * 128 + d] * w; }
            u32x4 o0, o1; o0.x = cvt_pk_bf16(acc[0], acc[1]); o0.y = cvt_pk_bf16(acc[2], acc[3]); o0.z = cvt_pk_bf16(acc[4], acc[5]); o0.w = cvt_pk_bf16(acc[6], acc[7]);
            o1.x = cvt_pk_bf16(acc[8], acc[9]); o1.y = cvt_pk_bf16(acc[10], acc[11]); o1.z = cvt_pk_bf16(acc[12], acc[13]); o1.w = cvt_pk_bf16(acc[14], acc[15]);
            bf16_t* dst = WCONV + (size_t)n * 1024 + 512 + g * 128 + cb * 16; *(u32x4*)dst = o0; *(u32x4*)(dst + 8) = o1;
        }
    }
}

template <int MODE>
__device__ __forceinline__ void phase_n1(const DArgs& a, int l, int wid, int lane) {
    const int gw = blockIdx.x * 8 + wid, NGW = gridDim.x * 8;
    const float* MOD = (const float*)(a.ws + WS_MOD);
    const float* nw = a.in[I_NORM1] + (size_t)l * D;
    bf16_t* H = (bf16_t*)(a.ws + WS_H);
    f32x4 px[4], pg[4], pg1[4]; u32x2 py0[4], py1[4], pya[4], pxb[4];
    const int* SLOTOF = (const int*)(a.ws + WS_SLOTOF); const float* ROUTEC = (const float*)(a.ws + WS_ROUTEC); const bf16_t* YS = (const bf16_t*)(a.ws + WS_YS);
    int sl0 = 0, sl1 = 0; float cw0 = 0.f, cw1 = 0.f, cc0 = 0.f, cc1 = 0.f;
#define N1_SLOTS(rw) do { if (MODE != 0) { sl0 = SLOTOF[2 * (size_t)(rw)]; sl1 = SLOTOF[2 * (size_t)(rw) + 1]; cw0 = ROUTEC[2 * (size_t)(rw)]; cw1 = ROUTEC[2 * (size_t)(rw) + 1]; } } while (0)
#define N1_PRELOAD(rw) do { const int _b = (rw) / TPB, _r = (rw) - _b * TPB, _m = _r < CL ? 16 : _b; \
        if (MODE == 0) { const float* _src = _r < CL ? a.in[I_CTX] + (size_t)(_b * CL + _r) * D : a.in[I_X] + (size_t)(_b * SEQ + (_r - CL)) * D; \
            _Pragma("unroll") for (int j = 0; j < 4; ++j) px[j] = *(const f32x4*)(_src + 4 * lane + 256 * j); } \
        else { const bf16_t* _xp = xrow_ptr(a, (rw)); const float* _g = MOD + ((size_t)(l - 1) * 17 + _m) * NMOD + 5 * D; \
            const bf16_t* _y0 = YS + (size_t)sl0 * D; const bf16_t* _y1 = YS + (size_t)sl1 * D; cc0 = cw0; cc1 = cw1; \
            _Pragma("unroll") for (int j = 0; j < 4; ++j) { const int c = 4 * lane + 256 * j; pxb[j] = *(const u32x2*)(_xp + c); pg[j] = *(const f32x4*)(_g + c); pg1[j] = *(const f32x4*)(_g - 3 * D + c); py0[j] = *(const u32x2*)(_y0 + c); py1[j] = *(const u32x2*)(_y1 + c); \
                pya[j] = *(const u32x2*)((const bf16_t*)(a.ws + WS_YATT) + (size_t)(rw) * D + c); } } } while (0)
    if (gw < T) { N1_SLOTS(gw); N1_PRELOAD(gw); if (gw + NGW < T) N1_SLOTS(gw + NGW); }
    for (int row = gw; row < T; row += NGW) {
        const int b = row / TPB, r = row - b * TPB, mrow = r < CL ? 16 : b;
        bf16_t* xp = xrow_ptr(a, row);
        f32x4 v[4];
        if (MODE == 0) {
#pragma unroll
            for (int j = 0; j < 4; ++j) v[j] = px[j];
        } else {
            const float c0 = cc0, c1 = cc1;
#pragma unroll
            for (int j = 0; j < 4; ++j) { const f32x4 g = pg[j], g1 = pg1[j]; const u32x2 p0 = py0[j], p1 = py1[j], pa = pya[j], xb = pxb[j]; f32x4 x = {bf_lo(xb.x), bf_hi(xb.x), bf_lo(xb.y), bf_hi(xb.y)};
                x[0] += g1[0] * bf_lo(pa.x); x[1] += g1[1] * bf_hi(pa.x); x[2] += g1[2] * bf_lo(pa.y); x[3] += g1[3] * bf_hi(pa.y);
                v[j][0] = x[0] + g[0] * (c0 * bf_lo(p0.x) + c1 * bf_lo(p1.x)); v[j][1] = x[1] + g[1] * (c0 * bf_hi(p0.x) + c1 * bf_hi(p1.x));
                v[j][2] = x[2] + g[2] * (c0 * bf_lo(p0.y) + c1 * bf_lo(p1.y)); v[j][3] = x[3] + g[3] * (c0 * bf_hi(p0.y) + c1 * bf_hi(p1.y)); }
        }
        if (row + NGW < T) { N1_PRELOAD(row + NGW); if (row + 2 * NGW < T) N1_SLOTS(row + 2 * NGW); }
        float ss = 0.f;
#pragma unroll
        for (int j = 0; j < 4; ++j) { u32x2 o; o.x = cvt_pk_bf16(v[j][0], v[j][1]); o.y = cvt_pk_bf16(v[j][2], v[j][3]); *(u32x2*)(xp + 4 * lane + 256 * j) = o; ss += (v[j][0] * v[j][0] + v[j][1] * v[j][1]) + (v[j][2] * v[j][2] + v[j][3] * v[j][3]); }
        const float rr = rsqrtf(wave_sum(ss) * (1.0f / D) + EPS);
        const float* sh = MOD + ((size_t)l * 17 + mrow) * NMOD; const float* sc = sh + D;
#pragma unroll
        for (int j = 0; j < 4; ++j) { const int c = 4 * lane + 256 * j; const f32x4 w = *(const f32x4*)(nw + c), s1 = *(const f32x4*)(sc + c), s0 = *(const f32x4*)(sh + c);
            f32x4 h; for (int q = 0; q < 4; ++q) h[q] = v[j][q] * rr * w[q] * (1.0f + s1[q]) + s0[q];
            u32x2 o; o.x = cvt_pk_bf16(h[0], h[1]); o.y = cvt_pk_bf16(h[2], h[3]); *(u32x2*)(H + (size_t)row * D + c) = o; }
    }
}

__device__ __forceinline__ void phase_n2(const DArgs& a, int l, LAS unsigned char* ldsb, int tid, int wid, int lane, const int skip, const bool dry = false) {
    const float* MOD = (const float*)(a.ws + WS_MOD);
    const float* nw = a.in[I_NORM2] + (size_t)l * D;
    bf16_t* H = (bf16_t*)(a.ws + WS_H);
    const bf16_t* YATT = (const bf16_t*)(a.ws + WS_YATT);
    const float* wrg = a.in[I_WRG] + (size_t)l * D * 4; const float* wre = a.in[I_WRE] + (size_t)l * D * 16;
    const float* brg = a.in[I_BRG] + l * 4; const float* bre = a.in[I_BRE] + l * 16;
    float* ROUTEC = (float*)(a.ws + WS_ROUTEC); int* LIST = (int*)(a.ws + WS_LIST);
    unsigned* gcnt = (unsigned*)(a.ws + WS_CTL) + CW_CNT + 64 * l;
    LAS int* re = (LAS int*)(ldsb + LC_RE); LAS int* lcnt = (LAS int*)(ldsb + LC_LCNT);
    const int rpw = (T + (int)gridDim.x - 1) / (int)gridDim.x, row0 = blockIdx.x * rpw, row1 = (row0 + rpw < T) ? row0 + rpw : T;
    LAS float* wl = (LAS float*)ldsb;
    for (int i = tid; i < 1024 * 4; i += 512) { const int c = i >> 2, z = i & 3; wl[z * 1024 + c] = wrg[i]; }
    for (int i = tid; i < 1024 * 16; i += 512) { const int c = i >> 4, z = i & 15; wl[(4 + z) * 1024 + c] = wre[i]; }
    if (tid < 48) lcnt[tid] = 0;
    __syncthreads();
    f32x4 pg[2][4]; u32x2 pp[2][4], px[2][4];
    int ln = lane;
#define N2_PRELOAD(s_, rw) do { const int _b = (rw) / TPB, _r = (rw) - _b * TPB, _m = _r < CL ? 16 : _b; const bf16_t* _xp = xrow_ptr(a, (rw)); const float* _g = MOD + ((size_t)l * 17 + _m) * NMOD + 2 * D; \
        _Pragma("unroll") for (int j = 0; j < 4; ++j) { const int c = 4 * ln + 256 * j; px[s_][j] = *(const u32x2*)(_xp + c); pg[s_][j] = *(const f32x4*)(_g + c); pp[s_][j] = *(const u32x2*)(YATT + (size_t)(rw) * D + c); } } while (0)
    for (int row = row0 + wid; row < row1; row += 16) {
        asm volatile("" : "+v"(ln));
        const int rws[2] = {row, row + 8 < row1 ? row + 8 : row};
        N2_PRELOAD(0, rws[0]); N2_PRELOAD(1, rws[1]);
        f32x4 v[2][4];
        const float gs = dry ? 0.f : 1.f;
#pragma unroll
        for (int s2 = 0; s2 < 2; ++s2)
#pragma unroll
            for (int j = 0; j < 4; ++j) { const u32x2 xb = px[s2][j]; const f32x4 x = {bf_lo(xb.x), bf_hi(xb.x), bf_lo(xb.y), bf_hi(xb.y)}, g = pg[s2][j]; const u32x2 p = pp[s2][j];
                v[s2][j][0] = x[0] + gs * g[0] * bf_lo(p.x); v[s2][j][1] = x[1] + gs * g[1] * bf_hi(p.x); v[s2][j][2] = x[2] + gs * g[2] * bf_lo(p.y); v[s2][j][3] = x[3] + gs * g[3] * bf_hi(p.y); }
        bool act[2]; int mrow[2];
#pragma unroll
        for (int s2 = 0; s2 < 2; ++s2) { const int rw = rws[s2], b = rw / TPB, r = rw - b * TPB; mrow[s2] = r < CL ? 16 : b; const bool present = (s2 == 0) || (row + 8 < row1);
            act[s2] = present && !(skip && r < CL);
            if (present && skip && r < CL && lane == 0) { re[rw - row0] = -1; re[160 + rw - row0] = -1; } }
        if (!act[0] && !act[1]) continue;
        float rr[2];
#pragma unroll
        for (int s2 = 0; s2 < 2; ++s2) { float ss = 0.f;
#pragma unroll
            for (int j = 0; j < 4; ++j) ss += (v[s2][j][0] * v[s2][j][0] + v[s2][j][1] * v[s2][j][1]) + (v[s2][j][2] * v[s2][j][2] + v[s2][j][3] * v[s2][j][3]);
            rr[s2] = rsqrtf(wave_sum(ss) * (1.0f / D) + EPS); }
        f32x2 lg[2][20];
#pragma unroll
        for (int s2 = 0; s2 < 2; ++s2)
#pragma unroll
            for (int q = 0; q < 20; ++q) lg[s2][q] = (f32x2){0.f, 0.f};
#pragma unroll
        for (int j = 0; j < 4; ++j) { const int c = 4 * ln + 256 * j; const f32x4 w = *(const f32x4*)(nw + c);
            f32x4 h[2];
#pragma unroll
            for (int s2 = 0; s2 < 2; ++s2) { const float* sh = MOD + ((size_t)l * 17 + mrow[s2]) * NMOD + 3 * D; const f32x4 s1 = *(const f32x4*)(sh + D + c), s0 = *(const f32x4*)(sh + c);
#pragma unroll
                for (int q = 0; q < 4; ++q) h[s2][q] = v[s2][j][q] * rr[s2] * w[q] * (1.0f + s1[q]) + s0[q];
                { u32x2 o; o.x = cvt_pk_bf16(h[s2][0], h[s2][1]); o.y = cvt_pk_bf16(h[s2][2], h[s2][3]); *(u32x2*)(H + (size_t)rws[s2] * D + c) = o; } }
#pragma unroll
            for (int z = 0; z < 20; ++z) { const f32x4 w4 = *(const LAS f32x4*)(wl + z * 1024 + c); const f32x2 wa2 = {w4[0], w4[1]}, wb2 = {w4[2], w4[3]};
                lg[0][z] += (f32x2){h[0][0], h[0][1]} * wa2; lg[0][z] += (f32x2){h[0][2], h[0][3]} * wb2; lg[1][z] += (f32x2){h[1][0], h[1][1]} * wa2; lg[1][z] += (f32x2){h[1][2], h[1][3]} * wb2;
                if ((z & 3) == 3) asm volatile("" : "+v"(lg[0][z - 3]), "+v"(lg[0][z - 2]), "+v"(lg[0][z - 1]), "+v"(lg[0][z]), "+v"(lg[1][z - 3]), "+v"(lg[1][z - 2]), "+v"(lg[1][z - 1]), "+v"(lg[1][z])); }
            asm volatile("" ::: "memory"); }
#define N2_ROUTE(s2) if (act[s2]) { \
            const int rw = rws[s2]; \
            float lgs[20]; \
            _Pragma("unroll") for (int k4 = 0; k4 < 5; ++k4) { const float u4 = wave_sum4(lg[s2][4 * k4][0] + lg[s2][4 * k4][1], lg[s2][4 * k4 + 1][0] + lg[s2][4 * k4 + 1][1], lg[s2][4 * k4 + 2][0] + lg[s2][4 * k4 + 2][1], lg[s2][4 * k4 + 3][0] + lg[s2][4 * k4 + 3][1]); \
                lgs[4 * k4] = lane_val(u4, 0); lgs[4 * k4 + 2] = lane_val(u4, 16); lgs[4 * k4 + 1] = lane_val(u4, 32); lgs[4 * k4 + 3] = lane_val(u4, 48); } \
            float g0 = lgs[0] + brg[0], g1 = lgs[1] + brg[1], g2 = lgs[2] + brg[2], g3 = lgs[3] + brg[3]; \
            int gi = 0; float gm = g0; if (g1 > gm) { gm = g1; gi = 1; } if (g2 > gm) { gm = g2; gi = 2; } if (g3 > gm) { gm = g3; gi = 3; } \
            const float gtop = 1.0f / (expf(g0 - gm) + expf(g1 - gm) + expf(g2 - gm) + expf(g3 - gm)); \
            float e[4]; \
            _Pragma("unroll") \
            for (int i = 0; i < 4; ++i) { const float v0 = lgs[4 + i] + bre[i], v1 = lgs[8 + i] + bre[4 + i], v2 = lgs[12 + i] + bre[8 + i], v3 = lgs[16 + i] + bre[12 + i]; \
                e[i] = gi == 0 ? v0 : gi == 1 ? v1 : gi == 2 ? v2 : v3; } \
            int ia = 0; float va = e[0]; if (e[1] > va) { va = e[1]; ia = 1; } if (e[2] > va) { va = e[2]; ia = 2; } if (e[3] > va) { va = e[3]; ia = 3; } \
            int ib = -1; float vb = -3.0e38f; \
            _Pragma("unroll") \
            for (int i = 0; i < 4; ++i) if (i != ia && e[i] > vb) { vb = e[i]; ib = i; } \
            const float wa = 1.0f / (1.0f + expf(vb - va)), wb = 1.0f - wa; \
            if (lane == 0 && !dry) { const int e0 = gi * 4 + ia, e1 = gi * 4 + ib; const int li = rw - row0; re[li] = e0; re[160 + li] = e1; \
                ROUTEC[(size_t)rw * 2] = wa * gtop; ROUTEC[(size_t)rw * 2 + 1] = wb * gtop; \
                __hip_atomic_fetch_add(lcnt + e0, 1, __ATOMIC_RELAXED, __HIP_MEMORY_SCOPE_WORKGROUP); __hip_atomic_fetch_add(lcnt + e1, 1, __ATOMIC_RELAXED, __HIP_MEMORY_SCOPE_WORKGROUP); } \
        }
        N2_ROUTE(0) N2_ROUTE(1)
#undef N2_ROUTE
    }
#undef N2_PRELOAD
    __syncthreads();
    if (dry) return;
    if (tid < 16) { lcnt[16 + tid] = (int)__hip_atomic_fetch_add(gcnt + tid, (unsigned)lcnt[tid], __ATOMIC_RELAXED, __HIP_MEMORY_SCOPE_AGENT); }
    __syncthreads();
    const int nr = row1 - row0;
    if (tid < 2 * nr && re[(tid & 1) * 160 + (tid >> 1)] >= 0) { const int li = tid >> 1, rk = tid & 1; const int e = re[rk * 160 + li];
        const int p = lcnt[16 + e] + __hip_atomic_fetch_add(lcnt + 32 + e, 1, __ATOMIC_RELAXED, __HIP_MEMORY_SCOPE_WORKGROUP);
        LIST[(size_t)e * T + p] = ((row0 + li) << 1) | rk; }
    __syncthreads();
}

__device__ __forceinline__ void phase_final(const DArgs& a, int wid, int lane, float poison) {
    const int gw = blockIdx.x * 8 + wid, NGW = gridDim.x * 8;
    const float* MOD = (const float*)(a.ws + WS_MOD);
    const float* nw = a.in[I_FINALNORM];
    const int* SLOTOF = (const int*)(a.ws + WS_SLOTOF); const float* ROUTEC = (const float*)(a.ws + WS_ROUTEC); const bf16_t* YS = (const bf16_t*)(a.ws + WS_YS);
    int sl0 = 0, sl1 = 0; float cw0 = 0.f, cw1 = 0.f;
#define FN_ROW(q_) (((q_) / SEQ) * TPB + CL + ((q_) % SEQ))
    if (gw < NB * SEQ) { const int r0 = FN_ROW(gw); sl0 = SLOTOF[2 * (size_t)r0]; sl1 = SLOTOF[2 * (size_t)r0 + 1]; cw0 = ROUTEC[2 * (size_t)r0]; cw1 = ROUTEC[2 * (size_t)r0 + 1]; }
    for (int lr = gw; lr < NB * SEQ; lr += NGW) {
        const int b = lr / SEQ, row = b * TPB + CL + (lr - b * SEQ);
        const bf16_t* xp = xrow_ptr(a, row); float* op = a.out + (size_t)lr * D;
        const float* gt2 = MOD + ((size_t)(DEPTH - 1) * 17 + b) * NMOD + 5 * D; const float* gt1 = gt2 - 3 * D;
        const bf16_t* y0 = YS + (size_t)sl0 * D; const bf16_t* y1 = YS + (size_t)sl1 * D; const bf16_t* ya = (const bf16_t*)(a.ws + WS_YATT) + (size_t)row * D;
        const float c0 = cw0, c1 = cw1;
        if (lr + NGW < NB * SEQ) { const int rn = FN_ROW(lr + NGW); sl0 = SLOTOF[2 * (size_t)rn]; sl1 = SLOTOF[2 * (size_t)rn + 1]; cw0 = ROUTEC[2 * (size_t)rn]; cw1 = ROUTEC[2 * (size_t)rn + 1]; }
        f32x4 v[4]; float ss = 0.f;
#pragma unroll
        for (int j = 0; j < 4; ++j) { const int c = 4 * lane + 256 * j; const u32x2 xb = *(const u32x2*)(xp + c); f32x4 x = {bf_lo(xb.x), bf_hi(xb.x), bf_lo(xb.y), bf_hi(xb.y)}; const f32x4 g = *(const f32x4*)(gt2 + c), g1 = *(const f32x4*)(gt1 + c);
            const u32x2 p0 = *(const u32x2*)(y0 + c), p1 = *(const u32x2*)(y1 + c), pa = *(const u32x2*)(ya + c);
            x[0] += g1[0] * bf_lo(pa.x); x[1] += g1[1] * bf_hi(pa.x); x[2] += g1[2] * bf_lo(pa.y); x[3] += g1[3] * bf_hi(pa.y);
            v[j][0] = x[0] + g[0] * (c0 * bf_lo(p0.x) + c1 * bf_lo(p1.x)); v[j][1] = x[1] + g[1] * (c0 * bf_hi(p0.x) + c1 * bf_hi(p1.x));
            v[j][2] = x[2] + g[2] * (c0 * bf_lo(p0.y) + c1 * bf_lo(p1.y)); v[j][3] = x[3] + g[3] * (c0 * bf_hi(p0.y) + c1 * bf_hi(p1.y));
            ss += (v[j][0] * v[j][0] + v[j][1] * v[j][1]) + (v[j][2] * v[j][2] + v[j][3] * v[j][3]); }
        const float rr = rsqrtf(wave_sum(ss) * (1.0f / D) + EPS);
#pragma unroll
        for (int j = 0; j < 4; ++j) { const int c = 4 * lane + 256 * j; const f32x4 w = *(const f32x4*)(nw + c);
            f32x4 o; for (int q = 0; q < 4; ++q) o[q] = poison != 0.f ? poison : v[j][q] * rr * w[q];
            *(f32x4*)(op + c) = o; }
    }
}

struct SchedInproj {
    const char* H; const char* W; int G, w, nA, skip;
    __device__ __forceinline__ bool next(int i, Unit& u) const {
        int L; if (i < 4) L = i * G + w; else { if (w < nA) return false; L = 4 * G + (i - 4) * (G - nA) + (w - nA); }
        const int nMn = skip ? 32 : 36;
        if (L < nMn * 28) { int pm, pi; pg8::tile_map(L, nMn, 28, pm, pi); if (skip) pm = (pm >> 3) * 9 + 1 + (pm & 7); const int wt = pi < 4 ? pi : pi + 4;
            u.a = H + (size_t)pm * 256 * 2048; u.b = W + (size_t)wt * 256 * 2048; u.pm = pm; u.pn = wt; u.kind = 0; u.nt = 16; u.cont = 0; return true; }
        L -= nMn * 28;
        if (L < 6 * 36) { int pi, pn; pg8::tile_map(L, 6, 36, pi, pn); const int wt = pi + 2;
            u.a = W + (size_t)wt * 256 * 2048; u.b = H + (size_t)pn * 256 * 2048; u.pm = wt; u.pn = pn; u.kind = 1; u.nt = 16; u.cont = 0; return true; }
        return false;
    }
};
struct EpiInproj {
    static constexpr bool PERM = true;
    unsigned char* ws; const float* lg2;
    const float* ropec; const float* ropes; bf16_t* gate;
    template <int ACT> __device__ __forceinline__ void plain(const f32x4 (&acc)[2][2][4][2], bf16_t* dst, int ld, int row0, int col0) const {
#pragma unroll
        for (int ai = 0; ai < 2; ++ai)
#pragma unroll
            for (int m = 0; m < 4; ++m) { bf16_t* rowp = dst + (size_t)(row0 + ai * 128 + m * 16) * ld + col0;
#pragma unroll
                for (int bj = 0; bj < 2; ++bj) { f32x4 v0 = acc[ai][bj][m][0], v1 = acc[ai][bj][m][1];
                    if (ACT == 1) { for (int q = 0; q < 4; ++q) { v0[q] = silu_f(v0[q]); v1[q] = silu_f(v1[q]); } }
                    if (ACT == 2) { for (int q = 0; q < 4; ++q) { v0[q] = sigmoid_f(v0[q]); v1[q] = sigmoid_f(v1[q]); } }
                    *(u32x4*)(rowp + bj * 128) = pack8(v0, v1); } }
    }
    __device__ __forceinline__ void operator()(const f32x4 (&acc)[2][2][4][2], const Unit& u, int wr, int wc, int fr, int fq) const {
        if (u.kind == 0) {
            const int wt = u.pn, row0 = u.pm * 256 + wr * 64 + fr, cl = wc * 32 + 8 * fq;
            if (wt < 4) {
                const int isk = wt >> 1, t = wt & 1, head = 2 * t + (wc >> 1), idx0 = 32 * (wc & 1) + 8 * fq;
                bf16_t* dA = (bf16_t*)(ws + (isk ? WS_KF : WS_QF));
#pragma unroll
                for (int ai = 0; ai < 2; ++ai)
#pragma unroll
                    for (int m = 0; m < 4; ++m) {
                        const int gr = row0 + ai * 128 + m * 16, r = gr % TPB;
                        f32x4 c0 = {1.f, 1.f, 1.f, 1.f}, c1 = c0, s0 = {0.f, 0.f, 0.f, 0.f}, s1 = s0;
                        if (r >= CL) { const int pos = r - CL, v = (wc & 1) ? (pos & 63) : (pos >> 6); const float* cp = ropec + v * 32 + 8 * fq; const float* sp = ropes + v * 32 + 8 * fq;
                            c0 = *(const f32x4*)cp; c1 = *(const f32x4*)(cp + 4); s0 = *(const f32x4*)sp; s1 = *(const f32x4*)(sp + 4); }
                        const f32x4 x10 = acc[ai][0][m][0], x11 = acc[ai][0][m][1], x20 = acc[ai][1][m][0], x21 = acc[ai][1][m][1];
                        const f32x4 o10 = x10 * c0 - x20 * s0, o11 = x11 * c1 - x21 * s1, o20 = x10 * s0 + x20 * c0, o21 = x11 * s1 + x21 * c1;
                        bf16_t* pa = dA + (size_t)gr * 512 + head * 128 + idx0;
                        *(u32x4*)pa = pack8(o10, o11); *(u32x4*)(pa + 64) = pack8(o20, o21);
                    }
            } else if (wt < 12) plain<1>(acc, (bf16_t*)(ws + WS_GS), 1024, row0, (wt - 8) * 256 + cl);
            else if (wt < 14) plain<0>(acc, (bf16_t*)(ws + WS_CB), 512, row0, (wt - 12) * 256 + cl);
            else if (wt < 18) { bf16_t* dst = (bf16_t*)(ws + WS_CU);
#pragma unroll
                for (int ai = 0; ai < 2; ++ai)
#pragma unroll
                    for (int m = 0; m < 4; ++m)
                        *(u32x4*)(dst + (size_t)(row0 + ai * 128 + m * 16) * 512 + (wt - 14) * 128 + cl) = pack8(acc[ai][0][m][0] * acc[ai][1][m][0], acc[ai][0][m][1] * acc[ai][1][m][1]);
            } else if (wt < 20) plain<0>(acc, (bf16_t*)(ws + WS_PI), 512, row0, (wt - 18) * 256 + cl);
            else {
                unsigned char* gp = (unsigned char*)gate + (size_t)((wt - 20) >> 2) * TG * 1024 + ((wt - 20) & 3) * 256 + (wc * 4 + fq) * 16;
#pragma unroll
                for (int ai = 0; ai < 2; ++ai)
#pragma unroll
                    for (int m = 0; m < 4; ++m) { u32x4 w;
#pragma unroll
                        for (int bj = 0; bj < 2; ++bj) { unsigned lo = 0u, hi = 0u;
#pragma unroll
                            for (int q = 0; q < 4; ++q) { lo |= (unsigned)(sigmoid_f(acc[ai][bj][m][0][q]) * 255.0f + 0.5f) << (8 * q); hi |= (unsigned)(sigmoid_f(acc[ai][bj][m][1][q]) * 255.0f + 0.5f) << (8 * q); }
                            if (bj == 0) { w.x = lo; w.y = hi; } else { w.z = lo; w.w = hi; } }
                        *(u32x4*)(gp + (size_t)(row0 + ai * 128 + m * 16) * 1024) = w; }
            }
        } else {
            const int wt = u.pm, tok0 = u.pn * 256 + wc * 32 + 8 * fq;
            if (wt < 4) {
                const int t = wt - 2, head = 2 * t + wr; const float lgf = lg2[head], lgb = lg2[4 + head];
                bf16_t* dF = (bf16_t*)(ws + WS_KTF); bf16_t* dB = (bf16_t*)(ws + WS_KTB);
#pragma unroll
                for (int m = 0; m < 4; ++m) { const int idx = 16 * m + fr;
#pragma unroll
                    for (int bj = 0; bj < 2; ++bj) { f32x4 o1[2], o2[2], sF[2], sB[2];
#pragma unroll
                        for (int n = 0; n < 2; ++n) { const int g0 = tok0 + bj * 128 + 4 * n, r0 = g0 % TPB; const f32x4 x1 = acc[0][bj][m][n], x2 = acc[1][bj][m][n];
                            f32x4 cs = {1.f, 1.f, 1.f, 1.f}, sn = {0.f, 0.f, 0.f, 0.f};
                            if (r0 >= CL) { const int pos = r0 - CL;
                                if (m < 2) { const float c = ropec[(pos >> 6) * 32 + idx], s = ropes[(pos >> 6) * 32 + idx]; cs = (f32x4){c, c, c, c}; sn = (f32x4){s, s, s, s}; }
                                else { const int v = pos & 63;
#pragma unroll
                                    for (int j = 0; j < 4; ++j) { cs[j] = ropec[(v + j) * 32 + idx - 32]; sn[j] = ropes[(v + j) * 32 + idx - 32]; } } }
                            o1[n] = x1 * cs - x2 * sn; o2[n] = x1 * sn + x2 * cs;
#pragma unroll
                            for (int j = 0; j < 4; ++j) { const float fi = (float)((g0 + j) & 127); sF[n][j] = __builtin_amdgcn_exp2f(-fi * lgf); sB[n][j] = __builtin_amdgcn_exp2f(fi * lgb); } }
                        const size_t r1 = (size_t)(head * 128 + idx) * TG + tok0 + bj * 128, r2 = r1 + (size_t)64 * TG;
                        *(u32x4*)(dF + r1) = pack8(o1[0] * sF[0], o1[1] * sF[1]); *(u32x4*)(dF + r2) = pack8(o2[0] * sF[0], o2[1] * sF[1]);
                        *(u32x4*)(dB + r1) = pack8(o1[0] * sB[0], o1[1] * sB[1]); *(u32x4*)(dB + r2) = pack8(o2[0] * sB[0], o2[1] * sB[1]);
                    } }
            } else {
                bf16_t* dst = (bf16_t*)(ws + WS_VT); const int e0 = (wt - 4) * 256 + wr * 64 + fr;
#pragma unroll
                for (int ai = 0; ai < 2; ++ai)
#pragma unroll
                    for (int m = 0; m < 4; ++m)
#pragma unroll
                        for (int bj = 0; bj < 2; ++bj) *(u32x4*)(dst + (size_t)(e0 + ai * 128 + m * 16) * TG + tok0 + bj * 128) = pack8(acc[ai][bj][m][0], acc[ai][bj][m][1]);
            }
        }
    }
};

struct SchedPlain {
    const char* A; const char* B; size_t astep, bstep; int nM, nN, G, c, skip;
    __device__ __forceinline__ bool next(int i, Unit& u) const {
        const int L = i * G + c; if (L >= nM * nN) return false;
        int pm, pn; pg8::tile_map(L, nM, nN, pm, pn); if (skip) pm = (pm >> 3) * 9 + 1 + (pm & 7);
        u.a = A + (size_t)pm * astep; u.b = B + (size_t)pn * bstep; u.pm = pm; u.pn = pn; u.kind = 0; u.nt = 0; u.cont = 0; return true;
    }
};
struct SchedG4 {
    const char* YRET; const char* YCP; const char* WRET; const char* WCP; int nM, G, c, skip;
    __device__ __forceinline__ bool next(int i, Unit& u) const {
        const int mac = i / 3, sub = i - mac * 3, L = mac * G + c; if (L >= nM * 4) return false;
        int pm, pn; pg8::tile_map(L, nM, 4, pm, pn); if (skip) pm = (pm >> 3) * 9 + 1 + (pm & 7);
        const size_t ao = (size_t)pm * 256 * 2048, bo = (size_t)pn * 256 * 2048;
        u.a = sub == 0 ? YRET + ao : YCP + ao + (sub == 2 ? 1024 : 0); u.b = sub == 0 ? WRET + bo : WCP + bo + (sub == 2 ? 1024 : 0);
        u.pm = pm; u.pn = pn; u.kind = sub; u.nt = sub == 0 ? 16 : 8; u.cont = sub != 2; return true;
    }
};
struct EpiG4 {
    static constexpr bool PERM = true;
    const unsigned char* gate;    bf16_t* merged;
    __device__ __forceinline__ void operator()(f32x4 (&acc)[2][2][4][2], const Unit& u, int wr, int wc, int fr, int fq) const {
        const int row0 = u.pm * 256 + wr * 64 + fr, col0 = u.pn * 256 + wc * 32 + 8 * fq, k = u.kind;
        const unsigned char* gk = gate + (size_t)k * TG * 1024 + u.pn * 256 + (wc * 4 + fq) * 16;
        const unsigned char* hk = gk + (k < 2 ? (size_t)TG * 1024 : (size_t)0);
        u32x4 gg[8], hh[8];
#pragma unroll
        for (int i = 0; i < 8; ++i) { const size_t ro = (size_t)(row0 + (i >> 2) * 128 + (i & 3) * 16) * 1024; gg[i] = *(const u32x4*)(gk + ro); hh[i] = *(const u32x4*)(hk + ro); }
#pragma unroll
        for (int ai = 0; ai < 2; ++ai)
#pragma unroll
            for (int m = 0; m < 4; ++m) { const int row = row0 + ai * 128 + m * 16; const u32x4 g = gg[ai * 4 + m], h = hh[ai * 4 + m];
#pragma unroll
                for (int bj = 0; bj < 2; ++bj) { const int col = col0 + bj * 128;
                    const unsigned g0 = bj ? g.z : g.x, g1 = bj ? g.w : g.y, h0 = bj ? h.z : h.x, h1 = bj ? h.w : h.y;
                    f32x4 v0 = acc[ai][bj][m][0], v1 = acc[ai][bj][m][1];
#pragma unroll
                    for (int q = 0; q < 4; ++q) {
                        const float n0 = fmaxf((float)((g0 >> (8 * q)) & 255u), 2.55e-16f), n1 = fmaxf((float)((g1 >> (8 * q)) & 255u), 2.55e-16f);
                        const float d0 = fmaxf((float)((h0 >> (8 * q)) & 255u), 2.55e-16f), d1 = fmaxf((float)((h1 >> (8 * q)) & 255u), 2.55e-16f);
                        v0[q] *= k < 2 ? n0 * __builtin_amdgcn_rcpf(d0) : n0 * (1.0f / 255.0f); v1[q] *= k < 2 ? n1 * __builtin_amdgcn_rcpf(d1) : n1 * (1.0f / 255.0f); }
                    if (k < 2) { acc[ai][bj][m][0] = v0; acc[ai][bj][m][1] = v1; }
                    else *(u32x4*)(merged + (size_t)row * 1024 + col) = pack8(v0, v1); } }
    }
};
struct EpiPlainBf16 {
    static constexpr bool PERM = true;
    bf16_t* O; int ld;
    __device__ __forceinline__ void operator()(const f32x4 (&acc)[2][2][4][2], const Unit& u, int wr, int wc, int fr, int fq) const {
        const int row0 = u.pm * 256 + wr * 64 + fr, col0 = u.pn * 256 + wc * 32 + 8 * fq;
#pragma unroll
        for (int ai = 0; ai < 2; ++ai)
#pragma unroll
            for (int m = 0; m < 4; ++m)
#pragma unroll
                for (int bj = 0; bj < 2; ++bj) *(u32x4*)(O + (size_t)(row0 + ai * 128 + m * 16) * ld + col0 + bj * 128) = pack8(acc[ai][bj][m][0], acc[ai][bj][m][1]);
    }
};

struct SchedMoe {
    const char* A; const char* W; size_t astep, wrow; const LAS int* tile_e; int ntiles, G, c;
    __device__ __forceinline__ bool next(int i, Unit& u) const {
        const int L = i * G + c; if (L >= ntiles * 4) return false;
        int tile, pn; pg8::tile_map(L, ntiles, 4, tile, pn); const int e = tile_e[tile];
        u.a = A + (size_t)tile * astep; u.b = W + ((size_t)e * 1024 + pn * 256) * wrow; u.pm = tile; u.pn = pn; u.kind = e; u.nt = 0; u.cont = 0; return true;
    }
};
struct SchedMoeG {
    const char* A; const char* W; const LAS int* tile_e; const LAS int* cnt; const LAS int* poff; const int* LIST; LAS int* tbl; int ntiles, G, c;
    __device__ __forceinline__ bool next(int i, Unit& u) const {
        const int L = i * G + c; if (L >= ntiles * 4) return false;
        int tile, pn; pg8::tile_map(L, ntiles, 4, tile, pn); const int e = tile_e[tile];
        u.a = A; u.b = W + ((size_t)e * 1024 + pn * 256) * 2048; u.pm = tile; u.pn = pn; u.kind = e; u.nt = 0; u.cont = 0; return true;
    }
    __device__ __forceinline__ void fill_table(const Unit& u, int buf, int tid) const {
        if (tid < 256) { const int e = u.kind; const int* src = LIST + (size_t)e * T + (u.pm * 256 - poff[e]) + tid;
            __builtin_amdgcn_global_load_lds((const unsigned*)src, (LAS unsigned*)(tbl + buf * 256 + (tid & ~63)), 4, 0, 0); }
    }
    __device__ __forceinline__ void load_offsets(const Unit& u, int buf, const int (&gR)[2], const int (&gC2)[2], unsigned (&vo0)[2], unsigned (&vo1)[2]) const {
        const int e = u.kind, pb = u.pm * 256 - poff[e], n = cnt[e];
#pragma unroll
        for (int i = 0; i < 2; ++i) { const int r0 = gR[i], r1 = 128 + gR[i]; const int e0 = tbl[buf * 256 + r0], e1 = tbl[buf * 256 + r1];
            vo0[i] = (unsigned)((pb + r0 < n) ? (e0 >> 1) : 0) * 2048u + (unsigned)gC2[i]; vo1[i] = (unsigned)((pb + r1 < n) ? (e1 >> 1) : 0) * 2048u + (unsigned)gC2[i]; }
    }
};
namespace pg8 { template <> struct sched_gather<SchedMoeG> { static constexpr bool value = true; }; }
struct EpiMoeUp {
    static constexpr bool PERM = true;
    bf16_t* ACT;
    __device__ __forceinline__ void operator()(const f32x4 (&acc)[2][2][4][2], const Unit& u, int wr, int wc, int fr, int fq) const {
        const int row0 = u.pm * 256 + wr * 64 + fr, col0 = u.pn * 128 + wc * 32 + 8 * fq;
#pragma unroll
        for (int ai = 0; ai < 2; ++ai)
#pragma unroll
            for (int m = 0; m < 4; ++m) { f32x4 v0, v1;
#pragma unroll
                for (int q = 0; q < 4; ++q) { v0[q] = silu_fast(acc[ai][0][m][0][q]) * acc[ai][1][m][0][q]; v1[q] = silu_fast(acc[ai][0][m][1][q]) * acc[ai][1][m][1][q]; }
                *(u32x4*)(ACT + (size_t)(row0 + ai * 128 + m * 16) * 512 + col0) = pack8(v0, v1); }
    }
};

template <int NROWS, bool PERMROWS>
__device__ __forceinline__ void dma_tile(LAS unsigned char* ldst, const char* gsrc, size_t row_stride, int tid) {
#pragma unroll
    for (int i = 0; i < NROWS * 16 / 512; ++i) {
        const int q = tid + 512 * i, row = q >> 4, cg = q & 15;
        const int srow = PERMROWS ? ((row & ~31) + pg8::perm32(row & 31)) : row;
        const char* src = gsrc + (size_t)srow * row_stride + ((cg ^ (row & 15)) << 4);
        __builtin_amdgcn_global_load_lds((const unsigned*)src, (LAS unsigned*)(ldst + ((tid & ~63) + 512 * i) * 16), 16, 0, 0);
    }
}
__device__ __forceinline__ bf16x8 lds_frag(const LAS unsigned char* base, int row, int gk) { return *(const LAS bf16x8*)(base + row * 256 + ((gk ^ (row & 15)) << 4)); }

#ifndef CP_DEFER_PCT
#define CP_DEFER_PCT 38
#endif
#ifndef CP_DEFER_PCT_LAST
#define CP_DEFER_PCT_LAST 10
#endif
constexpr int CP_TOTAL = TG * 16 + TG * 16;
constexpr int CP_DEFER_A = (CP_TOTAL / 100 * CP_DEFER_PCT) / 512 * 512, CP_DEFER_B = (CP_TOTAL / 100 * CP_DEFER_PCT_LAST) / 512 * 512;
#define CP_DEFER (skipctx ? CP_DEFER_B : CP_DEFER_A)
constexpr int NCHAIN = BG * 4 * 2 * 4;
template <int NROWS>
__device__ __forceinline__ void dma_tile128(LAS unsigned char* ldst, const char* gsrc, size_t row_stride, int tid) {
#pragma unroll
    for (int i = 0; i < NROWS * 8 / 512; ++i) {
        const int q = tid + 512 * i, row = q >> 3, cg = q & 7;
        const char* src = gsrc + (size_t)row * row_stride + ((cg ^ ((row >> 1) & 7)) << 4);
        __builtin_amdgcn_global_load_lds((const unsigned*)src, (LAS unsigned*)(ldst + ((tid & ~63) + 512 * i) * 16), 16, 0, 0);
    }
}
__device__ __forceinline__ bf16x8 lds_frag128(const LAS unsigned char* base, int row, int gk) { return *(const LAS bf16x8*)(base + row * 128 + ((gk ^ ((row >> 1) & 7)) << 4)); }

__device__ __forceinline__ void chain_unit(const DArgs& a, int unit, const float* lg2p, LAS unsigned char* lds, int tid, int wid, int lane) {
    const int eq = unit & 3, dir = (unit >> 2) & 1, h = (unit >> 3) & 3, bb = unit >> 5, fr = lane & 15, fq = lane >> 4;
    const char* VT = (const char*)(a.ws + WS_VT) + (size_t)(h * 256 + eq * 64) * TG * 2;
    const char* KT = (const char*)(a.ws + (dir ? WS_KTB : WS_KTF)) + (size_t)(h * 128) * TG * 2;
    bf16_t* ST = (bf16_t*)(a.ws + WS_STATES) + ((size_t)((bb * 4 + h) * 2 + dir) * NCH) * 256 * 128;
    const float dec = exp2f(128.0f * lg2p[dir * 4 + h]);
    f32x4 acc[4];
#pragma unroll
    for (int m = 0; m < 4; ++m) acc[m] = (f32x4){0.f, 0.f, 0.f, 0.f};
#define CH_ORDER(s) (dir == 0 ? (s) : ((s) < 2 ? 1 - (s) : 19 - (s)))
#define CH_LOAD(hs) do { const int _h = (hs) < 2 * NCH ? (hs) : 2 * NCH - 1; const int _c = CH_ORDER(_h >> 1); const size_t _tb = (size_t)(bb * TPB + _c * 128 + (_h & 1) * 64) * 2; \
        LAS unsigned char* _sl = lds + ((hs) % 5) * 24576; dma_tile128<64>(_sl, VT + _tb, (size_t)TG * 2, tid); dma_tile128<128>(_sl + 8192, KT + _tb, (size_t)TG * 2, tid); } while (0)
#define CH_MMA(hs) do { const LAS unsigned char* buf = lds + ((hs) % 5) * 24576; bf16x8 kf_[2], vf_[2][4];     \
        _Pragma("unroll") for (int ks = 0; ks < 2; ++ks) { kf_[ks] = lds_frag128(buf + 8192, wid * 16 + fr, 4 * ks + fq); \
            _Pragma("unroll") for (int m = 0; m < 4; ++m) vf_[ks][m] = lds_frag128(buf, 16 * m + fr, 4 * ks + fq); } \
        LDS_WAIT(); __builtin_amdgcn_sched_barrier(0); \
        _Pragma("unroll") for (int ks = 0; ks < 2; ++ks) \
            _Pragma("unroll") for (int m = 0; m < 4; ++m) acc[m] = __builtin_amdgcn_mfma_f32_16x16x32_bf16(kf_[ks], vf_[ks][m], acc[m], 0, 0, 0); } while (0)
#define CH_SYNC() do { asm volatile("s_waitcnt vmcnt(11)" ::: "memory"); LDS_WAIT(); __builtin_amdgcn_s_barrier(); asm volatile("" ::: "memory"); } while (0)
    CH_LOAD(0); CH_LOAD(1); CH_LOAD(2); CH_LOAD(3);
    asm volatile("s_waitcnt vmcnt(9)" ::: "memory"); LDS_WAIT(); __builtin_amdgcn_s_barrier(); asm volatile("" ::: "memory");
    for (int s = 0; s < NCH; ++s) {
        const int hs = 2 * s;
        if (s > 0) CH_SYNC();
        u32x2 pub[4];
#pragma unroll
        for (int m = 0; m < 4; ++m) { acc[m] = acc[m] * dec; pub[m].x = cvt_pk_bf16(acc[m][0], acc[m][1]); pub[m].y = cvt_pk_bf16(acc[m][2], acc[m][3]); }
        CH_LOAD(hs + 4);
        CH_MMA(hs);
        {
            const int _c = CH_ORDER(s); bf16_t* sp = ST + (size_t)_c * 256 * 128 + (size_t)(eq * 64 + 16 * (fq & 1) + fr) * 128 + wid * 16 + 8 * (fq >> 1);
#pragma unroll
            for (int mp = 0; mp < 2; ++mp) { unsigned ax = pub[2 * mp].x, ay = pub[2 * mp].y, bx = pub[2 * mp + 1].x, by = pub[2 * mp + 1].y;
                asm volatile("s_nop 1\n\tv_permlane16_swap_b32 %0, %1\n\tv_permlane16_swap_b32 %2, %3\n\ts_nop 1" : "+v"(ax), "+v"(bx), "+v"(ay), "+v"(by));
                const u32x4 w = {ax, ay, bx, by}; *(u32x4*)(sp + (size_t)mp * 32 * 128) = w; }
        }
        CH_SYNC();
        CH_MMA(hs + 1);
        CH_LOAD(hs + 5);
    }
    asm volatile("s_waitcnt vmcnt(0)" ::: "memory"); LDS_WAIT(); __builtin_amdgcn_s_barrier(); asm volatile("" ::: "memory");
#undef CH_ORDER
#undef CH_LOAD
#undef CH_MMA
#undef CH_SYNC
}
template <int WIN>
__device__ __forceinline__ void pool_quad(const bf16_t* prow, const int tl0, const int n, bf16_t* dst) {
    constexpr int HW = WIN / 2, K = WIN + 3;
    u32x4 p[K];
#pragma unroll
    for (int k = 0; k < K; ++k) { const int sidx = tl0 - HW + k; const int sc = sidx < 0 ? 0 : (sidx >= n ? n - 1 : sidx); p[k] = *(const u32x4*)(prow + (size_t)sc * 512); }
    f32x4 s0[4], s1[4];
#pragma unroll
    for (int j = 0; j < 4; ++j) { s0[j] = (f32x4){0.f, 0.f, 0.f, 0.f}; s1[j] = s0[j]; }
#pragma unroll
    for (int k = 0; k < K; ++k) { const int sidx = tl0 - HW + k; const bool ok = sidx >= 0 && sidx < n; const u32x4 q = p[k];
        const f32x4 f0 = {ok ? bf_lo(q.x) : 0.f, ok ? bf_hi(q.x) : 0.f, ok ? bf_lo(q.y) : 0.f, ok ? bf_hi(q.y) : 0.f}, f1 = {ok ? bf_lo(q.z) : 0.f, ok ? bf_hi(q.z) : 0.f, ok ? bf_lo(q.w) : 0.f, ok ? bf_hi(q.w) : 0.f};
#pragma unroll
        for (int j = 0; j < 4; ++j) if (k >= j && k - j < WIN) { s0[j] += f0; s1[j] += f1; } }
#pragma unroll
    for (int j = 0; j < 4; ++j) { const int tl = tl0 + j; int sa = tl - HW; if (sa < 0) sa = 0; int sb = tl + WIN - HW; if (sb > n) sb = n;
        const float inv = __builtin_amdgcn_rcpf((float)(sb - sa)); const u32x4 c = p[HW + j]; f32x4 o0, o1;
        o0[0] = s0[j][0] * inv - bf_lo(c.x); o0[1] = s0[j][1] * inv - bf_hi(c.x); o0[2] = s0[j][2] * inv - bf_lo(c.y); o0[3] = s0[j][3] * inv - bf_hi(c.y);
        o1[0] = s1[j][0] * inv - bf_lo(c.z); o1[1] = s1[j][1] * inv - bf_hi(c.z); o1[2] = s1[j][2] * inv - bf_lo(c.w); o1[3] = s1[j][3] * inv - bf_hi(c.w);
        *(u32x4*)(dst + (size_t)j * 1024) = pack8(o0, o1); }
}
__device__ __forceinline__ void conv_pool(const DArgs& a, int l, int worker, int nworkers, int tid, const int skip, const int it0, const int it1) {
    const bf16_t* CU = (const bf16_t*)(a.ws + WS_CU); const bf16_t* CBp = (const bf16_t*)(a.ws + WS_CB); const bf16_t* PI = (const bf16_t*)(a.ws + WS_PI);
    bf16_t* YCONV = (bf16_t*)(a.ws + WS_YCONV); bf16_t* POOLED = (bf16_t*)(a.ws + WS_POOLED);
    const float* cw = a.in[I_CONVW] + (size_t)l * 3 * 512;
    const int nitem = TG * 16;
    for (int it = it0 + worker * 512 + tid; it < it1; it += nworkers * 512) {
        const int ispool = it >= nitem, q = ispool ? it - nitem : it;
        if (!ispool) {
            const int c0 = (q & 63) * 8, gr0 = (q >> 6) * 4;
            const int r = gr0 % TPB, lo = r < CL ? 0 : CL, hi = r < CL ? CL : TPB;
            if (skip && r < CL) continue;
            u32x4 u[6], bv[4];
            const bool hasm = r > lo, hasp = r + 4 < hi; const u32x4 z4 = {0u, 0u, 0u, 0u};
            u[0] = *(const u32x4*)(CU + (size_t)(hasm ? gr0 - 1 : gr0) * 512 + c0);
#pragma unroll
            for (int j = 0; j < 4; ++j) { u[1 + j] = *(const u32x4*)(CU + (size_t)(gr0 + j) * 512 + c0); bv[j] = *(const u32x4*)(CBp + (size_t)(gr0 + j) * 512 + c0); }
            u[5] = *(const u32x4*)(CU + (size_t)(hasp ? gr0 + 4 : gr0 + 3) * 512 + c0);
            u[0] = hasm ? u[0] : z4; u[5] = hasp ? u[5] : z4;
            const f32x4 w00 = *(const f32x4*)(cw + c0), w01 = *(const f32x4*)(cw + c0 + 4), w10 = *(const f32x4*)(cw + 512 + c0), w11 = *(const f32x4*)(cw + 512 + c0 + 4),
                        w20 = *(const f32x4*)(cw + 1024 + c0), w21 = *(const f32x4*)(cw + 1024 + c0 + 4);
#pragma unroll
            for (int j = 0; j < 4; ++j) { const u32x4 u0 = u[j], u1 = u[j + 1], u2 = u[j + 2], b = bv[j]; f32x4 o0, o1;
                o0[0] = bf_lo(b.x) * (w00[0] * bf_lo(u0.x) + w10[0] * bf_lo(u1.x) + w20[0] * bf_lo(u2.x)); o0[1] = bf_hi(b.x) * (w00[1] * bf_hi(u0.x) + w10[1] * bf_hi(u1.x) + w20[1] * bf_hi(u2.x));
                o0[2] = bf_lo(b.y) * (w00[2] * bf_lo(u0.y) + w10[2] * bf_lo(u1.y) + w20[2] * bf_lo(u2.y)); o0[3] = bf_hi(b.y) * (w00[3] * bf_hi(u0.y) + w10[3] * bf_hi(u1.y) + w20[3] * bf_hi(u2.y));
                o1[0] = bf_lo(b.z) * (w01[0] * bf_lo(u0.z) + w11[0] * bf_lo(u1.z) + w21[0] * bf_lo(u2.z)); o1[1] = bf_hi(b.z) * (w01[1] * bf_hi(u0.z) + w11[1] * bf_hi(u1.z) + w21[1] * bf_hi(u2.z));
                o1[2] = bf_lo(b.w) * (w01[2] * bf_lo(u0.w) + w11[2] * bf_lo(u1.w) + w21[2] * bf_lo(u2.w)); o1[3] = bf_hi(b.w) * (w01[3] * bf_hi(u0.w) + w11[3] * bf_hi(u1.w) + w21[3] * bf_hi(u2.w));
                *(u32x4*)(YCONV + (size_t)(gr0 + j) * 1024 + c0) = pack8(o0, o1); }
        } else {
            const int cbl = q & 15; const int rest = q >> 4; const int g2 = rest / (TG / 4), gr0 = 4 * (rest - g2 * (TG / 4)), cc0 = g2 * 128 + cbl * 8;
            const int r0 = gr0 % TPB, lo2 = r0 < CL ? 0 : CL, hi2 = r0 < CL ? CL : TPB, base2 = gr0 - r0, tl0 = r0 - lo2, n = hi2 - lo2;
            if (skip && r0 < CL) continue;
            const bf16_t* prow = PI + (size_t)(base2 + lo2) * 512 + cc0; bf16_t* dst = YCONV + (size_t)gr0 * 1024 + 512 + cc0;
            if (g2 == 0) pool_quad<2>(prow, tl0, n, dst); else if (g2 == 1) pool_quad<4>(prow, tl0, n, dst); else if (g2 == 2) pool_quad<8>(prow, tl0, n, dst); else pool_quad<16>(prow, tl0, n, dst);
        }
    }
}

__device__ __forceinline__ void finalize_unit(const DArgs& a, int unit, const float* lg2p, LAS unsigned char* lds, int tid, int wid, int lane) {
    asm volatile("" : "+v"(tid)); lane = tid & 63;
    const int c = unit % NCH, h = (unit / NCH) & 3, bb = unit / (NCH * 4), fr = lane & 15, fq = lane >> 4;
    const int tok0 = bb * TPB + c * 128;
    const float lgf = lg2p[h], lgb = lg2p[4 + h];
    LAS unsigned char* R0 = lds; LAS unsigned char* R1 = lds + 65536;
    const char* QF = (const char*)(a.ws + WS_QF);
    dma_tile<128, false>(R0, (const char*)(a.ws + WS_KF) + ((size_t)tok0 * 512 + h * 128) * 2, 1024, tid);
    bf16x8 qf[4];
    { const size_t ro = ((size_t)(tok0 + wid * 16 + fr) * 512 + h * 128 + 8 * fq) * 2;
#pragma unroll
      for (int ks = 0; ks < 4; ++ks) qf[ks] = *(const bf16x8*)(QF + ro + ks * 64); }
    asm volatile("" ::: "memory");
    const char* ST = (const char*)(a.ws + WS_STATES) + ((size_t)((bb * 4 + h) * 2) * NCH + c) * 256 * 128 * 2;
    dma_tile<128, true>(R0 + 32768, ST, 256, tid);
    dma_tile<256, true>(R1, (const char*)(a.ws + WS_VT) + ((size_t)(h * 256) * TG + tok0) * 2, (size_t)TG * 2, tid);
    asm volatile("s_waitcnt vmcnt(12)" ::: "memory"); __builtin_amdgcn_s_barrier(); asm volatile("" ::: "memory");
    bf16x8 pf[4];
    const int i = wid * 16 + fr;
    {
        f32x4 sc[8];
#pragma unroll
        for (int n = 0; n < 8; ++n) sc[n] = (f32x4){0.f, 0.f, 0.f, 0.f};
#pragma unroll
        for (int k2 = 0; k2 < 2; ++k2) { bf16x8 kfr[2][8];
#pragma unroll
            for (int kk = 0; kk < 2; ++kk)
#pragma unroll
                for (int n = 0; n < 8; ++n) kfr[kk][n] = lds_frag(R0, 16 * n + fr, 4 * (2 * k2 + kk) + fq);
            LDS_WAIT(); __builtin_amdgcn_sched_barrier(0);
#pragma unroll
            for (int kk = 0; kk < 2; ++kk)
#pragma unroll
                for (int n = 0; n < 8; ++n) sc[n] = __builtin_amdgcn_mfma_f32_16x16x32_bf16(kfr[kk][n], qf[2 * k2 + kk], sc[n], 0, 0, 0); }
#pragma unroll
        for (int n = 0; n < 8; ++n)
#pragma unroll
            for (int jj = 0; jj < 4; ++jj) { const int d = i - (16 * n + 4 * fq + jj); const float w = d == 0 ? 2.0f : __builtin_amdgcn_exp2f(d > 0 ? lgf * (float)d : lgb * (float)(-d)); sc[n][jj] *= w; }
#pragma unroll
        for (int ks = 0; ks < 4; ++ks) { u32x4 w; w.x = cvt_pk_bf16(sc[2 * ks][0], sc[2 * ks][1]); w.y = cvt_pk_bf16(sc[2 * ks][2], sc[2 * ks][3]);
            w.z = cvt_pk_bf16(sc[2 * ks + 1][0], sc[2 * ks + 1][1]); w.w = cvt_pk_bf16(sc[2 * ks + 1][2], sc[2 * ks + 1][3]);
            asm volatile("s_nop 1\n\tv_permlane16_swap_b32 %0, %1\n\tv_permlane16_swap_b32 %2, %3\n\ts_nop 1" : "+v"(w.x), "+v"(w.z), "+v"(w.y), "+v"(w.w));
            pf[ks] = __builtin_bit_cast(bf16x8, w); }
    }
    asm volatile("s_waitcnt vmcnt(0)" ::: "memory"); LDS_WAIT(); __builtin_amdgcn_s_barrier(); asm volatile("" ::: "memory");
    dma_tile<128, true>(R0, ST + (size_t)128 * 256, 256, tid);
    f32x4 o[16];
#pragma unroll
    for (int n = 0; n < 16; ++n) o[n] = (f32x4){0.f, 0.f, 0.f, 0.f};
#pragma unroll
    for (int ks = 0; ks < 4; ++ks) { bf16x8 vw[16];
#pragma unroll
        for (int n = 0; n < 16; ++n) vw[n] = lds_frag(R1, 16 * n + fr, 4 * ks + (((fq & 1) << 1) | (fq >> 1)));
        LDS_WAIT(); __builtin_amdgcn_sched_barrier(0);
#pragma unroll
        for (int n = 0; n < 16; ++n) o[n] = __builtin_amdgcn_mfma_f32_16x16x32_bf16(vw[n], pf[ks], o[n], 0, 0, 0); }
    { const float r1 = __builtin_amdgcn_exp2f(-lgf * (float)i);
#pragma unroll
      for (int n = 0; n < 16; ++n) o[n] = o[n] * r1; }
#pragma unroll
    for (int k2 = 0; k2 < 2; ++k2) { bf16x8 sfr[2][8];
#pragma unroll
        for (int kk = 0; kk < 2; ++kk)
#pragma unroll
            for (int n = 0; n < 8; ++n) sfr[kk][n] = lds_frag(R0 + 32768, 16 * n + fr, 4 * (2 * k2 + kk) + fq);
        LDS_WAIT(); __builtin_amdgcn_sched_barrier(0);
#pragma unroll
        for (int kk = 0; kk < 2; ++kk)
#pragma unroll
            for (int n = 0; n < 8; ++n) o[n] = __builtin_amdgcn_mfma_f32_16x16x32_bf16(sfr[kk][n], qf[2 * k2 + kk], o[n], 0, 0, 0); }
    asm volatile("s_waitcnt vmcnt(0) lgkmcnt(0)" ::: "memory"); __builtin_amdgcn_s_barrier(); asm volatile("" ::: "memory");
    dma_tile<256, true>(R1, ST + (size_t)NCH * 256 * 128 * 2, 256, tid);
#pragma unroll
    for (int k2 = 0; k2 < 2; ++k2) { bf16x8 sfr[2][8];
#pragma unroll
        for (int kk = 0; kk < 2; ++kk)
#pragma unroll
            for (int n = 0; n < 8; ++n) sfr[kk][n] = lds_frag(R0, 16 * n + fr, 4 * (2 * k2 + kk) + fq);
        LDS_WAIT(); __builtin_amdgcn_sched_barrier(0);
#pragma unroll
        for (int kk = 0; kk < 2; ++kk)
#pragma unroll
            for (int n = 0; n < 8; ++n) o[8 + n] = __builtin_amdgcn_mfma_f32_16x16x32_bf16(sfr[kk][n], qf[2 * k2 + kk], o[8 + n], 0, 0, 0); }
    { const float r2 = __builtin_amdgcn_exp2f((lgf + lgb) * (float)i);
#pragma unroll
      for (int n = 0; n < 16; ++n) o[n] = o[n] * r2; }
    asm volatile("s_waitcnt vmcnt(0) lgkmcnt(0)" ::: "memory"); __builtin_amdgcn_s_barrier(); asm volatile("" ::: "memory");
    const size_t ro = (size_t)(tok0 + wid * 16 + fr) * 1024 + h * 256 + 8 * fq;
    const bf16_t* GS = (const bf16_t*)(a.ws + WS_GS) + ro; bf16_t* YR = (bf16_t*)(a.ws + WS_YRET) + ro;
    u32x4 gsv[8];
#pragma unroll
    for (int p = 0; p < 8; ++p) gsv[p] = *(const u32x4*)(GS + 32 * p);
    asm volatile("" ::: "memory");
#pragma unroll
    for (int ks = 0; ks < 4; ++ks) { bf16x8 sbr[16];
#pragma unroll
        for (int n = 0; n < 16; ++n) sbr[n] = lds_frag(R1, 16 * n + fr, 4 * ks + fq);
        LDS_WAIT(); __builtin_amdgcn_sched_barrier(0);
#pragma unroll
        for (int n = 0; n < 16; ++n) o[n] = __builtin_amdgcn_mfma_f32_16x16x32_bf16(sbr[n], qf[ks], o[n], 0, 0, 0); }
    { const float r3 = __builtin_amdgcn_exp2f(-lgb * (float)i);
#pragma unroll
      for (int n = 0; n < 16; ++n) o[n] = o[n] * r3; }
    float s = 0.f;
#pragma unroll
    for (int n = 0; n < 16; ++n) s += (o[n][0] + o[n][1]) + (o[n][2] + o[n][3]);
    s = rows4_sum(s);
    const float mu = s * (1.0f / 256.0f); float q = 0.f;
#pragma unroll
    for (int n = 0; n < 16; ++n) { o[n] = o[n] - mu; q += (o[n][0] * o[n][0] + o[n][1] * o[n][1]) + (o[n][2] * o[n][2] + o[n][3] * o[n][3]); }
    q = rows4_sum(q);
    const float rstd = rsqrtf(q * (1.0f / 256.0f) + EPS);
#pragma unroll
    for (int p = 0; p < 8; ++p) { const u32x4 g = gsv[p]; f32x4 v0 = o[2 * p] * rstd, v1 = o[2 * p + 1] * rstd;
        v0[0] *= bf_lo(g.x); v0[1] *= bf_hi(g.x); v0[2] *= bf_lo(g.y); v0[3] *= bf_hi(g.y); v1[0] *= bf_lo(g.z); v1[1] *= bf_hi(g.z); v1[2] *= bf_lo(g.w); v1[3] *= bf_hi(g.w);
        *(u32x4*)(YR + 32 * p) = pack8(v0, v1); }
    LDS_WAIT(); __builtin_amdgcn_s_barrier(); asm volatile("" ::: "memory");
}

__device__ __forceinline__ void finalize_ctx_unit(const DArgs& a, int unit, const float* lg2p, LAS unsigned char* lds, int tid, int wid, int lane) {
    asm volatile("" : "+v"(tid)); lane = tid & 63;
    const int c = unit & 1, h = (unit >> 1) & 3, bb = unit >> 3, fr = lane & 15, fq = lane >> 4;
    const int tok0 = bb * TPB + c * 128, tokx = bb * TPB + (1 - c) * 128;
    const float lgf = lg2p[h], lgb = lg2p[4 + h];
    LAS unsigned char* R0 = lds; LAS unsigned char* R1 = lds + 65536;
    const char* QF = (const char*)(a.ws + WS_QF);
    dma_tile<128, false>(R0, (const char*)(a.ws + WS_KF) + ((size_t)tok0 * 512 + h * 128) * 2, 1024, tid);
    dma_tile<128, false>(R0 + 32768, (const char*)(a.ws + WS_KF) + ((size_t)tokx * 512 + h * 128) * 2, 1024, tid);
    dma_tile<256, true>(R1, (const char*)(a.ws + WS_VT) + ((size_t)(h * 256) * TG + tok0) * 2, (size_t)TG * 2, tid);
    bf16x8 qf[4];
    { const size_t ro = ((size_t)(tok0 + wid * 16 + fr) * 512 + h * 128 + 8 * fq) * 2;
#pragma unroll
      for (int ks = 0; ks < 4; ++ks) qf[ks] = *(const bf16x8*)(QF + ro + ks * 64); }
    asm volatile("s_waitcnt vmcnt(0)" ::: "memory"); __builtin_amdgcn_s_barrier(); asm volatile("" ::: "memory");
    bf16x8 pf[2][4];
    const int i = wid * 16 + fr;
#pragma unroll
    for (int kc = 0; kc < 2; ++kc) {
        const LAS unsigned char* Kb = R0 + kc * 32768; const int off = kc == 0 ? 0 : (c ? 128 : -128);
        f32x4 sc[8];
#pragma unroll
        for (int n = 0; n < 8; ++n) sc[n] = (f32x4){0.f, 0.f, 0.f, 0.f};
#pragma unroll
        for (int k2 = 0; k2 < 2; ++k2) { bf16x8 kfr[2][8];
#pragma unroll
            for (int kk = 0; kk < 2; ++kk)
#pragma unroll
                for (int n = 0; n < 8; ++n) kfr[kk][n] = lds_frag(Kb, 16 * n + fr, 4 * (2 * k2 + kk) + fq);
            LDS_WAIT(); __builtin_amdgcn_sched_barrier(0);
#pragma unroll
            for (int kk = 0; kk < 2; ++kk)
#pragma unroll
                for (int n = 0; n < 8; ++n) sc[n] = __builtin_amdgcn_mfma_f32_16x16x32_bf16(kfr[kk][n], qf[2 * k2 + kk], sc[n], 0, 0, 0); }
#pragma unroll
        for (int n = 0; n < 8; ++n)
#pragma unroll
            for (int jj = 0; jj < 4; ++jj) { const int d = i + off - (16 * n + 4 * fq + jj); const float w = d == 0 ? 2.0f : __builtin_amdgcn_exp2f(d > 0 ? lgf * (float)d : lgb * (float)(-d)); sc[n][jj] *= w; }
#pragma unroll
        for (int ks = 0; ks < 4; ++ks) { u32x4 w; w.x = cvt_pk_bf16(sc[2 * ks][0], sc[2 * ks][1]); w.y = cvt_pk_bf16(sc[2 * ks][2], sc[2 * ks][3]);
            w.z = cvt_pk_bf16(sc[2 * ks + 1][0], sc[2 * ks + 1][1]); w.w = cvt_pk_bf16(sc[2 * ks + 1][2], sc[2 * ks + 1][3]);
            asm volatile("s_nop 1\n\tv_permlane16_swap_b32 %0, %1\n\tv_permlane16_swap_b32 %2, %3\n\ts_nop 1" : "+v"(w.x), "+v"(w.z), "+v"(w.y), "+v"(w.w));
            pf[kc][ks] = __builtin_bit_cast(bf16x8, w); }
    }
    LDS_WAIT(); __builtin_amdgcn_s_barrier(); asm volatile("" ::: "memory");
    dma_tile<256, true>(R0, (const char*)(a.ws + WS_VT) + ((size_t)(h * 256) * TG + tokx) * 2, (size_t)TG * 2, tid);
    f32x4 o[16];
#pragma unroll
    for (int n = 0; n < 16; ++n) o[n] = (f32x4){0.f, 0.f, 0.f, 0.f};
#pragma unroll
    for (int kc = 0; kc < 2; ++kc) {
        const LAS unsigned char* Vb = kc == 0 ? R1 : R0;
        if (kc == 1) { asm volatile("s_waitcnt vmcnt(0) lgkmcnt(0)" ::: "memory"); __builtin_amdgcn_s_barrier(); asm volatile("" ::: "memory"); }
#pragma unroll
        for (int ks = 0; ks < 4; ++ks) { bf16x8 vw[16];
#pragma unroll
            for (int n = 0; n < 16; ++n) vw[n] = lds_frag(Vb, 16 * n + fr, 4 * ks + (((fq & 1) << 1) | (fq >> 1)));
            LDS_WAIT(); __builtin_amdgcn_sched_barrier(0);
#pragma unroll
            for (int n = 0; n < 16; ++n) o[n] = __builtin_amdgcn_mfma_f32_16x16x32_bf16(vw[n], pf[kc][ks], o[n], 0, 0, 0); }
    }
    float s = 0.f;
#pragma unroll
    for (int n = 0; n < 16; ++n) s += (o[n][0] + o[n][1]) + (o[n][2] + o[n][3]);
    s = rows4_sum(s);
    const float mu = s * (1.0f / 256.0f); float q = 0.f;
#pragma unroll
    for (int n = 0; n < 16; ++n) { o[n] = o[n] - mu; q += (o[n][0] * o[n][0] + o[n][1] * o[n][1]) + (o[n][2] * o[n][2] + o[n][3] * o[n][3]); }
    q = rows4_sum(q);
    const float rstd = rsqrtf(q * (1.0f / 256.0f) + EPS);
    const size_t ro = (size_t)(tok0 + wid * 16 + fr) * 1024 + h * 256 + 8 * fq;
    const bf16_t* GS = (const bf16_t*)(a.ws + WS_GS) + ro; bf16_t* YR = (bf16_t*)(a.ws + WS_YRET) + ro;
#pragma unroll
    for (int p = 0; p < 8; ++p) { const u32x4 g = *(const u32x4*)(GS + 32 * p); f32x4 v0 = o[2 * p] * rstd, v1 = o[2 * p + 1] * rstd;
        v0[0] *= bf_lo(g.x); v0[1] *= bf_hi(g.x); v0[2] *= bf_lo(g.y); v0[3] *= bf_hi(g.y); v1[0] *= bf_lo(g.z); v1[1] *= bf_hi(g.z); v1[2] *= bf_lo(g.w); v1[3] *= bf_hi(g.w);
        *(u32x4*)(YR + 32 * p) = pack8(v0, v1); }
    LDS_WAIT(); __builtin_amdgcn_s_barrier(); asm volatile("" ::: "memory");
}

__global__ void __launch_bounds__(512, 2) fwd_kernel(Args kargs_unused) {
    DArgs a; a.out = KArgs().out(); a.ws = KArgs().wsp();
    extern __shared__ __attribute__((aligned(16))) unsigned char lds_raw[];
    LAS unsigned char* lds = (LAS unsigned char*)lds_raw;
    int tid = threadIdx.x, lane = tid & 63, wid = __builtin_amdgcn_readfirstlane(tid >> 6);
    int G = gridDim.x, bid = blockIdx.x;
#define PHASE_FENCE() do { asm volatile("" : "+v"(tid)); lane = tid & 63; wid = __builtin_amdgcn_readfirstlane(tid >> 6); \
        { unsigned _l = __builtin_amdgcn_readfirstlane((unsigned)(size_t)lds); asm volatile("" : "+s"(_l)); lds = (LAS unsigned char*)(size_t)_l; } \
        G = __builtin_amdgcn_readfirstlane(G); bid = __builtin_amdgcn_readfirstlane(bid); asm volatile("" : "+s"(G), "+s"(bid)); \
        a.out = KArgs().out(); a.ws = KArgs().wsp(); } while (0)
    for (int u = tid; u < (LDS_BYTES - LC_OFF) / 4; u += 512) ((LAS unsigned*)(lds + LC_OFF))[u] = 0u;
    __syncthreads();
    unsigned* ctl = (unsigned*)(a.ws + WS_CTL);
    const XcdBarrier bar = xcd_barrier_post(ctl + CW_BAR, (volatile LAS unsigned*)(lds + LC_BAR));
#define GRID_BAR() do { for (int _r = 0; _r < REP_BAR; ++_r) { XcdBarrier _b = bar; asm volatile("" : "+s"(_b.bar)); xcd_barrier(_b); } PHASE_FENCE(); } while (0)
#define TAB ((const float*)(a.ws + WS_TAB))

#ifndef DBG_POISON
#define DBG_POISON 0
#endif
    if (DBG_POISON) {
        u32x4* p4 = (u32x4*)(a.ws + 1 * MiB); const size_t n4 = (WS_END - 1 * MiB) / 16; const u32x4 pz = {0xffffffffu, 0xffffffffu, 0xffffffffu, 0xffffffffu};
        for (size_t i = (size_t)bid * 512 + tid; i < n4; i += (size_t)G * 512) p4[i] = pz;
        u32x4* o4 = (u32x4*)a.out; const size_t m4 = (size_t)NB * SEQ * D / 4;
        for (size_t i = (size_t)bid * 512 + tid; i < m4; i += (size_t)G * 512) o4[i] = pz;
        GRID_BAR();
    }
#ifndef X_NO_P0
    for (int rep = 0; rep < REP_P0; ++rep) { p0_mod(a, lds, tid, wid, lane); __syncthreads(); }
    for (int rep = 0; rep < REP_CVT; ++rep) { convert_weights(a, 0, lds, wid, lane); __syncthreads(); }
#endif
    GRID_BAR();

    for (int l = 0; l < DEPTH; ++l) {
#define lg2 (TAB + l * 8)
        const int skipctx = (l == DEPTH - 1) ? 1 : 0;
#ifndef X_NO_N1
        if (l > 0) for (int rep = 0; rep < REP_CVT; ++rep) { convert_weights(a, l, lds, wid, lane); __syncthreads(); }
        if (l == 0) { for (int rep = 0; rep < REP_N1; ++rep) phase_n1<0>(a, l, wid, lane); } else phase_n1<1>(a, l, wid, lane);
#endif
        GRID_BAR();
        for (int g = 0; g <= NG; ++g) {
#ifndef NO_OVERLAP
#define NO_OVERLAP 0
#endif
            const int nG4 = g == 0 ? 0 : (skipctx ? 128 : 144);
            if (bid < nG4) {
#ifndef X_NO_OUTPROJ
                for (int rep = 0; rep < REP_G4; ++rep) { PHASE_FENCE();
                    const int gp = g - 1;
                    const unsigned char* GATE = (const unsigned char*)(a.ws + ((gp & 1) ? WS_GATE1 : WS_GATE0)); bf16_t* MG = (bf16_t*)(a.ws + WS_MERGED) + (size_t)gp * TG * 1024;
                    SchedG4 S{(const char*)(a.ws + WS_YRET), (const char*)(a.ws + WS_YCONV), (const char*)(a.ws + WS_WRET), (const char*)(a.ws + WS_WCONV), skipctx ? TG / 256 / 9 * 8 : TG / 256, nG4, bid, skipctx};
                    EpiG4 E{GATE, MG};
                    pg8::gemm_phase<1024, 1024, 1024, EpiG4, SchedG4, true, true, true>(lds, tid, S, E);
                }
#endif
            }
            if (g == NG && bid >= nG4) {
                PHASE_FENCE();
                const int ntg = skipctx ? TG / 256 / 9 * 8 : TG / 256;
                SchedPlain S{(const char*)(a.ws + WS_MERGED), (const char*)(a.ws + WS_WO), (size_t)256 * 2048, (size_t)256 * 2048, (NG - 1) * ntg, 4, G - nG4, bid - nG4, skipctx};
                EpiPlainBf16 E{(bf16_t*)(a.ws + WS_YATT), 1024};
                pg8::gemm_phase<1024, 1024, 1024, EpiPlainBf16, SchedPlain, true, true>(lds, tid, S, E);
            }
            if (g < NG) {
#ifndef X_NO_INPROJ
                for (int rep = 0; rep < REP_G1; ++rep) { PHASE_FENCE();
                    SchedInproj S{(const char*)(a.ws + WS_H) + (size_t)g * TG * 2048, (const char*)(a.ws + WS_WIN), G, bid, nG4, skipctx};
                    EpiInproj E{a.ws, lg2, TAB + 32, TAB + 32 + 2048, (bf16_t*)(a.ws + ((g & 1) ? WS_GATE1 : WS_GATE0))};
                    pg8::gemm_phase<1024, 1024, 1024, EpiInproj, SchedInproj, true, true>(lds, tid, S, E);
                }
#endif
            }
            GRID_BAR();
            if (g == NG) break;
#ifndef X_NO_CHAIN
            for (int rep = 0; rep < REP_G2; ++rep) {
            if (bid < NCHAIN) {
                const int cu = (((bid & 7) + 8 * (bid >> 5)) << 2) | ((bid >> 3) & 3);
                for (int r2 = 0; r2 < REP_CH; ++r2) chain_unit(a, cu, lg2, lds, tid, wid, lane); }
            else if (skipctx) { for (int r2 = 0; r2 < REP_CP; ++r2) conv_pool(a, l, bid - NCHAIN, G - NCHAIN, tid, skipctx, 0, CP_TOTAL - CP_DEFER); }
            else {
                const int w = bid - NCHAIN, nv = 2 * (G - NCHAIN) - 32;
                if (w < 32) { finalize_ctx_unit(a, w, lg2, lds, tid, wid, lane); conv_pool(a, l, w, nv, tid, skipctx, 0, CP_TOTAL - CP_DEFER); }
                else { conv_pool(a, l, 32 + 2 * (w - 32), nv, tid, skipctx, 0, CP_TOTAL - CP_DEFER); conv_pool(a, l, 33 + 2 * (w - 32), nv, tid, skipctx, 0, CP_TOTAL - CP_DEFER); }
            }
            }
#endif
            GRID_BAR();
#ifndef X_NO_FIN
            for (int rep = 0; rep < REP_G3; ++rep)
            for (int u = bid; u < BG * 4 * 16; u += G) finalize_unit(a, (u >> 4) * NCH + 2 + (u & 15), lg2, lds, tid, wid, lane);
            conv_pool(a, l, bid, G, tid, skipctx, CP_TOTAL - CP_DEFER, CP_TOTAL);
#endif
            GRID_BAR();
        }
#ifndef X_NO_WO
        for (int rep = 0; rep < REP_WO; ++rep) { PHASE_FENCE();
            SchedPlain S{(const char*)(a.ws + WS_MERGED) + (size_t)(NG - 1) * TG * 2048, (const char*)(a.ws + WS_WO), (size_t)256 * 2048, (size_t)256 * 2048, skipctx ? TG / 256 / 9 * 8 : TG / 256, 4, G, bid, skipctx};
            EpiPlainBf16 E{(bf16_t*)(a.ws + WS_YATT) + (size_t)(NG - 1) * TG * 1024, 1024};
            pg8::gemm_phase<1024, 1024, 1024, EpiPlainBf16, SchedPlain, true, true>(lds, tid, S, E);
        }
#endif
        GRID_BAR();
#ifndef X_NO_N2
        for (int rep = 1; rep < REP_N2; ++rep) { phase_n2(a, l, lds, tid, wid, lane, skipctx, true); __syncthreads(); }
        phase_n2(a, l, lds, tid, wid, lane, skipctx);
#endif
        GRID_BAR();
        {
            LAS int* cnt = (LAS int*)(lds + LC_CNT); LAS int* poff = (LAS int*)(lds + LC_POFF); LAS int* tile_e = (LAS int*)(lds + LC_TILEE); LAS int* ntl = (LAS int*)(lds + LC_NT);
            if (tid == 0) { int off = 0;
_Pragma("unroll 1")
                for (int e = 0; e < 16; ++e) { const int n = (int)xb_ld(ctl + CW_CNT + 64 * l + e); cnt[e] = n; poff[e] = off; const int nt = (n + 255) >> 8;
                    for (int t = 0; t < nt; ++t) tile_e[(off >> 8) + t] = e; off += nt << 8; } poff[16] = off; ntl[0] = off >> 8; }
            __syncthreads();
            const int ntiles = ntl[0];
            {
                int* SLOTOF = (int*)(a.ws + WS_SLOTOF); const int* LISTp = (const int*)(a.ws + WS_LIST);
                for (int idx = bid * 512 + tid; idx < ntiles * 256; idx += G * 512) { const int e = tile_e[idx >> 8], p = idx - poff[e]; if (p < cnt[e]) SLOTOF[LISTp[(size_t)e * T + p]] = idx; }
            }
#ifndef X_NO_M1
            for (int rep = 0; rep < REP_M1; ++rep) { PHASE_FENCE(); SchedMoeG S{(const char*)(a.ws + WS_H), (const char*)(a.ws + WS_W13), tile_e, cnt, poff, (const int*)(a.ws + WS_LIST), (LAS int*)(lds + LC_GTBL), ntiles, G, bid};
              EpiMoeUp E{(bf16_t*)(a.ws + WS_ACT)};
              pg8::gemm_phase<1024, 1024, 1024, EpiMoeUp, SchedMoeG, true, true>(lds, tid, S, E); }
#endif
            GRID_BAR();
#ifndef X_NO_M2
            for (int rep = 0; rep < REP_M2; ++rep) { PHASE_FENCE(); SchedMoe S{(const char*)(a.ws + WS_ACT), (const char*)(a.ws + WS_W2), (size_t)256 * 1024, (size_t)1024, tile_e, ntiles, G, bid};
              EpiPlainBf16 E{(bf16_t*)(a.ws + WS_YS), 1024};
              pg8::gemm_phase<512, 512, 512, EpiPlainBf16, SchedMoe, true, true>(lds, tid, S, E); }
#endif
            GRID_BAR();
        }
    }
    {
        float poison = 0.f;
        const unsigned err = xb_ld(ctl + CW_ERR), tmo = xb_ld(ctl + CW_BAR + XB_TMO);
        if (err) poison = sqrtf((float)err); else if (tmo) poison = sqrtf(90.f);
        phase_final(a, wid, lane, poison);
    }
}

extern "C" void kernel_launch(void* const* d_in, const int* in_sizes, int n_in, void* d_out, int out_size, void* d_ws, size_t ws_size, hipStream_t stream) {
    static int grid = 0;
    if (grid == 0) {
        if (n_in != 25 || ws_size < WS_END) { fprintf(stderr, "kernel_launch: unexpected n_in %d / ws_size %zu\n", n_in, ws_size); grid = -1; return; }
        int dev = 0, cus = 0, per_cu = 0;
        if (hipGetDevice(&dev) != hipSuccess || hipDeviceGetAttribute(&cus, hipDeviceAttributeMultiprocessorCount, dev) != hipSuccess) { grid = -1; return; }
        if (hipFuncSetAttribute((const void*)fwd_kernel, hipFuncAttributeMaxDynamicSharedMemorySize, LDS_BYTES) != hipSuccess) { grid = -1; return; }
        if (hipOccupancyMaxActiveBlocksPerMultiprocessor(&per_cu, (const void*)fwd_kernel, 512, LDS_BYTES) != hipSuccess || per_cu < 1) fprintf(stderr, "kernel_launch: occupancy query says %d\n", per_cu);
        (void)hipGetLastError();
        grid = cus;
    }
    if (grid < 0) return;
    if (hipMemsetAsync((char*)d_ws + WS_CTL, 0, 1 * MiB, stream) != hipSuccess) return;
    Args a{};
    for (int i = 0; i < 25; ++i) a.in[i] = (const float*)d_in[i];
    a.out = (float*)d_out; a.ws = (unsigned char*)d_ws;
    hipLaunchKernelGGL(fwd_kernel, dim3(grid), dim3(512), LDS_BYTES, stream, a);
}
```

```cpp
#include <hip/hip_runtime.h>
#include <cstdio>
#include <cstdint>

#ifndef REP_G1
#define REP_G1 1
#endif
#ifndef REP_G2
#define REP_G2 1
#endif
#ifndef REP_G3
#define REP_G3 1
#endif
#ifndef REP_G4
#define REP_G4 1
#endif
#ifndef REP_WO
#define REP_WO 1
#endif
#ifndef REP_M0
#define REP_M0 1
#endif
#ifndef REP_M1
#define REP_M1 1
#endif
#ifndef REP_M2
#define REP_M2 1
#endif
#ifndef REP_CVT
#define REP_CVT 1
#endif
#ifndef REP_P0
#define REP_P0 1
#endif
#ifndef REP_N1
#define REP_N1 1
#endif
#ifndef REP_BAR
#define REP_BAR 1
#endif
#ifndef REP_N2
#define REP_N2 1
#endif
#ifndef REP_CH
#define REP_CH 1
#endif
#ifndef REP_EPI
#define REP_EPI 1
#endif
#ifndef REP_CP
#define REP_CP 1
#endif
#define LAS __attribute__((address_space(3)))
typedef unsigned short bf16_t;
typedef short bf16x8 __attribute__((ext_vector_type(8)));
typedef short bf16x4 __attribute__((ext_vector_type(4)));
typedef float f32x4 __attribute__((ext_vector_type(4)));
typedef float f32x2 __attribute__((ext_vector_type(2)));
typedef unsigned u32x4 __attribute__((ext_vector_type(4)));
typedef unsigned u32x2 __attribute__((ext_vector_type(2)));

constexpr int D = 1024, NB = 16, SEQ = 2048, CL = 256, TPB = SEQ + CL  , T = NB * TPB  , DEPTH = 4;
constexpr int NG = 4, BG = NB / NG, TG = BG * TPB;
constexpr int NCH = TPB / 128;
constexpr float EPS = 1e-6f;
constexpr int NMOD = 6 * D;

constexpr size_t MiB = 1u << 20;
constexpr size_t WS_CTL = 0;
constexpr size_t WS_MOD = 1 * MiB;
constexpr size_t WS_TAB = WS_MOD + (size_t)DEPTH * 17 * NMOD * 4;
constexpr size_t WS_WIN = 3 * MiB;
constexpr size_t WS_WRET = WS_WIN + 16 * MiB;
constexpr size_t WS_WCONV = WS_WRET + 2 * MiB;
constexpr size_t WS_WPOOL = WS_WCONV + 1 * MiB;
constexpr size_t WS_WO = WS_WPOOL + 1 * MiB;
constexpr size_t WS_W13 = WS_WO + 2 * MiB;
constexpr size_t WS_W2 = WS_W13 + 32 * MiB;
constexpr size_t WS_XC = WS_W2 + 16 * MiB;
constexpr size_t WS_H = WS_XC + 16 * MiB;
constexpr size_t WS_PROJ = WS_H + 72 * MiB;
constexpr size_t SEC = (size_t)TG * 512 * 2;
constexpr size_t WS_QF = WS_PROJ, WS_QB = WS_QF + SEC, WS_KF = WS_QB + SEC, WS_KB = WS_KF + SEC, WS_KTF = WS_KB + SEC, WS_KTB = WS_KTF + SEC;
constexpr size_t WS_VT = WS_KTB + SEC, WS_GS = WS_VT + 2 * SEC, WS_CB = WS_GS + 2 * SEC, WS_CU = WS_CB + SEC, WS_PI = WS_CU + SEC;
constexpr size_t WS_GATE0 = WS_PI + SEC, WS_GATE1 = WS_GATE0 + 6 * SEC;
constexpr size_t WS_PROJ_END = WS_GATE1 + 6 * SEC;
constexpr size_t WS_H2S = WS_PROJ;
constexpr size_t WS_ACT = WS_PROJ + 152 * MiB;
constexpr size_t WS_STATES = WS_PROJ_END;
constexpr size_t WS_YRET = WS_STATES + 36 * MiB;
constexpr size_t WS_YCONV = WS_YRET + 18 * MiB;
constexpr size_t WS_POOLED = WS_YCONV + 9 * MiB;
constexpr size_t WS_MERGEDF = WS_POOLED + 9 * MiB;
constexpr size_t WS_X = WS_MERGEDF + 36 * MiB;
constexpr size_t WS_YATT = WS_X + 72 * MiB;
constexpr size_t WS_YS = WS_YATT + 72 * MiB;
constexpr size_t WS_MERGED = WS_YS;
constexpr size_t WS_ROUTEC = WS_YS + 152 * MiB;
constexpr size_t WS_SLOTOF = WS_ROUTEC + 512 * 1024;
constexpr size_t WS_LIST = WS_ROUTEC + 1 * MiB;
constexpr size_t WS_END = WS_LIST + 3 * MiB;
static_assert(WS_PROJ_END - WS_PROJ == 25 * SEC, "proj");
static_assert(WS_ACT + (size_t)(2 * T + 4096) * 512 * 2 <= WS_X && WS_H2S + (size_t)(2 * T + 4096) * 1024 * 2 <= WS_ACT, "moe alias");
static_assert(WS_END <= 798 * MiB, "workspace");
constexpr int CW_ERR = 16;
constexpr int CW_BAR = 4096;
constexpr int CW_CHN = 32768;
constexpr int CW_CNT = 16384;

constexpr int LDS_BYTES = 147456;
constexpr int LC_OFF = 131072;
constexpr int LC_BAR = LC_OFF + 32;
constexpr int LC_CNT = LC_OFF + 256;
constexpr int LC_POFF = LC_OFF + 384;
constexpr int LC_NT = LC_OFF + 480;
constexpr int LC_TILEE = LC_OFF + 512;
constexpr int LC_RE = LC_OFF + 2048;
constexpr int LC_LCNT = LC_OFF + 3584;
constexpr int LC_GTBL = LC_OFF + 4096;

__device__ __forceinline__ unsigned cvt_pk_bf16(float lo, float hi) { unsigned r; asm volatile("s_nop 0\n\tv_cvt_pk_bf16_f32 %0, %1, %2" : "=v"(r) : "v"(lo), "v"(hi)); return r; }
__device__ __forceinline__ float bf_lo(unsigned w) { return __uint_as_float(w << 16); }
__device__ __forceinline__ float bf_hi(unsigned w) { return __uint_as_float(w & 0xffff0000u); }
template <int CTRL> __device__ __forceinline__ float dpp_add(float v) { return v + __builtin_bit_cast(float, __builtin_amdgcn_update_dpp(0, __builtin_bit_cast(int, v), CTRL, 0xF, 0xF, true)); }
__device__ __forceinline__ float row16_sum(float v) { v = dpp_add<0xB1>(v); v = dpp_add<0x4E>(v); v = dpp_add<0x141>(v); v = dpp_add<0x140>(v); return v; }
__device__ __forceinline__ float swap32_sum(float a, float b) { const auto r = __builtin_amdgcn_permlane32_swap(__builtin_bit_cast(unsigned, a), __builtin_bit_cast(unsigned, b), false, false);
    return __builtin_bit_cast(float, (unsigned)r[0]) + __builtin_bit_cast(float, (unsigned)r[1]); }
__device__ __forceinline__ float swap16_sum(float a, float b) { const auto r = __builtin_amdgcn_permlane16_swap(__builtin_bit_cast(unsigned, a), __builtin_bit_cast(unsigned, b), false, false);
    return __builtin_bit_cast(float, (unsigned)r[0]) + __builtin_bit_cast(float, (unsigned)r[1]); }
__device__ __forceinline__ float wave_sum4(float v0, float v1, float v2, float v3) { return row16_sum(swap16_sum(swap32_sum(v0, v1), swap32_sum(v2, v3))); }
__device__ __forceinline__ float wave_sum(float v) { const float r = row16_sum(v); const float t = swap16_sum(r, r); return swap32_sum(t, t); }
__device__ __forceinline__ float rows4_sum(float v) { const float t = swap16_sum(v, v); return swap32_sum(t, t); }
__device__ __forceinline__ float lane_val(float v, int l) { return __builtin_bit_cast(float, __builtin_amdgcn_readlane(__builtin_bit_cast(int, v), l)); }
__device__ __forceinline__ float fast_exp(float x) { return __builtin_amdgcn_exp2f(x * 1.4426950408889634f); }
__device__ __forceinline__ float silu_f(float x) { return x * __builtin_amdgcn_rcpf(1.0f + fast_exp(-x)); }
__device__ __forceinline__ float sigmoid_f(float x) { return __builtin_amdgcn_rcpf(1.0f + fast_exp(-x)); }
__device__ __forceinline__ float silu_fast(float x) { return x * __builtin_amdgcn_rcpf(1.0f + fast_exp(-x)); }
__device__ __forceinline__ float sigmoid_fast(float x) { return __builtin_amdgcn_rcpf(1.0f + fast_exp(-x)); }
__device__ __forceinline__ u32x4 pack8(const f32x4 a, const f32x4 b) { u32x4 w; w.x = cvt_pk_bf16(a[0], a[1]); w.y = cvt_pk_bf16(a[2], a[3]); w.z = cvt_pk_bf16(b[0], b[1]); w.w = cvt_pk_bf16(b[2], b[3]); return w; }
#define LDS_WAIT() asm volatile("s_waitcnt lgkmcnt(0)" ::: "memory")
#define VM_WAIT() asm volatile("s_waitcnt vmcnt(0)" ::: "memory")

#define XB_TMO      128
#define XB_XCNT(j)  (256  + 64 * (j))
#define XB_XSUB(j)  (1280 + 64 * (j))
#define XB_XGEN(j)  (2304 + 64 * (j))
#define XB_TOP      3328
#define XB_TOPGEN   3392
#define XCD_BAR_WORDS 3456
#define XB_SPIN_CAP (1u << 18)
__device__ __forceinline__ unsigned xb_ld(unsigned* p)              { return __hip_atomic_load(p, __ATOMIC_RELAXED, __HIP_MEMORY_SCOPE_AGENT); }
__device__ __forceinline__ unsigned xb_add(unsigned* p, unsigned v) { return __hip_atomic_fetch_add(p, v, __ATOMIC_RELAXED, __HIP_MEMORY_SCOPE_AGENT); }
__device__ __forceinline__ unsigned xb_xcc_id() { return (unsigned)__builtin_amdgcn_s_getreg((3 << 11) | 20) & 0xFu; }
#define XB_SPIN(cond, bar) do { unsigned _sp = 0; while (cond) { __builtin_amdgcn_s_sleep(1); \
    if ((++_sp & 255u) == 0u) { if (xb_ld(&(bar)[XB_TMO])) break; if (_sp > XB_SPIN_CAP) { atomicAdd(&(bar)[XB_TMO], 1u); break; } } } } while (0)
struct XcdBarrier { unsigned* bar; unsigned x; volatile LAS unsigned* st; };
__device__ __forceinline__ XcdBarrier xcd_barrier_post(unsigned* bar, volatile LAS unsigned* st) {
    XcdBarrier b; b.bar = bar; b.x = xb_xcc_id(); b.st = st;
    if (threadIdx.x == 0) (void)xb_add(&bar[XB_XCNT(b.x)], 1u);
    return b;
}
__device__ __forceinline__ void xcd_barrier_complete(unsigned* bar, unsigned x, unsigned& nloc, unsigned& nx) {
    const unsigned G = gridDim.x * gridDim.y * gridDim.z;
    unsigned sum, cnt, mine, sp = 0u;
    for (;;) {
        sum = 0u; cnt = 0u; mine = 0u;
#pragma unroll 1
        for (unsigned j = 0; j < 16; ++j) { const unsigned c = xb_ld(&bar[XB_XCNT(j)]); sum += c; cnt += (c > 0u) ? 1u : 0u; mine = (j == x) ? c : mine; }
        if (sum == G) break;
        __builtin_amdgcn_s_sleep(1);
        if ((++sp & 255u) == 0u) { if (xb_ld(&bar[XB_TMO])) break; if (sp > XB_SPIN_CAP) { atomicAdd(&bar[XB_TMO], 1u); break; } }
    }
    nloc = mine > 0u ? mine : 1u; nx = cnt > 0u ? cnt : 1u;
}
__device__ __forceinline__ void xcd_barrier(const XcdBarrier& b) {
    asm volatile("s_waitcnt vmcnt(0)" ::: "memory");
    __syncthreads();
    if (threadIdx.x == 0) {
        unsigned* bar = b.bar;
        __builtin_amdgcn_s_waitcnt(0);
        unsigned nloc = b.st[0], nx = b.st[1];
        if (nloc == 0u) { xcd_barrier_complete(bar, b.x, nloc, nx); b.st[0] = nloc; b.st[1] = nx; }
        const unsigned old = xb_add(&bar[XB_XSUB(b.x)], 1u);
        const unsigned gen = old / nloc;
        if (old + 1u == (gen + 1u) * nloc) {
            __builtin_amdgcn_fence(__ATOMIC_RELEASE, "agent");
            asm volatile("s_waitcnt vmcnt(0)" ::: "memory");
            const unsigned og = xb_add(&bar[XB_TOP], 1u);
            const unsigned tg = og / nx;
            if (og + 1u == (tg + 1u) * nx) xb_add(&bar[XB_TOPGEN], 1u);
            else XB_SPIN(xb_ld(&bar[XB_TOPGEN]) == tg, bar);
            __builtin_amdgcn_fence(__ATOMIC_ACQUIRE, "agent");
            xb_add(&bar[XB_XGEN(b.x)], 1u);
            asm volatile("s_waitcnt vmcnt(0)" ::: "memory");
        } else {
            XB_SPIN(xb_ld(&bar[XB_XGEN(b.x)]) == gen, bar);
            __builtin_amdgcn_fence(__ATOMIC_ACQUIRE, "agent");
            asm volatile("s_waitcnt vmcnt(0)" ::: "memory");
        }
    }
    __syncthreads();
}

namespace pg8 {
constexpr int BM = 256, BK = 64, HALF = 128, HTB = HALF * BK * 2, STAGE_BYTES = 8 * HTB, NXCD = 8, WGM = 8;
__host__ __device__ __forceinline__ int lds_byte(int r, int c) { const int st = (r >> 4) * 2 + (c >> 5), rr = r & 15, cc = c & 31, ob = rr * 64 + cc * 2; return st * 1024 + (ob ^ (((ob >> 9) & 1) << 5)); }
__host__ __device__ __forceinline__ void stage_rc(int b, int& R, int& C) { const int st = b / 1024, sb = b % 1024, swz = sb ^ (((sb >> 9) & 1) << 5); R = (st >> 1) * 16 + swz / 64; C = (st & 1) * 32 + (swz % 64) / 2; }
__host__ __device__ __forceinline__ int perm32(int rho) { const int n = rho >> 4, i = rho & 15; return 8 * (i >> 2) + 4 * n + (i & 3); }

struct Unit { const char* a; const char* b; int pm, pn, kind, nt, cont; };

__device__ __forceinline__ void tile_map(int L, int nM, int nN, int& pm, int& pn) {
    const int nwg = nM * nN; int wgid = L;
    { const int q = nwg / NXCD, r = nwg % NXCD, xcd = wgid % NXCD, off = wgid / NXCD; wgid = (xcd < r ? xcd * (q + 1) : r * (q + 1) + (xcd - r) * q) + off; }
    const int nig = WGM * nN, gid = wgid / nig, fm = gid * WGM, gsz = (nM - fm) < WGM ? (nM - fm) : WGM;
    pm = fm + ((wgid % nig) % gsz); pn = (wgid % nig) / gsz;
}

template <class S_> struct sched_gather { static constexpr bool value = false; };
template <int K, int lda, int ldb, class Epi, class Sched, bool ALIGN_EPI, bool SP2, bool VARNT = false>
__device__ __forceinline__ void gemm_phase(LAS unsigned char* lds, const int tid, const Sched& S, const Epi& E) {
    const int wid = __builtin_amdgcn_readfirstlane(tid >> 6), lane = tid & 63, wr = wid >> 2, wc = wid & 3, fr = lane & 15, fq = lane >> 4;
    constexpr int nt_c = K / BK;
    unsigned voffA[2], voffB[2];
#pragma unroll
    for (int i = 0; i < 2; ++i) { int R, C; stage_rc(tid * 16 + i * 8192, R, C); const int Rb = Epi::PERM ? ((R & ~31) + perm32(R & 31)) : R;
        voffA[i] = (unsigned)(R * lda + C) * 2u; voffB[i] = (unsigned)(Rb * ldb + C) * 2u; }
    constexpr bool GATHER = sched_gather<Sched>::value;
    int gR[2], gC2[2];
#pragma unroll
    for (int i = 0; i < 2; ++i) { int R, C; stage_rc(tid * 16 + i * 8192, R, C); gR[i] = R; gC2[i] = C * 2; }
    unsigned voA0[2] = {voffA[0], voffA[1]}, voA1[2] = {voffA[0], voffA[1]};
    constexpr size_t kstep = (size_t)(BK * 2);
    constexpr size_t hstepA = (size_t)HALF * lda * 2, hstepB = (size_t)HALF * ldb * 2;
    const unsigned ldsw = (unsigned)wid * 1024u;
    const int aoff = lds_byte(wr * 64 + fr, fq * 8), boff = lds_byte(wc * 32 + fr, fq * 8);
#define PG8_SA(b, h) (((b) * 2 + (h)) * HTB)
#define PG8_SB(b, h) ((4 + (b) * 2 + (h)) * HTB)
#define PG8_STAGE(bufoff, gbase, voff) do { _Pragma("unroll") for (int _i = 0; _i < 2; ++_i) \
        __builtin_amdgcn_global_load_lds((const unsigned*)((const char*)(gbase) + (voff)[_i]), (LAS unsigned*)(lds + (bufoff) + ldsw + _i * 8192), 16, 0, 0); } while (0)
#define PG8_STAGE_A(bufoff, gbase, h) do { if constexpr (GATHER) { if ((h) == 0) PG8_STAGE(bufoff, gbase, voA0); else PG8_STAGE(bufoff, gbase, voA1); } \
        else { PG8_STAGE(bufoff, (gbase) + ((h) ? hstepA : 0), voffA); } } while (0)
#define PG8_LDA(dst, b, h) do { _Pragma("unroll") for (int m = 0; m < 4; ++m) _Pragma("unroll") for (int k = 0; k < 2; ++k) dst[m][k] = *(const LAS bf16x8*)(lds + PG8_SA(b, h) + aoff + m * 2048 + k * 1024); } while (0)
#define PG8_LDB(dst, b, h) do { _Pragma("unroll") for (int n = 0; n < 2; ++n) _Pragma("unroll") for (int k = 0; k < 2; ++k) dst[n][k] = *(const LAS bf16x8*)(lds + PG8_SB(b, h) + boff + n * 2048 + k * 1024); } while (0)
#define PG8_MMA(ai, bj, At, Bt) do { __builtin_amdgcn_s_setprio(1); _Pragma("unroll") for (int m = 0; m < 4; ++m) _Pragma("unroll") for (int n = 0; n < 2; ++n) _Pragma("unroll") for (int k = 0; k < 2; ++k) \
        acc[ai][bj][m][n] = __builtin_amdgcn_mfma_f32_16x16x32_bf16(Bt[n][k], At[m][k], acc[ai][bj][m][n], 0, 0, 0); __builtin_amdgcn_s_setprio(0); } while (0)
#define PG8_WAIT_V(n) asm volatile("s_waitcnt vmcnt(" #n ")" ::: "memory")
#define PG8_WAIT_L(n) asm volatile("s_waitcnt lgkmcnt(" #n ")" ::: "memory")
#define PG8_BAR __builtin_amdgcn_s_barrier()
#define PG8_SCHED __builtin_amdgcn_sched_barrier(0)
    Unit cur, nxt; int ui = 0;
    if (!S.next(0, cur)) return;
    f32x4 acc[2][2][4][2];
#pragma unroll
    for (int a = 0; a < 2; ++a)
#pragma unroll
        for (int b = 0; b < 2; ++b)
#pragma unroll
            for (int m = 0; m < 4; ++m)
#pragma unroll
                for (int n = 0; n < 2; ++n) acc[a][b][m][n] = (f32x4){0.f, 0.f, 0.f, 0.f};
    bf16x8 At[4][2], B0[2][2], B1[2][2];
    const char* cA = cur.a; const char* cB = cur.b;
    if constexpr (GATHER) {
        S.fill_table(cur, 0, tid); asm volatile("s_waitcnt vmcnt(0)" ::: "memory"); __builtin_amdgcn_s_barrier(); asm volatile("" ::: "memory");
        S.load_offsets(cur, 0, gR, gC2, voA0, voA1);
    }
    if constexpr (SP2) {
        PG8_STAGE(PG8_SB(0, 0), cB, voffB); PG8_STAGE(PG8_SB(0, 1), cB + hstepB, voffB); PG8_STAGE_A(PG8_SA(0, 0), cA, 0); PG8_STAGE_A(PG8_SA(0, 1), cA, 1);
        if (wr == 1) PG8_BAR;
        PG8_WAIT_V(2); PG8_BAR;
        PG8_STAGE(PG8_SB(1, 0), cB + kstep, voffB); PG8_STAGE_A(PG8_SA(1, 0), cA + kstep, 0); PG8_STAGE(PG8_SB(1, 1), cB + hstepB + kstep, voffB);
        PG8_WAIT_V(6); PG8_BAR;
    } else {
        PG8_STAGE(PG8_SB(0, 0), cB, voffB); PG8_STAGE_A(PG8_SA(0, 0), cA, 0); PG8_STAGE(PG8_SB(0, 1), cB + hstepB, voffB); PG8_STAGE_A(PG8_SA(0, 1), cA, 1);
        if (wr == 1) PG8_BAR;
        PG8_WAIT_V(4); PG8_BAR;
        PG8_STAGE(PG8_SB(1, 0), cB + kstep, voffB); PG8_STAGE_A(PG8_SA(1, 0), cA + kstep, 0); PG8_STAGE(PG8_SB(1, 1), cB + hstepB + kstep, voffB);
        PG8_WAIT_V(6); PG8_BAR;
    }
    for (;;) {
        const bool has_next = S.next(ui + 1, nxt);
        const char* nA = has_next ? nxt.a : cA; const char* nB = has_next ? nxt.b : cB;
        if constexpr (GATHER) { if (has_next) S.fill_table(nxt, (ui + 1) & 1, tid); }
        const int nt = VARNT ? cur.nt : nt_c;
        for (int t = 0; t < nt; t += 2) {
            const bool last = (t == nt - 2);
            const char* a1 = cA + (size_t)(t + 1) * kstep;
            const char* a2 = last ? nA : cA + (size_t)(t + 2) * kstep; const char* b2 = last ? nB : cB + (size_t)(t + 2) * kstep;
            const char* a3 = a2 + kstep; const char* b3 = b2 + kstep;
            if constexpr (SP2) {
            PG8_LDB(B0, 0, 0); PG8_LDB(B1, 0, 1); PG8_SCHED; PG8_LDA(At, 0, 0); PG8_STAGE_A(PG8_SA(1, 1), a1, 1);
            PG8_WAIT_V(8); PG8_WAIT_L(0); PG8_BAR; PG8_MMA(0, 0, At, B0); PG8_MMA(0, 1, At, B1); PG8_BAR; PG8_SCHED;
            PG8_LDA(At, 0, 1);
            if constexpr (GATHER) { if (last && has_next) S.load_offsets(nxt, (ui + 1) & 1, gR, gC2, voA0, voA1); }
            PG8_STAGE(PG8_SB(0, 0), b2, voffB); PG8_STAGE(PG8_SB(0, 1), b2 + hstepB, voffB); PG8_STAGE_A(PG8_SA(0, 0), a2, 0);
            PG8_WAIT_V(8); PG8_WAIT_L(0); PG8_BAR; PG8_MMA(1, 0, At, B0); PG8_MMA(1, 1, At, B1); PG8_BAR; PG8_SCHED;
            PG8_LDB(B0, 1, 0); PG8_LDB(B1, 1, 1); PG8_SCHED; PG8_LDA(At, 1, 0); PG8_STAGE_A(PG8_SA(0, 1), a2, 1);
            PG8_WAIT_V(8); PG8_WAIT_L(0); PG8_BAR; PG8_MMA(0, 0, At, B0); PG8_MMA(0, 1, At, B1); PG8_BAR; PG8_SCHED;
            PG8_LDA(At, 1, 1); PG8_STAGE(PG8_SB(1, 0), b3, voffB); PG8_STAGE(PG8_SB(1, 1), b3 + hstepB, voffB); PG8_STAGE_A(PG8_SA(1, 0), a3, 0);
            PG8_WAIT_V(8); PG8_WAIT_L(0); PG8_BAR; PG8_MMA(1, 0, At, B0); PG8_MMA(1, 1, At, B1); PG8_BAR; PG8_SCHED;
            } else {
            PG8_LDB(B0, 0, 0); PG8_SCHED; PG8_LDA(At, 0, 0); PG8_STAGE_A(PG8_SA(1, 1), a1, 1);
            PG8_WAIT_L(8); PG8_BAR; PG8_WAIT_L(0); PG8_MMA(0, 0, At, B0); PG8_BAR; PG8_SCHED;
            PG8_LDB(B1, 0, 1); PG8_STAGE(PG8_SB(0, 0), b2, voffB);
            PG8_BAR; PG8_WAIT_L(0); PG8_MMA(0, 1, At, B1); PG8_BAR;
            PG8_LDA(At, 0, 1); PG8_STAGE_A(PG8_SA(0, 0), a2, 0);
            PG8_BAR; PG8_WAIT_L(0); PG8_MMA(1, 0, At, B0); PG8_BAR; PG8_SCHED;
            PG8_STAGE(PG8_SB(0, 1), b2 + hstepB, voffB);
            PG8_WAIT_V(6); PG8_BAR; PG8_MMA(1, 1, At, B1); PG8_BAR;
            PG8_LDB(B0, 1, 0); PG8_SCHED; PG8_LDA(At, 1, 0); PG8_STAGE_A(PG8_SA(0, 1), a2, 1);
            PG8_WAIT_L(8); PG8_BAR; PG8_WAIT_L(0); PG8_MMA(0, 0, At, B0); PG8_BAR; PG8_SCHED;
            PG8_LDB(B1, 1, 1); PG8_STAGE(PG8_SB(1, 0), b3, voffB);
            PG8_BAR; PG8_WAIT_L(0); PG8_MMA(0, 1, At, B1); PG8_BAR;
            PG8_LDA(At, 1, 1); PG8_STAGE_A(PG8_SA(1, 0), a3, 0);
            PG8_BAR; PG8_WAIT_L(0); PG8_MMA(1, 0, At, B0); PG8_BAR; PG8_SCHED;
            PG8_STAGE(PG8_SB(1, 1), b3 + hstepB, voffB);
            PG8_WAIT_V(6); PG8_BAR; PG8_MMA(1, 1, At, B1); PG8_BAR;
            }
        }
        if constexpr (ALIGN_EPI) { if (wr == 0) PG8_BAR; }
        E(acc, cur, wr, wc, fr, fq);
        if (REP_EPI > 1 && !VARNT) { for (int _r = 1; _r < REP_EPI; ++_r) E(acc, cur, wr, wc, fr, fq); }
        if (!has_next) break;
        if (!(VARNT && cur.cont))
#pragma unroll
        for (int a = 0; a < 2; ++a)
#pragma unroll
            for (int b = 0; b < 2; ++b)
#pragma unroll
                for (int m = 0; m < 4; ++m)
#pragma unroll
                    for (int n = 0; n < 2; ++n) acc[a][b][m][n] = (f32x4){0.f, 0.f, 0.f, 0.f};
        cur = nxt; cA = nA; cB = nB; ++ui;
        if constexpr (ALIGN_EPI) { if (wr == 1) PG8_BAR; }
    }
    PG8_WAIT_V(0);
    if constexpr (!ALIGN_EPI) { if (wr == 0) PG8_BAR; }
    PG8_BAR;
#undef PG8_SA
#undef PG8_SB
#undef PG8_STAGE
#undef PG8_LDA
#undef PG8_LDB
#undef PG8_MMA
#undef PG8_WAIT_V
#undef PG8_WAIT_L
#undef PG8_BAR
#undef PG8_SCHED
}
}
using pg8::Unit;

struct Args { const float* in[25]; float* out; unsigned char* ws; };
enum { I_X = 0, I_C, I_CTX, I_CCTX, I_WADA, I_BADA, I_NORM1, I_NORM2, I_WIN, I_RETDECAY, I_CONVW, I_POOLW, I_POOLSCALE, I_WRETOUT, I_WCONVOUT, I_WPOOLOUT, I_WO,
       I_WRG, I_BRG, I_WRE, I_BRE, I_W1, I_W3, I_W2, I_FINALNORM };

struct KArgs {
    __device__ __forceinline__ const char __attribute__((address_space(4)))* base() const { const char __attribute__((address_space(4)))* kp = (const char __attribute__((address_space(4)))*)__builtin_amdgcn_kernarg_segment_ptr(); asm volatile("" : "+s"(kp)); return kp; }
    __device__ __forceinline__ const float* in(int i) const { return *(const float* const __attribute__((address_space(4)))*)(base() + 8 * i); }
    __device__ __forceinline__ float* out() const { return *(float* const __attribute__((address_space(4)))*)(base() + 200); }
    __device__ __forceinline__ unsigned char* wsp() const { return *(unsigned char* const __attribute__((address_space(4)))*)(base() + 208); }
};
struct InProxy { __device__ __forceinline__ const float* operator[](int i) const { return KArgs().in(i); } };
struct DArgs { InProxy in; float* out; unsigned char* ws; };
__device__ __forceinline__ bf16_t* xrow_ptr(const DArgs& a, int row) { return (bf16_t*)(a.ws + WS_X) + (size_t)row * D; }

__device__ __forceinline__ void p0_mod(const DArgs& a, LAS unsigned char* lds, int tid, int wid, int lane, const int l0, const int nl, const int w, const int nw, const bool do_tab) {
    LAS float* s = (LAS float*)lds;
    LAS float* red = (LAS float*)(lds + 17 * 1024 * 4);
    const float* c = a.in[I_C]; const float* cc = a.in[I_CCTX];
    {
        f32x4 v[9];
#pragma unroll
        for (int j = 0; j < 8; ++j) v[j] = *(const f32x4*)(c + (size_t)(tid + 512 * j) * 4);
        v[8] = *(const f32x4*)(cc + (tid & 255) * 4);
#pragma unroll
        for (int j = 0; j < 9; ++j) { f32x4 o;
#pragma unroll
            for (int e = 0; e < 4; ++e) o[e] = silu_f(v[j][e]);
            if (j < 8 || tid < 256) *(LAS f32x4*)(s + (size_t)((j < 8 ? tid + 512 * j : 4096 + tid)) * 4) = o; }
    }
    __syncthreads();
    float* MOD = (float*)(a.ws + WS_MOD);
    for (int it = w; it < nl * 96; it += nw) {
        const int l = l0 + it / 96, nb = it % 96, n = nb * 64 + lane;
        const float* W = a.in[I_WADA] + (size_t)l * D * NMOD + n;
        float acc[17];
#pragma unroll
        for (int r = 0; r < 17; ++r) acc[r] = 0.f;
        for (int kc = 0; kc < 8; ++kc) {
            const int kb = wid * 128 + kc * 16; float wv[16];
            unsigned long long wp = (unsigned long long)(W + (size_t)kb * NMOD); const unsigned long long wstep = (unsigned long long)NMOD * 4;
#pragma unroll
            for (int i = 0; i < 16; ++i) asm volatile("global_load_dword %0, %1, off\n\tv_lshl_add_u64 %1, %1, 0, %2" : "=&v"(wv[i]), "+v"(wp) : "s"(wstep) : "memory");
            asm volatile("s_waitcnt vmcnt(0)" : "+v"(wv[0]), "+v"(wv[1]), "+v"(wv[2]), "+v"(wv[3]), "+v"(wv[4]), "+v"(wv[5]), "+v"(wv[6]), "+v"(wv[7]),
                "+v"(wv[8]), "+v"(wv[9]), "+v"(wv[10]), "+v"(wv[11]), "+v"(wv[12]), "+v"(wv[13]), "+v"(wv[14]), "+v"(wv[15]) :: "memory");
#pragma unroll
            for (int kk = 0; kk < 4; ++kk) { const int k = kb + 4 * kk;
#pragma unroll
                for (int r = 0; r < 17; ++r) { const f32x4 sv = *(const LAS f32x4*)(s + r * 1024 + k); acc[r] += sv[0] * wv[4 * kk] + sv[1] * wv[4 * kk + 1] + sv[2] * wv[4 * kk + 2] + sv[3] * wv[4 * kk + 3];
                    if (r == 5 || r == 11 || r == 16) asm volatile("" ::: "memory"); } }
        }
#pragma unroll
        for (int r = 0; r < 17; ++r) red[(wid * 17 + r) * 64 + lane] = acc[r];
        __syncthreads();
        for (int i = tid; i < 17 * 64; i += 512) { const int r = i >> 6, nn = i & 63; float v = 0.f;
#pragma unroll
            for (int w = 0; w < 8; ++w) v += red[(w * 17 + r) * 64 + nn];
            MOD[((size_t)l * 17 + r) * NMOD + nb * 64 + nn] = v + a.in[I_BADA][(size_t)l * NMOD + nb * 64 + nn]; }
        __syncthreads();
    }
    if (do_tab && blockIdx.x == gridDim.x - 1) {
        float* TAB = (float*)(a.ws + WS_TAB);
        if (tid < 32) { const float x = a.in[I_RETDECAY][tid]; TAB[tid] = -log1pf(expf(-x)) * 1.4426950408889634f; }
        for (int i = tid; i < 2048; i += 512) { const int v = i >> 5, f = i & 31; const float inv = powf(10000.0f, -(float)f / 32.0f); float sn, cs; sincosf((float)v * inv, &sn, &cs);
            TAB[32 + i] = cs; TAB[32 + 2048 + i] = sn; }
    }
}

template <class F>
__device__ __forceinline__ void cvt_item(const float* W, int N, int k0, int n0, float scale, LAS float* scr, int lane, const F& dstrow) {
    const int kk0 = lane >> 3, nq = lane & 7;
    f32x4 v[8];
#pragma unroll
    for (int i = 0; i < 8; ++i) v[i] = *(const f32x4*)(W + (size_t)(k0 + kk0 + 8 * i) * N + n0 + 4 * nq);
#pragma unroll
    for (int i = 0; i < 8; ++i) { LAS float* d = scr + (kk0 + 8 * i) * 33 + 4 * nq; d[0] = v[i][0]; d[1] = v[i][1]; d[2] = v[i][2]; d[3] = v[i][3]; }
    LDS_WAIT(); asm volatile("" ::: "memory");
    const int c = lane & 7;
#pragma unroll
    for (int j = 0; j < 4; ++j) { const int n = (lane >> 3) + 8 * j; const LAS float* sp = scr + (8 * c) * 33 + n;
        u32x4 o; o.x = cvt_pk_bf16(sp[0 * 33] * scale, sp[1 * 33] * scale); o.y = cvt_pk_bf16(sp[2 * 33] * scale, sp[3 * 33] * scale);
        o.z = cvt_pk_bf16(sp[4 * 33] * scale, sp[5 * 33] * scale); o.w = cvt_pk_bf16(sp[6 * 33] * scale, sp[7 * 33] * scale);
        *(u32x4*)(dstrow(n0 + n) + k0 + 8 * c) = o; }
    LDS_WAIT(); asm volatile("" ::: "memory");
}
__device__ __forceinline__ int win_row(int n) {
    if (n < 1024) { const int sec = n >> 9, c = n & 511, head = c >> 7, d = c & 127, half = d >> 6, idx = d & 63;
        return sec * 512 + (head >> 1) * 256 + half * 128 + (head & 1) * 64 + idx; }
    if (n >= 3584 && n < 4608) { const int isx = n >= 4096, i = isx ? n - 4096 : n - 3584; return 3584 + (i >> 7) * 256 + isx * 128 + (i & 127); }
    return n;
}
__device__ __forceinline__ void convert_weights(const DArgs& a, int l, LAS unsigned char* lds, int wid, int lane, int it_first = -1, int it_end = -1, int it_step = 0) {
    LAS float* scr = (LAS float*)(lds + wid * 8704);
    const int gw = blockIdx.x * 8 + wid, NGW = gridDim.x * 8;
    bf16_t* WIN = (bf16_t*)(a.ws + WS_WIN); bf16_t* WRET = (bf16_t*)(a.ws + WS_WRET); bf16_t* WCONV = (bf16_t*)(a.ws + WS_WCONV); bf16_t* WO = (bf16_t*)(a.ws + WS_WO);
    bf16_t* W13 = (bf16_t*)(a.ws + WS_W13); bf16_t* W2 = (bf16_t*)(a.ws + WS_W2); bf16_t* WPOOL = (bf16_t*)(a.ws + WS_WPOOL);
    constexpr int I0 = 16 * 256, I1 = 16 * 32, I2 = 8 * 32, I3 = 16 * 32, I4 = 16 * 256, I5 = 16 * 256, I6 = 16 * 256, I7 = 512;
    constexpr int NIT = I0 + I1 + I2 + I3 + I4 + I5 + I6 + I7;
    if (it_first < 0) { it_first = gw; it_step = NGW; }
    if (it_end < 0) it_end = NIT;
    for (int it0 = it_first; it0 < it_end; it0 += it_step) {
        int r = __builtin_amdgcn_readfirstlane(it0);
        if (r < I0) { const int kb = r / 256, nb = r % 256, n0 = nb * 32; const float sc = (n0 >= 512 && n0 < 1024) ? 0.08838834764831845f : 1.0f;
            cvt_item(a.in[I_WIN] + (size_t)l * D * 8192, 8192, kb * 64, n0, sc, scr, lane, [&](int n) { return WIN + (size_t)win_row(n) * 1024; }); continue; } r -= I0;
        if (r < I1) { const int kb = r / 32, nb = r % 32; cvt_item(a.in[I_WRETOUT] + (size_t)l * 1024 * 1024, 1024, kb * 64, nb * 32, 1.f, scr, lane, [&](int n) { return WRET + (size_t)n * 1024; }); continue; } r -= I1;
        if (r < I2) { const int kb = r / 32, nb = r % 32; cvt_item(a.in[I_WCONVOUT] + (size_t)l * 512 * 1024, 1024, kb * 64, nb * 32, 1.f, scr, lane, [&](int n) { return WCONV + (size_t)n * 1024; }); continue; } r -= I2;
        if (r < I3) { const int kb = r / 32, nb = r % 32; cvt_item(a.in[I_WO] + (size_t)l * 1024 * 1024, 1024, kb * 64, nb * 32, 1.f, scr, lane, [&](int n) { return WO + (size_t)n * 1024; }); continue; } r -= I3;
        if (r < I4 + I5) { const int is3 = r >= I4; if (is3) r -= I4; const int e = r / 256, q = r % 256, kb = q / 16, nb = q % 16;
            const float* src = a.in[is3 ? I_W3 : I_W1] + ((size_t)l * 16 + e) * 1024 * 512;
            cvt_item(src, 512, kb * 64, nb * 32, 1.f, scr, lane, [&](int n) { return W13 + ((size_t)e * 1024 + (n >> 7) * 256 + is3 * 128 + (n & 127)) * 1024; }); continue; } r -= I4 + I5;
        if (r < I6) { const int e = r / 256, q = r % 256, kb = q / 32, nb = q % 32;
            cvt_item(a.in[I_W2] + ((size_t)l * 16 + e) * 512 * 1024, 1024, kb * 64, nb * 32, 1.f, scr, lane, [&](int n) { return W2 + ((size_t)e * 1024 + n) * 512; }); continue; } r -= I6;
        {
            const int g = r / 128, q = r % 128, cb = q / 16, nb = q % 16, n = nb * 64 + lane;
            const float* pw = a.in[I_POOLW] + ((size_t)l * 4 + g) * 128 * 128 + (size_t)cb * 16 * 128;
            const float* sc = a.in[I_POOLSCALE] + (size_t)l * 512 + g * 128;
            const float* wpo = a.in[I_WPOOLOUT] + ((size_t)l * 512 + g * 128) * 1024 + n;
            float acc[16];
#pragma unroll
            for (int cc = 0; cc < 16; ++cc) acc[cc] = 0.f;
            {   f32x4 t[8];
#pragma unroll
                for (int i = 0; i < 8; ++i) t[i] = *(const f32x4*)(pw + (size_t)(lane + 64 * i) * 4);
                const float s0 = sc[lane], s1 = sc[64 + lane];
#pragma unroll
                for (int i = 0; i < 8; ++i) *(LAS f32x4*)(scr + (lane + 64 * i) * 4) = t[i];
                scr[2048 + lane] = s0; scr[2048 + 64 + lane] = s1;
                LDS_WAIT(); asm volatile("" ::: "memory"); }
            float wv[16];
#define PF_ISSUE(dd) do { unsigned long long wp = (unsigned long long)(wpo + (size_t)(dd) * 1024); const unsigned long long wstep = 4096ull; \
                _Pragma("unroll") for (int i = 0; i < 16; ++i) asm volatile("global_load_dword %0, %1, off\n\tv_lshl_add_u64 %1, %1, 0, %2" : "=&v"(wv[i]), "+v"(wp) : "s"(wstep) : "memory"); } while (0)
            PF_ISSUE(0);
            for (int d0 = 0; d0 < 128; d0 += 16) {
                float w[16];
                asm volatile("s_waitcnt vmcnt(0)" : "+v"(wv[0]), "+v"(wv[1]), "+v"(wv[2]), "+v"(wv[3]), "+v"(wv[4]), "+v"(wv[5]), "+v"(wv[6]), "+v"(wv[7]),
                    "+v"(wv[8]), "+v"(wv[9]), "+v"(wv[10]), "+v"(wv[11]), "+v"(wv[12]), "+v"(wv[13]), "+v"(wv[14]), "+v"(wv[15]) :: "memory");
#pragma unroll
                for (int i4 = 0; i4 < 4; ++i4) { const f32x4 sv = *(const LAS f32x4*)(scr + 2048 + d0 + 4 * i4);
#pragma unroll
                    for (int j = 0; j < 4; ++j) w[4 * i4 + j] = wv[4 * i4 + j] * sv[j]; }
                asm volatile("" : "+v"(w[0]), "+v"(w[1]), "+v"(w[2]), "+v"(w[3]), "+v"(w[4]), "+v"(w[5]), "+v"(w[6]), "+v"(w[7]),
                    "+v"(w[8]), "+v"(w[9]), "+v"(w[10]), "+v"(w[11]), "+v"(w[12]), "+v"(w[13]), "+v"(w[14]), "+v"(w[15]) :: "memory");
                PF_ISSUE(d0 + 16 < 128 ? d0 + 16 : 112);
#pragma unroll
                for (int cc = 0; cc < 16; ++cc) {
#pragma unroll
                    for (int i4 = 0; i4 < 4; ++i4) { const f32x4 pv = *(const LAS f32x4*)(scr + cc * 128 + d0 + 4 * i4);
#pragma unroll
                        for (int j = 0; j < 4; ++j) acc[cc] += pv[j] * w[4 * i4 + j]; }
                    if (cc & 1) { asm volatile("" : "+v"(acc[cc - 1]), "+v"(acc[cc]) :: "memory"); __builtin_amdgcn_sched_barrier(0); } }
            }
            asm volatile("s_waitcnt vmcnt(0)" : "+v"(wv[0]), "+v"(wv[1]), "+v"(wv[2]), "+v"(wv[3]), "+v"(wv[4]), "+v"(wv[5]), "+v"(wv[6]), "+v"(wv[7]),
                "+v"(wv[8]), "+v"(wv[9]), "+v"(wv[10]), "+v"(wv[11]), "+v"(wv[12]), "+v"(wv[13]), "+v"(wv[14]), "+v"(wv[15]) :: "memory");
#undef PF_ISSUE
            LDS_WAIT(); asm volatile("" ::: "memory");
            u32x4 o0, o1; o0.x = cvt_pk_bf16(acc[0], acc[1]); o0.y = cvt_pk_bf16(acc[2], acc[3]); o0.z = cvt_pk_bf16(acc[4], acc[5]); o0.w = cvt_pk_bf16(acc[6], acc[7]);
            o1.x = cvt_pk_bf16(acc[8], acc[9]); o1.y = cvt_pk_bf16(acc[10], acc[11]); o1.z = cvt_pk_bf16(acc[12], acc[13]); o1.w = cvt_pk_bf16(acc[14], acc[15]);
            bf16_t* dst = WCONV + (size_t)n * 1024 + 512 + g * 128 + cb * 16; *(u32x4*)dst = o0; *(u32x4*)(dst + 8) = o1;
        }
    }
}

template <int MODE>
__device__ __forceinline__ void phase_n1(const DArgs& a, int l, int wid, int lane) {
    const int gw = blockIdx.x * 8 + wid, NGW = gridDim.x * 8;
    const float* MOD = (const float*)(a.ws + WS_MOD);
    const float* nw = a.in[I_NORM1] + (size_t)l * D;
    bf16_t* H = (bf16_t*)(a.ws + WS_H);
    f32x4 px[4], pg[4], pg1[4], psh[4], psc[4], nwv[4]; u32x2 py0[4], py1[4], pya[4], pxb[4];
#pragma unroll
    for (int j = 0; j < 4; ++j) nwv[j] = *(const f32x4*)(nw + 4 * lane + 256 * j);
    const int* SLOTOF = (const int*)(a.ws + WS_SLOTOF); const float* ROUTEC = (const float*)(a.ws + WS_ROUTEC); const bf16_t* YS = (const bf16_t*)(a.ws + WS_YS);
    int sl0 = 0, sl1 = 0; float cw0 = 0.f, cw1 = 0.f, cc0 = 0.f, cc1 = 0.f;
#define N1_SLOTS(rw) do { if (MODE != 0) { sl0 = SLOTOF[2 * (size_t)(rw)]; sl1 = SLOTOF[2 * (size_t)(rw) + 1]; cw0 = ROUTEC[2 * (size_t)(rw)]; cw1 = ROUTEC[2 * (size_t)(rw) + 1]; } } while (0)
#define N1_PRELOAD(rw) do { const int _b = (rw) / TPB, _r = (rw) - _b * TPB, _m = _r < CL ? 16 : _b; \
        { const float* _sh = MOD + ((size_t)l * 17 + _m) * NMOD; _Pragma("unroll") for (int j = 0; j < 4; ++j) { psh[j] = *(const f32x4*)(_sh + 4 * lane + 256 * j); psc[j] = *(const f32x4*)(_sh + D + 4 * lane + 256 * j); } } \
        if (MODE == 0) { const float* _src = _r < CL ? a.in[I_CTX] + (size_t)(_b * CL + _r) * D : a.in[I_X] + (size_t)(_b * SEQ + (_r - CL)) * D; \
            _Pragma("unroll") for (int j = 0; j < 4; ++j) px[j] = *(const f32x4*)(_src + 4 * lane + 256 * j); } \
        else { const bf16_t* _xp = xrow_ptr(a, (rw)); const float* _g = MOD + ((size_t)(l - 1) * 17 + _m) * NMOD + 5 * D; \
            const bf16_t* _y0 = YS + (size_t)sl0 * D; const bf16_t* _y1 = YS + (size_t)sl1 * D; cc0 = cw0; cc1 = cw1; \
            _Pragma("unroll") for (int j = 0; j < 4; ++j) { const int c = 4 * lane + 256 * j; pxb[j] = *(const u32x2*)(_xp + c); pg[j] = *(const f32x4*)(_g + c); pg1[j] = *(const f32x4*)(_g - 3 * D + c); py0[j] = *(const u32x2*)(_y0 + c); py1[j] = *(const u32x2*)(_y1 + c); \
                pya[j] = *(const u32x2*)((const bf16_t*)(a.ws + WS_YATT) + (size_t)(rw) * D + c); } } } while (0)
    if (gw < T) { N1_SLOTS(gw); N1_PRELOAD(gw); if (gw + NGW < T) N1_SLOTS(gw + NGW); }
    for (int row = gw; row < T; row += NGW) {
        const int b = row / TPB, r = row - b * TPB, mrow = r < CL ? 16 : b;
        bf16_t* xp = xrow_ptr(a, row);
        f32x4 v[4];
        if (MODE == 0) {
#pragma unroll
            for (int j = 0; j < 4; ++j) v[j] = px[j];
        } else {
            const float c0 = cc0, c1 = cc1;
#pragma unroll
            for (int j = 0; j < 4; ++j) { const f32x4 g = pg[j], g1 = pg1[j]; const u32x2 p0 = py0[j], p1 = py1[j], pa = pya[j], xb = pxb[j]; f32x4 x = {bf_lo(xb.x), bf_hi(xb.x), bf_lo(xb.y), bf_hi(xb.y)};
                x[0] += g1[0] * bf_lo(pa.x); x[1] += g1[1] * bf_hi(pa.x); x[2] += g1[2] * bf_lo(pa.y); x[3] += g1[3] * bf_hi(pa.y);
                v[j][0] = x[0] + g[0] * (c0 * bf_lo(p0.x) + c1 * bf_lo(p1.x)); v[j][1] = x[1] + g[1] * (c0 * bf_hi(p0.x) + c1 * bf_hi(p1.x));
                v[j][2] = x[2] + g[2] * (c0 * bf_lo(p0.y) + c1 * bf_lo(p1.y)); v[j][3] = x[3] + g[3] * (c0 * bf_hi(p0.y) + c1 * bf_hi(p1.y)); }
        }
        f32x4 s0v[4], s1v[4];
#pragma unroll
        for (int j = 0; j < 4; ++j) { s0v[j] = psh[j]; s1v[j] = psc[j]; }
        if (row + NGW < T) { N1_PRELOAD(row + NGW); if (row + 2 * NGW < T) N1_SLOTS(row + 2 * NGW); }
        float ss = 0.f;
#pragma unroll
        for (int j = 0; j < 4; ++j) { u32x2 o; o.x = cvt_pk_bf16(v[j][0], v[j][1]); o.y = cvt_pk_bf16(v[j][2], v[j][3]); *(u32x2*)(xp + 4 * lane + 256 * j) = o; ss += (v[j][0] * v[j][0] + v[j][1] * v[j][1]) + (v[j][2] * v[j][2] + v[j][3] * v[j][3]); }
        const float rr = rsqrtf(wave_sum(ss) * (1.0f / D) + EPS);
#pragma unroll
        for (int j = 0; j < 4; ++j) { const int c = 4 * lane + 256 * j; const f32x4 w = nwv[j], s1 = s1v[j], s0 = s0v[j];
            f32x4 h; for (int q = 0; q < 4; ++q) h[q] = v[j][q] * rr * w[q] * (1.0f + s1[q]) + s0[q];
            u32x2 o; o.x = cvt_pk_bf16(h[0], h[1]); o.y = cvt_pk_bf16(h[2], h[3]); *(u32x2*)(H + (size_t)row * D + c) = o; }
    }
}

__device__ __forceinline__ void phase_n2(const DArgs& a, int l, LAS unsigned char* ldsb, int tid, int wid, int lane, const int skip, const bool dry = false) {
    const float* MOD = (const float*)(a.ws + WS_MOD);
    const float* nw = a.in[I_NORM2] + (size_t)l * D;
    bf16_t* H = (bf16_t*)(a.ws + WS_H);
    const bf16_t* YATT = (const bf16_t*)(a.ws + WS_YATT);
    const float* wrg = a.in[I_WRG] + (size_t)l * D * 4; const float* wre = a.in[I_WRE] + (size_t)l * D * 16;
    const float* brg = a.in[I_BRG] + l * 4; const float* bre = a.in[I_BRE] + l * 16;
    const float brgl = brg[lane & 3], brel = bre[lane & 15];
    float* ROUTEC = (float*)(a.ws + WS_ROUTEC); int* LIST = (int*)(a.ws + WS_LIST);
    unsigned* gcnt = (unsigned*)(a.ws + WS_CTL) + CW_CNT + 64 * l;
    LAS int* re = (LAS int*)(ldsb + LC_RE); LAS int* lcnt = (LAS int*)(ldsb + LC_LCNT);
    const int rpw = (T + (int)gridDim.x - 1) / (int)gridDim.x, row0 = blockIdx.x * rpw, row1 = (row0 + rpw < T) ? row0 + rpw : T;
    LAS float* wl = (LAS float*)ldsb;
    {
        f32x4 vg[2], ve[8];
#pragma unroll
        for (int j = 0; j < 2; ++j) vg[j] = *(const f32x4*)(wrg + (size_t)(tid + 512 * j) * 4);
#pragma unroll
        for (int j = 0; j < 8; ++j) ve[j] = *(const f32x4*)(wre + (size_t)(tid + 512 * j) * 4);
#pragma unroll
        for (int j = 0; j < 2; ++j) { const int c = tid + 512 * j;
#pragma unroll
            for (int e = 0; e < 4; ++e) wl[e * 1024 + c] = vg[j][e]; }
#pragma unroll
        for (int j = 0; j < 8; ++j) { const int q = tid + 512 * j, c = q >> 2, z = (q & 3) * 4;
#pragma unroll
            for (int e = 0; e < 4; ++e) wl[(4 + z + e) * 1024 + c] = ve[j][e]; }
    }
    if (tid < 48) lcnt[tid] = 0;
    __syncthreads();
    f32x4 pg[2][4]; u32x2 pp[2][4], px[2][4];
    int ln = lane;
#define N2_PRELOAD_XP(s_, rw) do { const bf16_t* _xp = xrow_ptr(a, (rw)); \
        _Pragma("unroll") for (int j = 0; j < 4; ++j) { const int c = 4 * ln + 256 * j; px[s_][j] = *(const u32x2*)(_xp + c); pp[s_][j] = *(const u32x2*)(YATT + (size_t)(rw) * D + c); } } while (0)
#define N2_PRELOAD_G(s_, rw) do { const int _b = (rw) / TPB, _r = (rw) - _b * TPB, _m = _r < CL ? 16 : _b; const float* _g = MOD + ((size_t)l * 17 + _m) * NMOD + 2 * D; \
        _Pragma("unroll") for (int j = 0; j < 4; ++j) { const int c = 4 * ln + 256 * j; pg[s_][j] = *(const f32x4*)(_g + c); } } while (0)
    if (row0 + wid < row1) { const int r0 = row0 + wid, r1 = r0 + 8 < row1 ? r0 + 8 : r0; N2_PRELOAD_XP(0, r0); N2_PRELOAD_XP(1, r1); }
    for (int row = row0 + wid; row < row1; row += 16) {
        asm volatile("" : "+v"(ln));
        const int rws[2] = {row, row + 8 < row1 ? row + 8 : row};
        N2_PRELOAD_G(0, rws[0]); N2_PRELOAD_G(1, rws[1]);
        f32x4 v[2][4];
        const float gs = dry ? 0.f : 1.f;
#pragma unroll
        for (int s2 = 0; s2 < 2; ++s2)
#pragma unroll
            for (int j = 0; j < 4; ++j) { const u32x2 xb = px[s2][j]; const f32x4 x = {bf_lo(xb.x), bf_hi(xb.x), bf_lo(xb.y), bf_hi(xb.y)}, g = pg[s2][j]; const u32x2 p = pp[s2][j];
                v[s2][j][0] = x[0] + gs * g[0] * bf_lo(p.x); v[s2][j][1] = x[1] + gs * g[1] * bf_hi(p.x); v[s2][j][2] = x[2] + gs * g[2] * bf_lo(p.y); v[s2][j][3] = x[3] + gs * g[3] * bf_hi(p.y); }
#define N2_PREFETCH_NEXT() do { const int nrow = row + 16 < row1 ? row + 16 : row, nr1 = nrow + 8 < row1 ? nrow + 8 : nrow; N2_PRELOAD_XP(0, nrow); N2_PRELOAD_XP(1, nr1); } while (0)
        bool act[2]; int mrow[2];
#pragma unroll
        for (int s2 = 0; s2 < 2; ++s2) { const int rw = rws[s2], b = rw / TPB, r = rw - b * TPB; mrow[s2] = r < CL ? 16 : b; const bool present = (s2 == 0) || (row + 8 < row1);
            act[s2] = present && !(skip && r < CL);
            if (present && skip && r < CL && lane == 0) { re[rw - row0] = -1; re[160 + rw - row0] = -1; } }
        if (!act[0] && !act[1]) { N2_PREFETCH_NEXT(); continue; }
        f32x4 wq[4], s1q[2][4], s0q[2][4];
#pragma unroll
        for (int j = 0; j < 4; ++j) { const int c = 4 * ln + 256 * j; wq[j] = *(const f32x4*)(nw + c);
#pragma unroll
            for (int s2 = 0; s2 < 2; ++s2) { const float* sh = MOD + ((size_t)l * 17 + mrow[s2]) * NMOD + 3 * D; s1q[s2][j] = *(const f32x4*)(sh + D + c); s0q[s2][j] = *(const f32x4*)(sh + c); } }
        N2_PREFETCH_NEXT();
#undef N2_PREFETCH_NEXT
        float rr[2];
#pragma unroll
        for (int s2 = 0; s2 < 2; ++s2) { float ss = 0.f;
#pragma unroll
            for (int j = 0; j < 4; ++j) ss += (v[s2][j][0] * v[s2][j][0] + v[s2][j][1] * v[s2][j][1]) + (v[s2][j][2] * v[s2][j][2] + v[s2][j][3] * v[s2][j][3]);
            rr[s2] = rsqrtf(wave_sum(ss) * (1.0f / D) + EPS); }
        f32x2 lg[2][4];
        f32x4 hh[2][4];
#pragma unroll
        for (int s2 = 0; s2 < 2; ++s2)
#pragma unroll
            for (int q = 0; q < 4; ++q) lg[s2][q] = (f32x2){0.f, 0.f};
#pragma unroll
        for (int j = 0; j < 4; ++j) { const int c = 4 * ln + 256 * j; const f32x4 w = wq[j];
#pragma unroll
            for (int s2 = 0; s2 < 2; ++s2) { const f32x4 s1 = s1q[s2][j], s0 = s0q[s2][j];
#pragma unroll
                for (int q = 0; q < 4; ++q) hh[s2][j][q] = v[s2][j][q] * rr[s2] * w[q] * (1.0f + s1[q]) + s0[q];
                { u32x2 o; o.x = cvt_pk_bf16(hh[s2][j][0], hh[s2][j][1]); o.y = cvt_pk_bf16(hh[s2][j][2], hh[s2][j][3]); *(u32x2*)(H + (size_t)rws[s2] * D + c) = o; } }
#pragma unroll
            for (int z = 0; z < 4; ++z) { const f32x4 w4 = *(const LAS f32x4*)(wl + z * 1024 + c); const f32x2 wa2 = {w4[0], w4[1]}, wb2 = {w4[2], w4[3]};
                lg[0][z] += (f32x2){hh[0][j][0], hh[0][j][1]} * wa2; lg[0][z] += (f32x2){hh[0][j][2], hh[0][j][3]} * wb2; lg[1][z] += (f32x2){hh[1][j][0], hh[1][j][1]} * wa2; lg[1][z] += (f32x2){hh[1][j][2], hh[1][j][3]} * wb2; }
            asm volatile("" ::: "memory"); }
#define N2_ROUTE(s2) if (act[s2]) { \
            const int rw = rws[s2]; \
            const float ug = wave_sum4(lg[s2][0][0] + lg[s2][0][1], lg[s2][1][0] + lg[s2][1][1], lg[s2][2][0] + lg[s2][2][1], lg[s2][3][0] + lg[s2][3][1]); \
            float g0 = lane_val(ug, 0) + lane_val(brgl, 0), g1 = lane_val(ug, 32) + lane_val(brgl, 1), g2 = lane_val(ug, 16) + lane_val(brgl, 2), g3 = lane_val(ug, 48) + lane_val(brgl, 3); \
            int gi = 0; float gm = g0; if (g1 > gm) { gm = g1; gi = 1; } if (g2 > gm) { gm = g2; gi = 2; } if (g3 > gm) { gm = g3; gi = 3; } \
            const float gtop = 1.0f / (expf(g0 - gm) + expf(g1 - gm) + expf(g2 - gm) + expf(g3 - gm)); \
            gi = __builtin_amdgcn_readfirstlane(gi); \
              \
            f32x2 le[4]; \
            _Pragma("unroll") for (int i = 0; i < 4; ++i) le[i] = (f32x2){0.f, 0.f}; \
            { const LAS float* we = wl + (4 + 4 * gi) * 1024 + 4 * ln; \
              _Pragma("unroll") for (int j = 0; j < 4; ++j) \
                _Pragma("unroll") for (int i = 0; i < 4; ++i) { const f32x4 w4 = *(const LAS f32x4*)(we + i * 1024 + 256 * j); \
                    le[i] += (f32x2){hh[s2][j][0], hh[s2][j][1]} * (f32x2){w4[0], w4[1]}; le[i] += (f32x2){hh[s2][j][2], hh[s2][j][3]} * (f32x2){w4[2], w4[3]}; } } \
            const float ue = wave_sum4(le[0][0] + le[0][1], le[1][0] + le[1][1], le[2][0] + le[2][1], le[3][0] + le[3][1]); \
            float e[4]; e[0] = lane_val(ue, 0) + lane_val(brel, 4 * gi); e[1] = lane_val(ue, 32) + lane_val(brel, 4 * gi + 1); e[2] = lane_val(ue, 16) + lane_val(brel, 4 * gi + 2); e[3] = lane_val(ue, 48) + lane_val(brel, 4 * gi + 3); \
            int ia = 0; float va = e[0]; if (e[1] > va) { va = e[1]; ia = 1; } if (e[2] > va) { va = e[2]; ia = 2; } if (e[3] > va) { va = e[3]; ia = 3; } \
            int ib = -1; float vb = -3.0e38f; \
            _Pragma("unroll") \
            for (int i = 0; i < 4; ++i) if (i != ia && e[i] > vb) { vb = e[i]; ib = i; } \
            const float wa = 1.0f / (1.0f + expf(vb - va)), wb = 1.0f - wa; \
            if (lane == 0 && !dry) { const int e0 = gi * 4 + ia, e1 = gi * 4 + ib; const int li = rw - row0; re[li] = e0; re[160 + li] = e1; \
                ROUTEC[(size_t)rw * 2] = wa * gtop; ROUTEC[(size_t)rw * 2 + 1] = wb * gtop; \
                __hip_atomic_fetch_add(lcnt + e0, 1, __ATOMIC_RELAXED, __HIP_MEMORY_SCOPE_WORKGROUP); __hip_atomic_fetch_add(lcnt + e1, 1, __ATOMIC_RELAXED, __HIP_MEMORY_SCOPE_WORKGROUP); } \
        }
        N2_ROUTE(0) N2_ROUTE(1)
#undef N2_ROUTE
    }
#undef N2_PRELOAD_XP
#undef N2_PRELOAD_G
    __syncthreads();
    if (dry) return;
    if (tid < 16) { lcnt[16 + tid] = (int)__hip_atomic_fetch_add(gcnt + tid, (unsigned)lcnt[tid], __ATOMIC_RELAXED, __HIP_MEMORY_SCOPE_AGENT); }
    __syncthreads();
    const int nr = row1 - row0;
    if (tid < 2 * nr && re[(tid & 1) * 160 + (tid >> 1)] >= 0) { const int li = tid >> 1, rk = tid & 1; const int e = re[rk * 160 + li];
        const int p = lcnt[16 + e] + __hip_atomic_fetch_add(lcnt + 32 + e, 1, __ATOMIC_RELAXED, __HIP_MEMORY_SCOPE_WORKGROUP);
        LIST[(size_t)e * T + p] = ((row0 + li) << 1) | rk; }
    __syncthreads();
}

__device__ __forceinline__ void phase_final(const DArgs& a, int wid, int lane, float poison) {
    const int gw = blockIdx.x * 8 + wid, NGW = gridDim.x * 8;
    const float* MOD = (const float*)(a.ws + WS_MOD);
    const float* nw = a.in[I_FINALNORM];
    const int* SLOTOF = (const int*)(a.ws + WS_SLOTOF); const float* ROUTEC = (const float*)(a.ws + WS_ROUTEC); const bf16_t* YS = (const bf16_t*)(a.ws + WS_YS);
    int sl0 = 0, sl1 = 0; float cw0 = 0.f, cw1 = 0.f;
#define FN_ROW(q_) (((q_) / SEQ) * TPB + CL + ((q_) % SEQ))
    f32x4 nwv[4];
#pragma unroll
    for (int j = 0; j < 4; ++j) nwv[j] = *(const f32x4*)(nw + 4 * lane + 256 * j);
    if (gw < NB * SEQ) { const int r0 = FN_ROW(gw); sl0 = SLOTOF[2 * (size_t)r0]; sl1 = SLOTOF[2 * (size_t)r0 + 1]; cw0 = ROUTEC[2 * (size_t)r0]; cw1 = ROUTEC[2 * (size_t)r0 + 1]; }
    for (int lr = gw; lr < NB * SEQ; lr += NGW) {
        const int b = lr / SEQ, row = b * TPB + CL + (lr - b * SEQ);
        const bf16_t* xp = xrow_ptr(a, row); float* op = a.out + (size_t)lr * D;
        const float* gt2 = MOD + ((size_t)(DEPTH - 1) * 17 + b) * NMOD + 5 * D; const float* gt1 = gt2 - 3 * D;
        const bf16_t* y0 = YS + (size_t)sl0 * D; const bf16_t* y1 = YS + (size_t)sl1 * D; const bf16_t* ya = (const bf16_t*)(a.ws + WS_YATT) + (size_t)row * D;
        const float c0 = cw0, c1 = cw1;
        if (lr + NGW < NB * SEQ) { const int rn = FN_ROW(lr + NGW); sl0 = SLOTOF[2 * (size_t)rn]; sl1 = SLOTOF[2 * (size_t)rn + 1]; cw0 = ROUTEC[2 * (size_t)rn]; cw1 = ROUTEC[2 * (size_t)rn + 1]; }
        f32x4 v[4]; float ss = 0.f;
#pragma unroll
        for (int j = 0; j < 4; ++j) { const int c = 4 * lane + 256 * j; const u32x2 xb = *(const u32x2*)(xp + c); f32x4 x = {bf_lo(xb.x), bf_hi(xb.x), bf_lo(xb.y), bf_hi(xb.y)}; const f32x4 g = *(const f32x4*)(gt2 + c), g1 = *(const f32x4*)(gt1 + c);
            const u32x2 p0 = *(const u32x2*)(y0 + c), p1 = *(const u32x2*)(y1 + c), pa = *(const u32x2*)(ya + c);
            x[0] += g1[0] * bf_lo(pa.x); x[1] += g1[1] * bf_hi(pa.x); x[2] += g1[2] * bf_lo(pa.y); x[3] += g1[3] * bf_hi(pa.y);
            v[j][0] = x[0] + g[0] * (c0 * bf_lo(p0.x) + c1 * bf_lo(p1.x)); v[j][1] = x[1] + g[1] * (c0 * bf_hi(p0.x) + c1 * bf_hi(p1.x));
            v[j][2] = x[2] + g[2] * (c0 * bf_lo(p0.y) + c1 * bf_lo(p1.y)); v[j][3] = x[3] + g[3] * (c0 * bf_hi(p0.y) + c1 * bf_hi(p1.y));
            ss += (v[j][0] * v[j][0] + v[j][1] * v[j][1]) + (v[j][2] * v[j][2] + v[j][3] * v[j][3]); }
        const float rr = rsqrtf(wave_sum(ss) * (1.0f / D) + EPS);
#pragma unroll
        for (int j = 0; j < 4; ++j) { const int c = 4 * lane + 256 * j; const f32x4 w = nwv[j];
            f32x4 o; for (int q = 0; q < 4; ++q) o[q] = poison != 0.f ? poison : v[j][q] * rr * w[q];
            *(f32x4*)(op + c) = o; }
    }
}

struct SchedInproj {
    const char* H; const char* W; int G, w, nA, skip;
    __device__ __forceinline__ bool next(int i, Unit& u) const {
        int L; if (i < 4) L = i * G + w; else { if (w < nA) return false; L = 4 * G + (i - 4) * (G - nA) + (w - nA); }
        const int nMn = skip ? 32 : 36;
        if (L < nMn * 28) { int pm, pi; pg8::tile_map(L, nMn, 28, pm, pi); if (skip) pm = (pm >> 3) * 9 + 1 + (pm & 7); const int wt = pi < 4 ? pi : pi + 4;
            u.a = H + (size_t)pm * 256 * 2048; u.b = W + (size_t)wt * 256 * 2048; u.pm = pm; u.pn = wt; u.kind = 0; u.nt = 16; u.cont = 0; return true; }
        L -= nMn * 28;
        if (L < 6 * 36) { int pi, pn; pg8::tile_map(L, 6, 36, pi, pn); const int wt = pi + 2;
            u.a = W + (size_t)wt * 256 * 2048; u.b = H + (size_t)pn * 256 * 2048; u.pm = wt; u.pn = pn; u.kind = 1; u.nt = 16; u.cont = 0; return true; }
        return false;
    }
};
struct EpiInproj {
    static constexpr bool PERM = true;
    unsigned char* ws; const float* lg2;
    const float* ropec; const float* ropes; bf16_t* gate;
    template <int ACT> __device__ __forceinline__ void plain(const f32x4 (&acc)[2][2][4][2], bf16_t* dst, int ld, int row0, int col0) const {
#pragma unroll
        for (int ai = 0; ai < 2; ++ai)
#pragma unroll
            for (int m = 0; m < 4; ++m) { bf16_t* rowp = dst + (size_t)(row0 + ai * 128 + m * 16) * ld + col0;
#pragma unroll
                for (int bj = 0; bj < 2; ++bj) { f32x4 v0 = acc[ai][bj][m][0], v1 = acc[ai][bj][m][1];
                    if (ACT == 1) { for (int q = 0; q < 4; ++q) { v0[q] = silu_f(v0[q]); v1[q] = silu_f(v1[q]); } }
                    if (ACT == 2) { for (int q = 0; q < 4; ++q) { v0[q] = sigmoid_f(v0[q]); v1[q] = sigmoid_f(v1[q]); } }
                    *(u32x4*)(rowp + bj * 128) = pack8(v0, v1); } }
    }
    __device__ __forceinline__ void operator()(const f32x4 (&acc)[2][2][4][2], const Unit& u, int wr, int wc, int fr, int fq) const {
        if (u.kind == 0) {
            const int wt = u.pn, row0 = u.pm * 256 + wr * 64 + fr, cl = wc * 32 + 8 * fq;
            if (wt < 4) {
                const int isk = wt >> 1, t = wt & 1, head = 2 * t + (wc >> 1), idx0 = 32 * (wc & 1) + 8 * fq;
                bf16_t* dA = (bf16_t*)(ws + (isk ? WS_KF : WS_QF));
#pragma unroll
                for (int ai = 0; ai < 2; ++ai) {
                    f32x4 rc0[4], rc1[4], rs0[4], rs1[4];
#pragma unroll
                    for (int m = 0; m < 4; ++m) { const int r = (row0 + ai * 128 + m * 16) % TPB, pos = r >= CL ? r - CL : 0, v = (wc & 1) ? (pos & 63) : (pos >> 6);
                        const float* cp = ropec + v * 32 + 8 * fq; const float* sp = ropes + v * 32 + 8 * fq;
                        rc0[m] = *(const f32x4*)cp; rc1[m] = *(const f32x4*)(cp + 4); rs0[m] = *(const f32x4*)sp; rs1[m] = *(const f32x4*)(sp + 4); }
#pragma unroll
                    for (int m = 0; m < 4; ++m) {
                        const int gr = row0 + ai * 128 + m * 16, r = gr % TPB;
                        f32x4 c0 = rc0[m], c1 = rc1[m], s0 = rs0[m], s1 = rs1[m];
                        if (r < CL) { c0 = (f32x4){1.f, 1.f, 1.f, 1.f}; c1 = c0; s0 = (f32x4){0.f, 0.f, 0.f, 0.f}; s1 = s0; }
                        const f32x4 x10 = acc[ai][0][m][0], x11 = acc[ai][0][m][1], x20 = acc[ai][1][m][0], x21 = acc[ai][1][m][1];
                        const f32x4 o10 = x10 * c0 - x20 * s0, o11 = x11 * c1 - x21 * s1, o20 = x10 * s0 + x20 * c0, o21 = x11 * s1 + x21 * c1;
                        bf16_t* pa = dA + (size_t)gr * 512 + head * 128 + idx0;
                        *(u32x4*)pa = pack8(o10, o11); *(u32x4*)(pa + 64) = pack8(o20, o21);
                    } }
            } else if (wt < 12) plain<1>(acc, (bf16_t*)(ws + WS_GS), 1024, row0, (wt - 8) * 256 + cl);
            else if (wt < 14) plain<0>(acc, (bf16_t*)(ws + WS_CB), 512, row0, (wt - 12) * 256 + cl);
            else if (wt < 18) { bf16_t* dst = (bf16_t*)(ws + WS_CU);
#pragma unroll
                for (int ai = 0; ai < 2; ++ai)
#pragma unroll
                    for (int m = 0; m < 4; ++m)
                        *(u32x4*)(dst + (size_t)(row0 + ai * 128 + m * 16) * 512 + (wt - 14) * 128 + cl) = pack8(acc[ai][0][m][0] * acc[ai][1][m][0], acc[ai][0][m][1] * acc[ai][1][m][1]);
            } else if (wt < 20) plain<0>(acc, (bf16_t*)(ws + WS_PI), 512, row0, (wt - 18) * 256 + cl);
            else {
                unsigned char* gp = (unsigned char*)gate + (size_t)((wt - 20) >> 2) * TG * 1024 + ((wt - 20) & 3) * 256 + (wc * 4 + fq) * 16;
#pragma unroll
                for (int ai = 0; ai < 2; ++ai)
#pragma unroll
                    for (int m = 0; m < 4; ++m) { u32x4 w;
#pragma unroll
                        for (int bj = 0; bj < 2; ++bj) { unsigned lo = 0u, hi = 0u;
#pragma unroll
                            for (int q = 0; q < 4; ++q) { lo |= (unsigned)fmaxf(sigmoid_f(acc[ai][bj][m][0][q]) * 255.0f + 0.5f, 1.0f) << (8 * q); hi |= (unsigned)fmaxf(sigmoid_f(acc[ai][bj][m][1][q]) * 255.0f + 0.5f, 1.0f) << (8 * q); }
                            if (bj == 0) { w.x = lo; w.y = hi; } else { w.z = lo; w.w = hi; } }
                        *(u32x4*)(gp + (size_t)(row0 + ai * 128 + m * 16) * 1024) = w; }
            }
        } else {
            const int wt = u.pm, tok0 = u.pn * 256 + wc * 32 + 8 * fq;
            if (wt < 4) {
                const int t = wt - 2, head = 2 * t + wr; const float lgf = lg2[head], lgb = lg2[4 + head];
                bf16_t* dF = (bf16_t*)(ws + WS_KTF); bf16_t* dB = (bf16_t*)(ws + WS_KTB);
                f32x4 sF[2][2], sB[2][2]; int posv[2][2]; bool isl[2][2];
#pragma unroll
                for (int bj = 0; bj < 2; ++bj)
#pragma unroll
                    for (int n = 0; n < 2; ++n) { const int g0 = tok0 + bj * 128 + 4 * n, r0 = g0 % TPB; isl[bj][n] = r0 >= CL; posv[bj][n] = r0 >= CL ? r0 - CL : 0;
#pragma unroll
                        for (int j = 0; j < 4; ++j) { const float fi = (float)((g0 + j) & 127); sF[bj][n][j] = __builtin_amdgcn_exp2f(-fi * lgf); sB[bj][n][j] = __builtin_amdgcn_exp2f(fi * lgb); } }
#pragma unroll
                for (int m = 0; m < 4; ++m) { const int idx = 16 * m + fr;
                    f32x4 cs[2][2], sn[2][2];
#pragma unroll
                    for (int bj = 0; bj < 2; ++bj)
#pragma unroll
                        for (int n = 0; n < 2; ++n) { const int pos = posv[bj][n];
                            if (m < 2) { const float c = ropec[(pos >> 6) * 32 + idx], sv = ropes[(pos >> 6) * 32 + idx]; cs[bj][n] = (f32x4){c, c, c, c}; sn[bj][n] = (f32x4){sv, sv, sv, sv}; }
                            else { const int v = pos & 63;
#pragma unroll
                                for (int j = 0; j < 4; ++j) { cs[bj][n][j] = ropec[(v + j) * 32 + idx - 32]; sn[bj][n][j] = ropes[(v + j) * 32 + idx - 32]; } } }
#pragma unroll
                    for (int bj = 0; bj < 2; ++bj) { f32x4 o1[2], o2[2];
#pragma unroll
                        for (int n = 0; n < 2; ++n) { const f32x4 x1 = acc[0][bj][m][n], x2 = acc[1][bj][m][n]; f32x4 c4 = cs[bj][n], s4 = sn[bj][n];
                            if (!isl[bj][n]) { c4 = (f32x4){1.f, 1.f, 1.f, 1.f}; s4 = (f32x4){0.f, 0.f, 0.f, 0.f}; }
                            o1[n] = x1 * c4 - x2 * s4; o2[n] = x1 * s4 + x2 * c4; }
                        const size_t r1 = (size_t)(head * 128 + idx) * TG + tok0 + bj * 128, r2 = r1 + (size_t)64 * TG;
                        *(u32x4*)(dF + r1) = pack8(o1[0] * sF[bj][0], o1[1] * sF[bj][1]); *(u32x4*)(dF + r2) = pack8(o2[0] * sF[bj][0], o2[1] * sF[bj][1]);
                        *(u32x4*)(dB + r1) = pack8(o1[0] * sB[bj][0], o1[1] * sB[bj][1]); *(u32x4*)(dB + r2) = pack8(o2[0] * sB[bj][0], o2[1] * sB[bj][1]);
                    } }
            } else {
                bf16_t* dst = (bf16_t*)(ws + WS_VT); const int e0 = (wt - 4) * 256 + wr * 64 + fr;
#pragma unroll
                for (int ai = 0; ai < 2; ++ai)
#pragma unroll
                    for (int m = 0; m < 4; ++m)
#pragma unroll
                        for (int bj = 0; bj < 2; ++bj) *(u32x4*)(dst + (size_t)(e0 + ai * 128 + m * 16) * TG + tok0 + bj * 128) = pack8(acc[ai][bj][m][0], acc[ai][bj][m][1]);
            }
        }
    }
};

struct SchedPlain {
    const char* A; const char* B; size_t astep, bstep; int nM, nN, G, c, skip;
    __device__ __forceinline__ bool next(int i, Unit& u) const {
        const int L = i * G + c; if (L >= nM * nN) return false;
        int pm, pn; pg8::tile_map(L, nM, nN, pm, pn); if (skip) pm = (pm >> 3) * 9 + 1 + (pm & 7);
        u.a = A + (size_t)pm * astep; u.b = B + (size_t)pn * bstep; u.pm = pm; u.pn = pn; u.kind = 0; u.nt = 0; u.cont = 0; return true;
    }
};
struct SchedG4 {
    const char* YRET; const char* YCP; const char* WRET; const char* WCP; int nM, G, c, skip;
    __device__ __forceinline__ bool next(int i, Unit& u) const {
        const int mac = i / 3, sub = i - mac * 3, L = mac * G + c; if (L >= nM * 4) return false;
        int pm, pn; pg8::tile_map(L, nM, 4, pm, pn); if (skip) pm = (pm >> 3) * 9 + 1 + (pm & 7);
        const size_t ao = (size_t)pm * 256 * 2048, bo = (size_t)pn * 256 * 2048;
        u.a = sub == 0 ? YRET + ao : YCP + ao + (sub == 2 ? 1024 : 0); u.b = sub == 0 ? WRET + bo : WCP + bo + (sub == 2 ? 1024 : 0);
        u.pm = pm; u.pn = pn; u.kind = sub; u.nt = sub == 0 ? 16 : 8; u.cont = sub != 2; return true;
    }
};
struct EpiG4 {
    static constexpr bool PERM = true;
    const unsigned char* gate;    bf16_t* merged;
    __device__ __forceinline__ void operator()(f32x4 (&acc)[2][2][4][2], const Unit& u, int wr, int wc, int fr, int fq) const {
        const int row0 = u.pm * 256 + wr * 64 + fr, col0 = u.pn * 256 + wc * 32 + 8 * fq, k = u.kind;
        const unsigned char* gk = gate + (size_t)k * TG * 1024 + u.pn * 256 + (wc * 4 + fq) * 16;
        const unsigned char* hk = gk + (k < 2 ? (size_t)TG * 1024 : (size_t)0);
        if (k < 2) {
            u32x4 gg[8], hh[8];
#pragma unroll
            for (int i = 0; i < 8; ++i) { const size_t ro = (size_t)(row0 + (i >> 2) * 128 + (i & 3) * 16) * 1024; gg[i] = *(const u32x4*)(gk + ro); hh[i] = *(const u32x4*)(hk + ro); }
#pragma unroll
            for (int ai = 0; ai < 2; ++ai)
#pragma unroll
                for (int m = 0; m < 4; ++m) { const u32x4 g = gg[ai * 4 + m], h = hh[ai * 4 + m];
#pragma unroll
                    for (int bj = 0; bj < 2; ++bj) { const unsigned g0 = bj ? g.z : g.x, g1 = bj ? g.w : g.y, h0 = bj ? h.z : h.x, h1 = bj ? h.w : h.y;
#pragma unroll
                        for (int q = 0; q < 4; ++q) {
                            const float n0 = (float)((g0 >> (8 * q)) & 255u), n1 = (float)((g1 >> (8 * q)) & 255u);
                            const float d0 = (float)((h0 >> (8 * q)) & 255u), d1 = (float)((h1 >> (8 * q)) & 255u);
                            acc[ai][bj][m][0][q] *= n0 * __builtin_amdgcn_rcpf(d0); acc[ai][bj][m][1][q] *= n1 * __builtin_amdgcn_rcpf(d1); } } }
        } else {
            u32x4 gg[8];
#pragma unroll
            for (int i = 0; i < 8; ++i) gg[i] = *(const u32x4*)(gk + (size_t)(row0 + (i >> 2) * 128 + (i & 3) * 16) * 1024);
#pragma unroll
            for (int ai = 0; ai < 2; ++ai)
#pragma unroll
                for (int m = 0; m < 4; ++m) { const int row = row0 + ai * 128 + m * 16; const u32x4 g = gg[ai * 4 + m];
#pragma unroll
                    for (int bj = 0; bj < 2; ++bj) { const int col = col0 + bj * 128; const unsigned g0 = bj ? g.z : g.x, g1 = bj ? g.w : g.y;
                        f32x4 v0 = acc[ai][bj][m][0], v1 = acc[ai][bj][m][1];
#pragma unroll
                        for (int q = 0; q < 4; ++q) { v0[q] *= (float)((g0 >> (8 * q)) & 255u) * (1.0f / 255.0f); v1[q] *= (float)((g1 >> (8 * q)) & 255u) * (1.0f / 255.0f); }
                        *(u32x4*)(merged + (size_t)row * 1024 + col) = pack8(v0, v1); } }
        }
    }
};
struct EpiPlainBf16 {
    static constexpr bool PERM = true;
    bf16_t* O; int ld;
    __device__ __forceinline__ void operator()(const f32x4 (&acc)[2][2][4][2], const Unit& u, int wr, int wc, int fr, int fq) const {
        const int row0 = u.pm * 256 + wr * 64 + fr, col0 = u.pn * 256 + wc * 32 + 8 * fq;
#pragma unroll
        for (int ai = 0; ai < 2; ++ai)
#pragma unroll
            for (int m = 0; m < 4; ++m)
#pragma unroll
                for (int bj = 0; bj < 2; ++bj) *(u32x4*)(O + (size_t)(row0 + ai * 128 + m * 16) * ld + col0 + bj * 128) = pack8(acc[ai][bj][m][0], acc[ai][bj][m][1]);
    }
};

struct SchedMoe {
    const char* A; const char* W; size_t astep, wrow; const LAS int* tile_e; int ntiles, G, c;
    __device__ __forceinline__ bool next(int i, Unit& u) const {
        const int L = i * G + c; if (L >= ntiles * 4) return false;
        int tile, pn; pg8::tile_map(L, ntiles, 4, tile, pn); const int e = tile_e[tile];
        u.a = A + (size_t)tile * astep; u.b = W + ((size_t)e * 1024 + pn * 256) * wrow; u.pm = tile; u.pn = pn; u.kind = e; u.nt = 0; u.cont = 0; return true;
    }
};
struct SchedMoeG {
    const char* A; const char* W; const LAS int* tile_e; const LAS int* cnt; const LAS int* poff; const int* LIST; LAS int* tbl; int ntiles, G, c;
    __device__ __forceinline__ bool next(int i, Unit& u) const {
        const int L = i * G + c; if (L >= ntiles * 4) return false;
        int tile, pn; pg8::tile_map(L, ntiles, 4, tile, pn); const int e = tile_e[tile];
        u.a = A; u.b = W + ((size_t)e * 1024 + pn * 256) * 2048; u.pm = tile; u.pn = pn; u.kind = e; u.nt = 0; u.cont = 0; return true;
    }
    __device__ __forceinline__ void fill_table(const Unit& u, int buf, int tid) const {
        if (tid < 256) { const int e = u.kind; const int* src = LIST + (size_t)e * T + (u.pm * 256 - poff[e]) + tid;
            __builtin_amdgcn_global_load_lds((const unsigned*)src, (LAS unsigned*)(tbl + buf * 256 + (tid & ~63)), 4, 0, 0); }
    }
    __device__ __forceinline__ void load_offsets(const Unit& u, int buf, const int (&gR)[2], const int (&gC2)[2], unsigned (&vo0)[2], unsigned (&vo1)[2]) const {
        const int e = u.kind, pb = u.pm * 256 - poff[e], n = cnt[e];
#pragma unroll
        for (int i = 0; i < 2; ++i) { const int r0 = gR[i], r1 = 128 + gR[i]; const int e0 = tbl[buf * 256 + r0], e1 = tbl[buf * 256 + r1];
            vo0[i] = (unsigned)((pb + r0 < n) ? (e0 >> 1) : 0) * 2048u + (unsigned)gC2[i]; vo1[i] = (unsigned)((pb + r1 < n) ? (e1 >> 1) : 0) * 2048u + (unsigned)gC2[i]; }
    }
};
namespace pg8 { template <> struct sched_gather<SchedMoeG> { static constexpr bool value = true; }; }
struct EpiMoeUp {
    static constexpr bool PERM = true;
    bf16_t* ACT;
    __device__ __forceinline__ void operator()(const f32x4 (&acc)[2][2][4][2], const Unit& u, int wr, int wc, int fr, int fq) const {
        const int row0 = u.pm * 256 + wr * 64 + fr, col0 = u.pn * 128 + wc * 32 + 8 * fq;
#pragma unroll
        for (int ai = 0; ai < 2; ++ai)
#pragma unroll
            for (int m = 0; m < 4; ++m) { f32x4 v0, v1;
#pragma unroll
                for (int q = 0; q < 4; ++q) { v0[q] = silu_fast(acc[ai][0][m][0][q]) * acc[ai][1][m][0][q]; v1[q] = silu_fast(acc[ai][0][m][1][q]) * acc[ai][1][m][1][q]; }
                *(u32x4*)(ACT + (size_t)(row0 + ai * 128 + m * 16) * 512 + col0) = pack8(v0, v1); }
    }
};

template <int NROWS, bool PERMROWS>
__device__ __forceinline__ void dma_tile(LAS unsigned char* ldst, const char* gsrc, size_t row_stride, int tid) {
#pragma unroll
    for (int i = 0; i < NROWS * 16 / 512; ++i) {
        const int q = tid + 512 * i, row = q >> 4, cg = q & 15;
        const int srow = PERMROWS ? ((row & ~31) + pg8::perm32(row & 31)) : row;
        const char* src = gsrc + (size_t)srow * row_stride + ((cg ^ (row & 15)) << 4);
        __builtin_amdgcn_global_load_lds((const unsigned*)src, (LAS unsigned*)(ldst + ((tid & ~63) + 512 * i) * 16), 16, 0, 0);
    }
}
__device__ __forceinline__ bf16x8 lds_frag(const LAS unsigned char* base, int row, int gk) { return *(const LAS bf16x8*)(base + row * 256 + ((gk ^ (row & 15)) << 4)); }

#ifndef CP_DEFER_PCT
#define CP_DEFER_PCT 38
#endif
#ifndef CP_DEFER_PCT_LAST
#define CP_DEFER_PCT_LAST 10
#endif
constexpr int CP_TOTAL = TG * 16 + TG * 16;
constexpr int CP_DEFER_A = (CP_TOTAL / 100 * CP_DEFER_PCT) / 512 * 512, CP_DEFER_B = (CP_TOTAL / 100 * CP_DEFER_PCT_LAST) / 512 * 512;
#define CP_DEFER (skipctx ? CP_DEFER_B : CP_DEFER_A)
constexpr int NCHAIN = BG * 4 * 2 * 4;
template <int NROWS>
__device__ __forceinline__ void dma_tile128(LAS unsigned char* ldst, const char* gsrc, size_t row_stride, int tid) {
#pragma unroll
    for (int i = 0; i < NROWS * 8 / 512; ++i) {
        const int q = tid + 512 * i, row = q >> 3, cg = q & 7;
        const char* src = gsrc + (size_t)row * row_stride + ((cg ^ ((row >> 1) & 7)) << 4);
        __builtin_amdgcn_global_load_lds((const unsigned*)src, (LAS unsigned*)(ldst + ((tid & ~63) + 512 * i) * 16), 16, 0, 0);
    }
}
__device__ __forceinline__ bf16x8 lds_frag128(const LAS unsigned char* base, int row, int gk) { return *(const LAS bf16x8*)(base + row * 128 + ((gk ^ ((row >> 1) & 7)) << 4)); }

__device__ __forceinline__ void chain_unit(const DArgs& a, int unit, const float* lg2p, LAS unsigned char* lds, int tid, int wid, int lane) {
    const int eq = unit & 3, dir = (unit >> 2) & 1, h = (unit >> 3) & 3, bb = unit >> 5, fr = lane & 15, fq = lane >> 4;
    const char* VT = (const char*)(a.ws + WS_VT) + (size_t)(h * 256 + eq * 64) * TG * 2;
    const char* KT = (const char*)(a.ws + (dir ? WS_KTB : WS_KTF)) + (size_t)(h * 128) * TG * 2;
    bf16_t* ST = (bf16_t*)(a.ws + WS_STATES) + ((size_t)((bb * 4 + h) * 2 + dir) * NCH) * 256 * 128;
    const float dec = exp2f(128.0f * lg2p[dir * 4 + h]);
    f32x4 acc[4];
#pragma unroll
    for (int m = 0; m < 4; ++m) acc[m] = (f32x4){0.f, 0.f, 0.f, 0.f};
#define CH_ORDER(s) (dir == 0 ? (s) : ((s) < 2 ? 1 - (s) : 19 - (s)))
#define CH_LOAD(hs) do { const int _h = (hs) < 2 * NCH ? (hs) : 2 * NCH - 1; const int _c = CH_ORDER(_h >> 1); const size_t _tb = (size_t)(bb * TPB + _c * 128 + (_h & 1) * 64) * 2; \
        LAS unsigned char* _sl = lds + ((hs) % 5) * 24576; dma_tile128<64>(_sl, VT + _tb, (size_t)TG * 2, tid); dma_tile128<128>(_sl + 8192, KT + _tb, (size_t)TG * 2, tid); } while (0)
#define CH_MMA(hs) do { const LAS unsigned char* buf = lds + ((hs) % 5) * 24576; bf16x8 kf_[2], vf_[2][4];     \
        _Pragma("unroll") for (int ks = 0; ks < 2; ++ks) { kf_[ks] = lds_frag128(buf + 8192, wid * 16 + fr, 4 * ks + fq); \
            _Pragma("unroll") for (int m = 0; m < 4; ++m) vf_[ks][m] = lds_frag128(buf, 16 * m + fr, 4 * ks + fq); } \
        LDS_WAIT(); __builtin_amdgcn_sched_barrier(0); \
        _Pragma("unroll") for (int ks = 0; ks < 2; ++ks) \
            _Pragma("unroll") for (int m = 0; m < 4; ++m) acc[m] = __builtin_amdgcn_mfma_f32_16x16x32_bf16(kf_[ks], vf_[ks][m], acc[m], 0, 0, 0); } while (0)
#define CH_SYNC() do { asm volatile("s_waitcnt vmcnt(11)" ::: "memory"); LDS_WAIT(); __builtin_amdgcn_s_barrier(); asm volatile("" ::: "memory"); } while (0)
    CH_LOAD(0); CH_LOAD(1); CH_LOAD(2); CH_LOAD(3);
    asm volatile("s_waitcnt vmcnt(9)" ::: "memory"); LDS_WAIT(); __builtin_amdgcn_s_barrier(); asm volatile("" ::: "memory");
    for (int s = 0; s < NCH; ++s) {
        const int hs = 2 * s;
        if (s > 0) CH_SYNC();
        u32x2 pub[4];
#pragma unroll
        for (int m = 0; m < 4; ++m) { acc[m] = acc[m] * dec; pub[m].x = cvt_pk_bf16(acc[m][0], acc[m][1]); pub[m].y = cvt_pk_bf16(acc[m][2], acc[m][3]); }
        CH_LOAD(hs + 4);
        CH_MMA(hs);
        {
            const int _c = CH_ORDER(s); bf16_t* sp = ST + (size_t)_c * 256 * 128 + (size_t)(eq * 64 + 16 * (fq & 1) + fr) * 128 + wid * 16 + 8 * (fq >> 1);
#pragma unroll
            for (int mp = 0; mp < 2; ++mp) { unsigned ax = pub[2 * mp].x, ay = pub[2 * mp].y, bx = pub[2 * mp + 1].x, by = pub[2 * mp + 1].y;
                asm volatile("s_nop 1\n\tv_permlane16_swap_b32 %0, %1\n\tv_permlane16_swap_b32 %2, %3\n\ts_nop 1" : "+v"(ax), "+v"(bx), "+v"(ay), "+v"(by));
                const u32x4 w = {ax, ay, bx, by}; *(u32x4*)(sp + (size_t)mp * 32 * 128) = w; }
        }
        CH_SYNC();
        CH_MMA(hs + 1);
        CH_LOAD(hs + 5);
    }
    asm volatile("s_waitcnt vmcnt(0)" ::: "memory"); LDS_WAIT(); __builtin_amdgcn_s_barrier(); asm volatile("" ::: "memory");
#undef CH_ORDER
#undef CH_LOAD
#undef CH_MMA
#undef CH_SYNC
}
template <int WIN>
__device__ __forceinline__ void pool_quad(const bf16_t* prow, const int tl0, const int n, bf16_t* dst) {
    constexpr int HW = WIN / 2, K = WIN + 3;
    u32x4 p[K];
#pragma unroll
    for (int k = 0; k < K; ++k) { const int sidx = tl0 - HW + k; const int sc = sidx < 0 ? 0 : (sidx >= n ? n - 1 : sidx); p[k] = *(const u32x4*)(prow + (size_t)sc * 512); }
    f32x4 s0[4], s1[4];
#pragma unroll
    for (int j = 0; j < 4; ++j) { s0[j] = (f32x4){0.f, 0.f, 0.f, 0.f}; s1[j] = s0[j]; }
#pragma unroll
    for (int k = 0; k < K; ++k) { const int sidx = tl0 - HW + k; const bool ok = sidx >= 0 && sidx < n; const u32x4 q = p[k];
        const f32x4 f0 = {ok ? bf_lo(q.x) : 0.f, ok ? bf_hi(q.x) : 0.f, ok ? bf_lo(q.y) : 0.f, ok ? bf_hi(q.y) : 0.f}, f1 = {ok ? bf_lo(q.z) : 0.f, ok ? bf_hi(q.z) : 0.f, ok ? bf_lo(q.w) : 0.f, ok ? bf_hi(q.w) : 0.f};
#pragma unroll
        for (int j = 0; j < 4; ++j) if (k >= j && k - j < WIN) { s0[j] += f0; s1[j] += f1; } }
#pragma unroll
    for (int j = 0; j < 4; ++j) { const int tl = tl0 + j; int sa = tl - HW; if (sa < 0) sa = 0; int sb = tl + WIN - HW; if (sb > n) sb = n;
        const float inv = __builtin_amdgcn_rcpf((float)(sb - sa)); const u32x4 c = p[HW + j]; f32x4 o0, o1;
        o0[0] = s0[j][0] * inv - bf_lo(c.x); o0[1] = s0[j][1] * inv - bf_hi(c.x); o0[2] = s0[j][2] * inv - bf_lo(c.y); o0[3] = s0[j][3] * inv - bf_hi(c.y);
        o1[0] = s1[j][0] * inv - bf_lo(c.z); o1[1] = s1[j][1] * inv - bf_hi(c.z); o1[2] = s1[j][2] * inv - bf_lo(c.w); o1[3] = s1[j][3] * inv - bf_hi(c.w);
        *(u32x4*)(dst + (size_t)j * 1024) = pack8(o0, o1); }
}
__device__ __forceinline__ void conv_pool(const DArgs& a, int l, int worker, int nworkers, int tid, const int skip, const int it0, const int it1) {
    const bf16_t* CU = (const bf16_t*)(a.ws + WS_CU); const bf16_t* CBp = (const bf16_t*)(a.ws + WS_CB); const bf16_t* PI = (const bf16_t*)(a.ws + WS_PI);
    bf16_t* YCONV = (bf16_t*)(a.ws + WS_YCONV); bf16_t* POOLED = (bf16_t*)(a.ws + WS_POOLED);
    const float* cw = a.in[I_CONVW] + (size_t)l * 3 * 512;
    const int nitem = TG * 16;
    for (int it = it0 + worker * 512 + tid; it < it1; it += nworkers * 512) {
        const int ispool = it >= nitem, q = ispool ? it - nitem : it;
        if (!ispool) {
            const int c0 = (q & 63) * 8, gr0 = (q >> 6) * 4;
            const int r = gr0 % TPB, lo = r < CL ? 0 : CL, hi = r < CL ? CL : TPB;
            if (skip && r < CL) continue;
            u32x4 u[6], bv[4];
            const bool hasm = r > lo, hasp = r + 4 < hi; const u32x4 z4 = {0u, 0u, 0u, 0u};
            u[0] = *(const u32x4*)(CU + (size_t)(hasm ? gr0 - 1 : gr0) * 512 + c0);
#pragma unroll
            for (int j = 0; j < 4; ++j) { u[1 + j] = *(const u32x4*)(CU + (size_t)(gr0 + j) * 512 + c0); bv[j] = *(const u32x4*)(CBp + (size_t)(gr0 + j) * 512 + c0); }
            u[5] = *(const u32x4*)(CU + (size_t)(hasp ? gr0 + 4 : gr0 + 3) * 512 + c0);
            u[0] = hasm ? u[0] : z4; u[5] = hasp ? u[5] : z4;
            const f32x4 w00 = *(const f32x4*)(cw + c0), w01 = *(const f32x4*)(cw + c0 + 4), w10 = *(const f32x4*)(cw + 512 + c0), w11 = *(const f32x4*)(cw + 512 + c0 + 4),
                        w20 = *(const f32x4*)(cw + 1024 + c0), w21 = *(const f32x4*)(cw + 1024 + c0 + 4);
#pragma unroll
            for (int j = 0; j < 4; ++j) { const u32x4 u0 = u[j], u1 = u[j + 1], u2 = u[j + 2], b = bv[j]; f32x4 o0, o1;
                o0[0] = bf_lo(b.x) * (w00[0] * bf_lo(u0.x) + w10[0] * bf_lo(u1.x) + w20[0] * bf_lo(u2.x)); o0[1] = bf_hi(b.x) * (w00[1] * bf_hi(u0.x) + w10[1] * bf_hi(u1.x) + w20[1] * bf_hi(u2.x));
                o0[2] = bf_lo(b.y) * (w00[2] * bf_lo(u0.y) + w10[2] * bf_lo(u1.y) + w20[2] * bf_lo(u2.y)); o0[3] = bf_hi(b.y) * (w00[3] * bf_hi(u0.y) + w10[3] * bf_hi(u1.y) + w20[3] * bf_hi(u2.y));
                o1[0] = bf_lo(b.z) * (w01[0] * bf_lo(u0.z) + w11[0] * bf_lo(u1.z) + w21[0] * bf_lo(u2.z)); o1[1] = bf_hi(b.z) * (w01[1] * bf_hi(u0.z) + w11[1] * bf_hi(u1.z) + w21[1] * bf_hi(u2.z));
                o1[2] = bf_lo(b.w) * (w01[2] * bf_lo(u0.w) + w11[2] * bf_lo(u1.w) + w21[2] * bf_lo(u2.w)); o1[3] = bf_hi(b.w) * (w01[3] * bf_hi(u0.w) + w11[3] * bf_hi(u1.w) + w21[3] * bf_hi(u2.w));
                *(u32x4*)(YCONV + (size_t)(gr0 + j) * 1024 + c0) = pack8(o0, o1); }
        } else {
            const int cbl = q & 15; const int rest = q >> 4; const int g2 = rest / (TG / 4), gr0 = 4 * (rest - g2 * (TG / 4)), cc0 = g2 * 128 + cbl * 8;
            const int r0 = gr0 % TPB, lo2 = r0 < CL ? 0 : CL, hi2 = r0 < CL ? CL : TPB, base2 = gr0 - r0, tl0 = r0 - lo2, n = hi2 - lo2;
            if (skip && r0 < CL) continue;
            const bf16_t* prow = PI + (size_t)(base2 + lo2) * 512 + cc0; bf16_t* dst = YCONV + (size_t)gr0 * 1024 + 512 + cc0;
            if (g2 == 0) pool_quad<2>(prow, tl0, n, dst); else if (g2 == 1) pool_quad<4>(prow, tl0, n, dst); else if (g2 == 2) pool_quad<8>(prow, tl0, n, dst); else pool_quad<16>(prow, tl0, n, dst);
        }
    }
}

__device__ __forceinline__ void finalize_unit(const DArgs& a, int unit, const float* lg2p, LAS unsigned char* lds, int tid, int wid, int lane, unsigned* chn = nullptr, unsigned* barw = nullptr) {
    asm volatile("" : "+v"(tid)); lane = tid & 63;
    const int c = unit % NCH, h = (unit / NCH) & 3, bb = unit / (NCH * 4), fr = lane & 15, fq = lane >> 4;
    const int tok0 = bb * TPB + c * 128;
    const float lgf = lg2p[h], lgb = lg2p[4 + h];
    LAS unsigned char* R0 = lds; LAS unsigned char* R1 = lds + 65536;
    const char* QF = (const char*)(a.ws + WS_QF);
    dma_tile<128, false>(R0, (const char*)(a.ws + WS_KF) + ((size_t)tok0 * 512 + h * 128) * 2, 1024, tid);
    bf16x8 qf[4];
    { const size_t ro = ((size_t)(tok0 + wid * 16 + fr) * 512 + h * 128 + 8 * fq) * 2;
#pragma unroll
      for (int ks = 0; ks < 4; ++ks) qf[ks] = *(const bf16x8*)(QF + ro + ks * 64); }
    asm volatile("" ::: "memory");
    const char* ST = (const char*)(a.ws + WS_STATES) + ((size_t)((bb * 4 + h) * 2) * NCH + c) * 256 * 128 * 2;
    dma_tile<256, true>(R1, (const char*)(a.ws + WS_VT) + ((size_t)(h * 256) * TG + tok0) * 2, (size_t)TG * 2, tid);
    if (chn) {
        if (threadIdx.x == 0) { unsigned* cf = chn + ((bb * 4 + h) * 2) * 16; unsigned* cb = cf + 16;
            XB_SPIN(xb_ld(cf) < 4u || xb_ld(cb) < 4u, barw);
            __builtin_amdgcn_fence(__ATOMIC_ACQUIRE, "agent"); asm volatile("s_waitcnt vmcnt(0)" ::: "memory"); }
        __syncthreads(); }
    dma_tile<128, true>(R0 + 32768, ST, 256, tid);
    asm volatile("s_waitcnt vmcnt(12)" ::: "memory"); __builtin_amdgcn_s_barrier(); asm volatile("" ::: "memory");
    bf16x8 pf[4];
    const int i = wid * 16 + fr;
    {
        f32x4 sc[8];
#pragma unroll
        for (int n = 0; n < 8; ++n) sc[n] = (f32x4){0.f, 0.f, 0.f, 0.f};
#pragma unroll
        for (int k2 = 0; k2 < 2; ++k2) { bf16x8 kfr[2][8];
#pragma unroll
            for (int kk = 0; kk < 2; ++kk)
#pragma unroll
                for (int n = 0; n < 8; ++n) kfr[kk][n] = lds_frag(R0, 16 * n + fr, 4 * (2 * k2 + kk) + fq);
            LDS_WAIT(); __builtin_amdgcn_sched_barrier(0);
#pragma unroll
            for (int kk = 0; kk < 2; ++kk)
#pragma unroll
                for (int n = 0; n < 8; ++n) sc[n] = __builtin_amdgcn_mfma_f32_16x16x32_bf16(kfr[kk][n], qf[2 * k2 + kk], sc[n], 0, 0, 0); }
#pragma unroll
        for (int n = 0; n < 8; ++n)
#pragma unroll
            for (int jj = 0; jj < 4; ++jj) { const int d = i - (16 * n + 4 * fq + jj); const float w = d == 0 ? 2.0f : __builtin_amdgcn_exp2f(d > 0 ? lgf * (float)d : lgb * (float)(-d)); sc[n][jj] *= w; }
#pragma unroll
        for (int ks = 0; ks < 4; ++ks) { u32x4 w; w.x = cvt_pk_bf16(sc[2 * ks][0], sc[2 * ks][1]); w.y = cvt_pk_bf16(sc[2 * ks][2], sc[2 * ks][3]);
            w.z = cvt_pk_bf16(sc[2 * ks + 1][0], sc[2 * ks + 1][1]); w.w = cvt_pk_bf16(sc[2 * ks + 1][2], sc[2 * ks + 1][3]);
            asm volatile("s_nop 1\n\tv_permlane16_swap_b32 %0, %1\n\tv_permlane16_swap_b32 %2, %3\n\ts_nop 1" : "+v"(w.x), "+v"(w.z), "+v"(w.y), "+v"(w.w));
            pf[ks] = __builtin_bit_cast(bf16x8, w); }
    }
    asm volatile("s_waitcnt vmcnt(0)" ::: "memory"); LDS_WAIT(); __builtin_amdgcn_s_barrier(); asm volatile("" ::: "memory");
    dma_tile<128, true>(R0, ST + (size_t)128 * 256, 256, tid);
    f32x4 o[16];
#pragma unroll
    for (int n = 0; n < 16; ++n) o[n] = (f32x4){0.f, 0.f, 0.f, 0.f};
#pragma unroll
    for (int ks = 0; ks < 4; ++ks) { bf16x8 vw[16];
#pragma unroll
        for (int n = 0; n < 16; ++n) vw[n] = lds_frag(R1, 16 * n + fr, 4 * ks + (((fq & 1) << 1) | (fq >> 1)));
        LDS_WAIT(); __builtin_amdgcn_sched_barrier(0);
#pragma unroll
        for (int n = 0; n < 16; ++n) o[n] = __builtin_amdgcn_mfma_f32_16x16x32_bf16(vw[n], pf[ks], o[n], 0, 0, 0); }
    { const float r1 = __builtin_amdgcn_exp2f(-lgf * (float)i);
#pragma unroll
      for (int n = 0; n < 16; ++n) o[n] = o[n] * r1; }
#pragma unroll
    for (int k2 = 0; k2 < 2; ++k2) { bf16x8 sfr[2][8];
#pragma unroll
        for (int kk = 0; kk < 2; ++kk)
#pragma unroll
            for (int n = 0; n < 8; ++n) sfr[kk][n] = lds_frag(R0 + 32768, 16 * n + fr, 4 * (2 * k2 + kk) + fq);
        LDS_WAIT(); __builtin_amdgcn_sched_barrier(0);
#pragma unroll
        for (int kk = 0; kk < 2; ++kk)
#pragma unroll
            for (int n = 0; n < 8; ++n) o[n] = __builtin_amdgcn_mfma_f32_16x16x32_bf16(sfr[kk][n], qf[2 * k2 + kk], o[n], 0, 0, 0); }
    asm volatile("s_waitcnt vmcnt(0) lgkmcnt(0)" ::: "memory"); __builtin_amdgcn_s_barrier(); asm volatile("" ::: "memory");
    dma_tile<256, true>(R1, ST + (size_t)NCH * 256 * 128 * 2, 256, tid);
#pragma unroll
    for (int k2 = 0; k2 < 2; ++k2) { bf16x8 sfr[2][8];
#pragma unroll
        for (int kk = 0; kk < 2; ++kk)
#pragma unroll
            for (int n = 0; n < 8; ++n) sfr[kk][n] = lds_frag(R0, 16 * n + fr, 4 * (2 * k2 + kk) + fq);
        LDS_WAIT(); __builtin_amdgcn_sched_barrier(0);
#pragma unroll
        for (int kk = 0; kk < 2; ++kk)
#pragma unroll
            for (int n = 0; n < 8; ++n) o[8 + n] = __builtin_amdgcn_mfma_f32_16x16x32_bf16(sfr[kk][n], qf[2 * k2 + kk], o[8 + n], 0, 0, 0); }
    { const float r2 = __builtin_amdgcn_exp2f((lgf + lgb) * (float)i);
#pragma unroll
      for (int n = 0; n < 16; ++n) o[n] = o[n] * r2; }
    asm volatile("s_waitcnt vmcnt(0) lgkmcnt(0)" ::: "memory"); __builtin_amdgcn_s_barrier(); asm volatile("" ::: "memory");
    const size_t ro = (size_t)(tok0 + wid * 16 + fr) * 1024 + h * 256 + 8 * fq;
    const bf16_t* GS = (const bf16_t*)(a.ws + WS_GS) + ro; bf16_t* YR = (bf16_t*)(a.ws + WS_YRET) + ro;
    u32x4 gsv[8];
#pragma unroll
    for (int p = 0; p < 8; ++p) gsv[p] = *(const u32x4*)(GS + 32 * p);
    asm volatile("" ::: "memory");
#pragma unroll
    for (int ks = 0; ks < 4; ++ks) { bf16x8 sbr[16];
#pragma unroll
        for (int n = 0; n < 16; ++n) sbr[n] = lds_frag(R1, 16 * n + fr, 4 * ks + fq);
        LDS_WAIT(); __builtin_amdgcn_sched_barrier(0);
#pragma unroll
        for (int n = 0; n < 16; ++n) o[n] = __builtin_amdgcn_mfma_f32_16x16x32_bf16(sbr[n], qf[ks], o[n], 0, 0, 0); }
    { const float r3 = __builtin_amdgcn_exp2f(-lgb * (float)i);
#pragma unroll
      for (int n = 0; n < 16; ++n) o[n] = o[n] * r3; }
    float s = 0.f;
#pragma unroll
    for (int n = 0; n < 16; ++n) s += (o[n][0] + o[n][1]) + (o[n][2] + o[n][3]);
    s = rows4_sum(s);
    const float mu = s * (1.0f / 256.0f); float q = 0.f;
#pragma unroll
    for (int n = 0; n < 16; ++n) { o[n] = o[n] - mu; q += (o[n][0] * o[n][0] + o[n][1] * o[n][1]) + (o[n][2] * o[n][2] + o[n][3] * o[n][3]); }
    q = rows4_sum(q);
    const float rstd = rsqrtf(q * (1.0f / 256.0f) + EPS);
#pragma unroll
    for (int p = 0; p < 8; ++p) { const u32x4 g = gsv[p]; f32x4 v0 = o[2 * p] * rstd, v1 = o[2 * p + 1] * rstd;
        v0[0] *= bf_lo(g.x); v0[1] *= bf_hi(g.x); v0[2] *= bf_lo(g.y); v0[3] *= bf_hi(g.y); v1[0] *= bf_lo(g.z); v1[1] *= bf_hi(g.z); v1[2] *= bf_lo(g.w); v1[3] *= bf_hi(g.w);
        *(u32x4*)(YR + 32 * p) = pack8(v0, v1); }
    LDS_WAIT(); __builtin_amdgcn_s_barrier(); asm volatile("" ::: "memory");
}

__device__ __forceinline__ void finalize_ctx_unit(const DArgs& a, int unit, const float* lg2p, LAS unsigned char* lds, int tid, int wid, int lane) {
    asm volatile("" : "+v"(tid)); lane = tid & 63;
    const int c = unit & 1, h = (unit >> 1) & 3, bb = unit >> 3, fr = lane & 15, fq = lane >> 4;
    const int tok0 = bb * TPB + c * 128, tokx = bb * TPB + (1 - c) * 128;
    const float lgf = lg2p[h], lgb = lg2p[4 + h];
    LAS unsigned char* R0 = lds; LAS unsigned char* R1 = lds + 65536;
    const char* QF = (const char*)(a.ws + WS_QF);
    dma_tile<128, false>(R0, (const char*)(a.ws + WS_KF) + ((size_t)tok0 * 512 + h * 128) * 2, 1024, tid);
    dma_tile<128, false>(R0 + 32768, (const char*)(a.ws + WS_KF) + ((size_t)tokx * 512 + h * 128) * 2, 1024, tid);
    dma_tile<256, true>(R1, (const char*)(a.ws + WS_VT) + ((size_t)(h * 256) * TG + tok0) * 2, (size_t)TG * 2, tid);
    bf16x8 qf[4];
    { const size_t ro = ((size_t)(tok0 + wid * 16 + fr) * 512 + h * 128 + 8 * fq) * 2;
#pragma unroll
      for (int ks = 0; ks < 4; ++ks) qf[ks] = *(const bf16x8*)(QF + ro + ks * 64); }
    asm volatile("s_waitcnt vmcnt(0)" ::: "memory"); __builtin_amdgcn_s_barrier(); asm volatile("" ::: "memory");
    bf16x8 pf[2][4];
    const int i = wid * 16 + fr;
#pragma unroll
    for (int kc = 0; kc < 2; ++kc) {
        const LAS unsigned char* Kb = R0 + kc * 32768; const int off = kc == 0 ? 0 : (c ? 128 : -128);
        f32x4 sc[8];
#pragma unroll
        for (int n = 0; n < 8; ++n) sc[n] = (f32x4){0.f, 0.f, 0.f, 0.f};
#pragma unroll
        for (int k2 = 0; k2 < 2; ++k2) { bf16x8 kfr[2][8];
#pragma unroll
            for (int kk = 0; kk < 2; ++kk)
#pragma unroll
                for (int n = 0; n < 8; ++n) kfr[kk][n] = lds_frag(Kb, 16 * n + fr, 4 * (2 * k2 + kk) + fq);
            LDS_WAIT(); __builtin_amdgcn_sched_barrier(0);
#pragma unroll
            for (int kk = 0; kk < 2; ++kk)
#pragma unroll
                for (int n = 0; n < 8; ++n) sc[n] = __builtin_amdgcn_mfma_f32_16x16x32_bf16(kfr[kk][n], qf[2 * k2 + kk], sc[n], 0, 0, 0); }
#pragma unroll
        for (int n = 0; n < 8; ++n)
#pragma unroll
            for (int jj = 0; jj < 4; ++jj) { const int d = i + off - (16 * n + 4 * fq + jj); const float w = d == 0 ? 2.0f : __builtin_amdgcn_exp2f(d > 0 ? lgf * (float)d : lgb * (float)(-d)); sc[n][jj] *= w; }
#pragma unroll
        for (int ks = 0; ks < 4; ++ks) { u32x4 w; w.x = cvt_pk_bf16(sc[2 * ks][0], sc[2 * ks][1]); w.y = cvt_pk_bf16(sc[2 * ks][2], sc[2 * ks][3]);
            w.z = cvt_pk_bf16(sc[2 * ks + 1][0], sc[2 * ks + 1][1]); w.w = cvt_pk_bf16(sc[2 * ks + 1][2], sc[2 * ks + 1][3]);
            asm volatile("s_nop 1\n\tv_permlane16_swap_b32 %0, %1\n\tv_permlane16_swap_b32 %2, %3\n\ts_nop 1" : "+v"(w.x), "+v"(w.z), "+v"(w.y), "+v"(w.w));
            pf[kc][ks] = __builtin_bit_cast(bf16x8, w); }
    }
    LDS_WAIT(); __builtin_amdgcn_s_barrier(); asm volatile("" ::: "memory");
    dma_tile<256, true>(R0, (const char*)(a.ws + WS_VT) + ((size_t)(h * 256) * TG + tokx) * 2, (size_t)TG * 2, tid);
    f32x4 o[16]; u32x4 gsv[8];
    const bf16_t* GSp = (const bf16_t*)(a.ws + WS_GS) + (size_t)(tok0 + wid * 16 + fr) * 1024 + h * 256 + 8 * fq;
#pragma unroll
    for (int n = 0; n < 16; ++n) o[n] = (f32x4){0.f, 0.f, 0.f, 0.f};
#pragma unroll
    for (int kc = 0; kc < 2; ++kc) {
        const LAS unsigned char* Vb = kc == 0 ? R1 : R0;
        if (kc == 1) { asm volatile("s_waitcnt vmcnt(0) lgkmcnt(0)" ::: "memory"); __builtin_amdgcn_s_barrier(); asm volatile("" ::: "memory"); }
        if (kc == 1) {
#pragma unroll
            for (int p = 0; p < 8; ++p) gsv[p] = *(const u32x4*)(GSp + 32 * p);
            asm volatile("" ::: "memory"); }
#pragma unroll
        for (int ks = 0; ks < 4; ++ks) { bf16x8 vw[16];
#pragma unroll
            for (int n = 0; n < 16; ++n) vw[n] = lds_frag(Vb, 16 * n + fr, 4 * ks + (((fq & 1) << 1) | (fq >> 1)));
            LDS_WAIT(); __builtin_amdgcn_sched_barrier(0);
#pragma unroll
            for (int n = 0; n < 16; ++n) o[n] = __builtin_amdgcn_mfma_f32_16x16x32_bf16(vw[n], pf[kc][ks], o[n], 0, 0, 0); }
    }
    float s = 0.f;
#pragma unroll
    for (int n = 0; n < 16; ++n) s += (o[n][0] + o[n][1]) + (o[n][2] + o[n][3]);
    s = rows4_sum(s);
    const float mu = s * (1.0f / 256.0f); float q = 0.f;
#pragma unroll
    for (int n = 0; n < 16; ++n) { o[n] = o[n] - mu; q += (o[n][0] * o[n][0] + o[n][1] * o[n][1]) + (o[n][2] * o[n][2] + o[n][3] * o[n][3]); }
    q = rows4_sum(q);
    const float rstd = rsqrtf(q * (1.0f / 256.0f) + EPS);
    const size_t ro = (size_t)(tok0 + wid * 16 + fr) * 1024 + h * 256 + 8 * fq;
    const bf16_t* GS = (const bf16_t*)(a.ws + WS_GS) + ro; bf16_t* YR = (bf16_t*)(a.ws + WS_YRET) + ro;
#pragma unroll
    for (int p = 0; p < 8; ++p) { const u32x4 g = gsv[p]; f32x4 v0 = o[2 * p] * rstd, v1 = o[2 * p + 1] * rstd;
        v0[0] *= bf_lo(g.x); v0[1] *= bf_hi(g.x); v0[2] *= bf_lo(g.y); v0[3] *= bf_hi(g.y); v1[0] *= bf_lo(g.z); v1[1] *= bf_hi(g.z); v1[2] *= bf_lo(g.w); v1[3] *= bf_hi(g.w);
        *(u32x4*)(YR + 32 * p) = pack8(v0, v1); }
    LDS_WAIT(); __builtin_amdgcn_s_barrier(); asm volatile("" ::: "memory");
}

__global__ void __launch_bounds__(512, 2) fwd_kernel(Args kargs_unused) {
    DArgs a; a.out = KArgs().out(); a.ws = KArgs().wsp();
    extern __shared__ __attribute__((aligned(16))) unsigned char lds_raw[];
    LAS unsigned char* lds = (LAS unsigned char*)lds_raw;
    int tid = threadIdx.x, lane = tid & 63, wid = __builtin_amdgcn_readfirstlane(tid >> 6);
    int G = gridDim.x, bid = blockIdx.x;
#define PHASE_FENCE() do { asm volatile("" : "+v"(tid)); lane = tid & 63; wid = __builtin_amdgcn_readfirstlane(tid >> 6); \
        { unsigned _l = __builtin_amdgcn_readfirstlane((unsigned)(size_t)lds); asm volatile("" : "+s"(_l)); lds = (LAS unsigned char*)(size_t)_l; } \
        G = __builtin_amdgcn_readfirstlane(G); bid = __builtin_amdgcn_readfirstlane(bid); asm volatile("" : "+s"(G), "+s"(bid)); \
        a.out = KArgs().out(); a.ws = KArgs().wsp(); } while (0)
    for (int u = tid; u < (LDS_BYTES - LC_OFF) / 4; u += 512) ((LAS unsigned*)(lds + LC_OFF))[u] = 0u;
    __syncthreads();
    unsigned* ctl = (unsigned*)(a.ws + WS_CTL);
    const XcdBarrier bar = xcd_barrier_post(ctl + CW_BAR, (volatile LAS unsigned*)(lds + LC_BAR));
#define GRID_BAR() do { for (int _r = 0; _r < REP_BAR; ++_r) { XcdBarrier _b = bar; asm volatile("" : "+s"(_b.bar)); xcd_barrier(_b); } PHASE_FENCE(); } while (0)
#define TAB ((const float*)(a.ws + WS_TAB))

#ifndef DBG_POISON
#define DBG_POISON 0
#endif
    if (DBG_POISON) {
        u32x4* p4 = (u32x4*)(a.ws + 1 * MiB); const size_t n4 = (WS_END - 1 * MiB) / 16; const u32x4 pz = {0xffffffffu, 0xffffffffu, 0xffffffffu, 0xffffffffu};
        for (size_t i = (size_t)bid * 512 + tid; i < n4; i += (size_t)G * 512) p4[i] = pz;
        u32x4* o4 = (u32x4*)a.out; const size_t m4 = (size_t)NB * SEQ * D / 4;
        for (size_t i = (size_t)bid * 512 + tid; i < m4; i += (size_t)G * 512) o4[i] = pz;
        GRID_BAR();
    }
#ifndef X_NO_P0
    for (int rep = 0; rep < REP_P0; ++rep) { p0_mod(a, lds, tid, wid, lane, 0, 1, bid, G, true); __syncthreads(); }
    for (int rep = 0; rep < REP_CVT; ++rep) {
        const int gw0 = bid * 8 + wid;
        if (G == 256) { if (gw0 < 768) convert_weights(a, 0, lds, wid, lane, gw0, 5376, 768); else convert_weights(a, 0, lds, wid, lane, 5376 + (gw0 - 768), -1, 1280); }
        else convert_weights(a, 0, lds, wid, lane);
        __syncthreads(); }
#endif
    GRID_BAR();

    for (int l = 0; l < DEPTH; ++l) {
#define lg2 (TAB + l * 8)
        const int skipctx = (l == DEPTH - 1) ? 1 : 0;
#ifndef X_NO_N1
        if (l > 0) for (int rep = 0; rep < REP_CVT; ++rep) { convert_weights(a, l, lds, wid, lane); __syncthreads(); }
        if (l == 0) { for (int rep = 0; rep < REP_N1; ++rep) phase_n1<0>(a, l, wid, lane); } else phase_n1<1>(a, l, wid, lane);
#endif
        GRID_BAR();
        for (int g = 0; g <= NG; ++g) {
#ifndef NO_OVERLAP
#define NO_OVERLAP 0
#endif
            const int nG4 = g == 0 ? 0 : (skipctx ? 128 : 144);
            if (bid < nG4) {
#ifndef X_NO_OUTPROJ
                for (int rep = 0; rep < REP_G4; ++rep) { PHASE_FENCE();
                    const int gp = g - 1;
                    const unsigned char* GATE = (const unsigned char*)(a.ws + ((gp & 1) ? WS_GATE1 : WS_GATE0)); bf16_t* MG = (bf16_t*)(a.ws + WS_MERGED) + (size_t)gp * TG * 1024;
                    SchedG4 S{(const char*)(a.ws + WS_YRET), (const char*)(a.ws + WS_YCONV), (const char*)(a.ws + WS_WRET), (const char*)(a.ws + WS_WCONV), skipctx ? TG / 256 / 9 * 8 : TG / 256, nG4, bid, skipctx};
                    EpiG4 E{GATE, MG};
                    pg8::gemm_phase<1024, 1024, 1024, EpiG4, SchedG4, true, true, true>(lds, tid, S, E);
                }
#endif
                if (g == NG && l + 1 < DEPTH) { PHASE_FENCE(); p0_mod(a, lds, tid, wid, lane, l + 1, 1, bid, nG4, false); }
            }
            if (g == NG && bid >= nG4) {
                PHASE_FENCE();
                const int nwt = skipctx ? (NG - 1) * (TG / 256 / 9 * 8) : 3 * (G - nG4) / 4;
                SchedPlain S{(const char*)(a.ws + WS_MERGED), (const char*)(a.ws + WS_WO), (size_t)256 * 2048, (size_t)256 * 2048, nwt, 4, G - nG4, bid - nG4, skipctx};
                EpiPlainBf16 E{(bf16_t*)(a.ws + WS_YATT), 1024};
                pg8::gemm_phase<1024, 1024, 1024, EpiPlainBf16, SchedPlain, true, true>(lds, tid, S, E);
            }
            if (g < NG) {
#ifndef X_NO_INPROJ
                for (int rep = 0; rep < REP_G1; ++rep) { PHASE_FENCE();
                    SchedInproj S{(const char*)(a.ws + WS_H) + (size_t)g * TG * 2048, (const char*)(a.ws + WS_WIN), G, bid, nG4, skipctx};
                    EpiInproj E{a.ws, lg2, TAB + 32, TAB + 32 + 2048, (bf16_t*)(a.ws + ((g & 1) ? WS_GATE1 : WS_GATE0))};
                    pg8::gemm_phase<1024, 1024, 1024, EpiInproj, SchedInproj, true, true>(lds, tid, S, E);
                }
#endif
            }
            GRID_BAR();
            if (g == NG) break;
            {
                unsigned* chn = ctl + CW_CHN + (size_t)((l * NG + g) * BG * 4 * 2) * 16;
#ifndef X_NO_CHAIN
                if (bid < NCHAIN) {
                    const int cu = (((bid & 7) + 8 * (bid >> 5)) << 2) | ((bid >> 3) & 3);
                    for (int r2 = 0; r2 < REP_CH; ++r2) chain_unit(a, cu, lg2, lds, tid, wid, lane);
                    if (threadIdx.x == 0) { __builtin_amdgcn_fence(__ATOMIC_RELEASE, "agent"); asm volatile("s_waitcnt vmcnt(0)" ::: "memory"); xb_add(chn + (cu >> 2) * 16, 1u); } }
                else if (skipctx) { for (int r2 = 0; r2 < REP_CP; ++r2) conv_pool(a, l, bid - NCHAIN, G - NCHAIN, tid, skipctx, 0, CP_TOTAL); }
                else {
                    const int w = bid - NCHAIN, nv = 2 * (G - NCHAIN) - 32;
                    if (w < 32) { finalize_ctx_unit(a, w, lg2, lds, tid, wid, lane); conv_pool(a, l, w, nv, tid, skipctx, 0, CP_TOTAL); }
                    else { conv_pool(a, l, 32 + 2 * (w - 32), nv, tid, skipctx, 0, CP_TOTAL); conv_pool(a, l, 33 + 2 * (w - 32), nv, tid, skipctx, 0, CP_TOTAL); }
                }
#endif
#ifndef X_NO_FIN
                PHASE_FENCE();
                for (int rep = 0; rep < REP_G3; ++rep)
                for (int u = bid; u < BG * 4 * 16; u += G) finalize_unit(a, (u >> 4) * NCH + 2 + (u & 15), lg2, lds, tid, wid, lane, chn, ctl + CW_BAR);
#endif
            }
            GRID_BAR();
        }
#ifndef X_NO_WO
        for (int rep = 0; rep < REP_WO; ++rep) { PHASE_FENCE();
            const int t0 = skipctx ? (NG - 1) * (TG / 256) : 3 * (G - 144) / 4, nt = skipctx ? TG / 256 / 9 * 8 : NG * (TG / 256) - t0;
            SchedPlain S{(const char*)(a.ws + WS_MERGED) + (size_t)t0 * 256 * 2048, (const char*)(a.ws + WS_WO), (size_t)256 * 2048, (size_t)256 * 2048, nt, 4, G, bid, skipctx};
            EpiPlainBf16 E{(bf16_t*)(a.ws + WS_YATT) + (size_t)t0 * 256 * 1024, 1024};
            pg8::gemm_phase<1024, 1024, 1024, EpiPlainBf16, SchedPlain, true, true>(lds, tid, S, E);
        }
#endif
        GRID_BAR();
#ifndef X_NO_N2
        for (int rep = 1; rep < REP_N2; ++rep) { phase_n2(a, l, lds, tid, wid, lane, skipctx, true); __syncthreads(); }
        phase_n2(a, l, lds, tid, wid, lane, skipctx);
#endif
        GRID_BAR();
        {
            LAS int* cnt = (LAS int*)(lds + LC_CNT); LAS int* poff = (LAS int*)(lds + LC_POFF); LAS int* tile_e = (LAS int*)(lds + LC_TILEE); LAS int* ntl = (LAS int*)(lds + LC_NT);
            if (tid < 16) cnt[tid] = (int)xb_ld(ctl + CW_CNT + 64 * l + tid);
            __syncthreads();
            if (tid == 0) { int off = 0;
_Pragma("unroll 1")
                for (int e = 0; e < 16; ++e) { const int n = cnt[e]; poff[e] = off; const int nt = (n + 255) >> 8;
                    for (int t = 0; t < nt; ++t) tile_e[(off >> 8) + t] = e; off += nt << 8; } poff[16] = off; ntl[0] = off >> 8; }
            __syncthreads();
            const int ntiles = ntl[0];
            {
                int* SLOTOF = (int*)(a.ws + WS_SLOTOF); const int* LISTp = (const int*)(a.ws + WS_LIST);
                for (int idx = bid * 512 + tid; idx < ntiles * 256; idx += G * 512) { const int e = tile_e[idx >> 8], p = idx - poff[e]; if (p < cnt[e]) SLOTOF[LISTp[(size_t)e * T + p]] = idx; }
            }
#ifndef X_NO_M1
            for (int rep = 0; rep < REP_M1; ++rep) { PHASE_FENCE(); SchedMoeG S{(const char*)(a.ws + WS_H), (const char*)(a.ws + WS_W13), tile_e, cnt, poff, (const int*)(a.ws + WS_LIST), (LAS int*)(lds + LC_GTBL), ntiles, G, bid};
              EpiMoeUp E{(bf16_t*)(a.ws + WS_ACT)};
              pg8::gemm_phase<1024, 1024, 1024, EpiMoeUp, SchedMoeG, true, true>(lds, tid, S, E); }
#endif
            GRID_BAR();
#ifndef X_NO_M2
            for (int rep = 0; rep < REP_M2; ++rep) { PHASE_FENCE(); SchedMoe S{(const char*)(a.ws + WS_ACT), (const char*)(a.ws + WS_W2), (size_t)256 * 1024, (size_t)1024, tile_e, ntiles, G, bid};
              EpiPlainBf16 E{(bf16_t*)(a.ws + WS_YS), 1024};
              pg8::gemm_phase<512, 512, 512, EpiPlainBf16, SchedMoe, true, true>(lds, tid, S, E); }
#endif
            GRID_BAR();
        }
    }
    {
        float poison = 0.f;
        const unsigned err = xb_ld(ctl + CW_ERR), tmo = xb_ld(ctl + CW_BAR + XB_TMO);
        if (err) poison = sqrtf((float)err); else if (tmo) poison = sqrtf(90.f);
        phase_final(a, wid, lane, poison);
    }
}

extern "C" void kernel_launch(void* const* d_in, const int* in_sizes, int n_in, void* d_out, int out_size, void* d_ws, size_t ws_size, hipStream_t stream) {
    static int grid = 0;
    if (grid == 0) {
        if (n_in != 25 || ws_size < WS_END) { fprintf(stderr, "kernel_launch: unexpected n_in %d / ws_size %zu\n", n_in, ws_size); grid = -1; return; }
        int dev = 0, cus = 0, per_cu = 0;
        if (hipGetDevice(&dev) != hipSuccess || hipDeviceGetAttribute(&cus, hipDeviceAttributeMultiprocessorCount, dev) != hipSuccess) { grid = -1; return; }
        if (hipFuncSetAttribute((const void*)fwd_kernel, hipFuncAttributeMaxDynamicSharedMemorySize, LDS_BYTES) != hipSuccess) { grid = -1; return; }
        if (hipOccupancyMaxActiveBlocksPerMultiprocessor(&per_cu, (const void*)fwd_kernel, 512, LDS_BYTES) != hipSuccess || per_cu < 1) fprintf(stderr, "kernel_launch: occupancy query says %d\n", per_cu);
        (void)hipGetLastError();
        grid = cus;
    }
    if (grid < 0) return;
    if (hipMemsetAsync((char*)d_ws + WS_CTL, 0, 1 * MiB, stream) != hipSuccess) return;
    Args a{};
    for (int i = 0; i < 25; ++i) a.in[i] = (const float*)d_in[i];
    a.out = (float*)d_out; a.ws = (unsigned char*)d_ws;
    hipLaunchKernelGGL(fwd_kernel, dim3(grid), dim3(512), LDS_BYTES, stream, a);
}
```
